# Optimizing an MI355X kernel written in HIP

```python
import math
import jax, jax.numpy as jnp
from jax import lax
import numpy as np

D_MODEL = 1024
BATCH = 8
SEQ = 2048
DEPTH = 4
DEC_BATCH = 128
DEC_SEQ = 4
PAST_LEN = 16384
PAGE_SIZE = 128

N_META = 16
N_MIXERS = 2
N_GDN = (DEPTH + 1) // 2
N_RWKV = DEPTH // 2
GDN_HEADS = 8
GDN_DK = 128
GDN_DV = 128
GDN_QK = GDN_HEADS * GDN_DK
GDN_V = GDN_HEADS * GDN_DV
GDN_CONV = 4
GDN_CONV_DIM = 2 * GDN_QK + GDN_V
GDN_IN = GDN_CONV_DIM + GDN_V + 2 * GDN_HEADS
GDN_CHUNK = 64
RWKV_N = 64
RWKV_HEADS = D_MODEL // RWKV_N
DECAY_LORA = 64
AAA_LORA = 64
MV_LORA = 32
GATE_LORA = 160
D_FF = 2816
FFN_CONV = 3
RMS_EPS = 1e-6
L2_EPS = 1e-6
GN_EPS = 64e-5

kernel_name = 'hybrid_gdn_rwkv7_convffn_meta_step'

F32 = jnp.float32


def rmsnorm(x, g):
    xf = x.astype(F32)
    y = xf * lax.rsqrt(jnp.mean(xf * xf, axis=-1, keepdims=True) + RMS_EPS)
    return (y * g.astype(F32)).astype(x.dtype)


def l2norm(x):
    xf = x.astype(F32)
    return xf * lax.rsqrt(jnp.sum(xf * xf, axis=-1, keepdims=True) + L2_EPS)


def causal_dwconv(buf, x, w):
    width = w.shape[0]
    L = x.shape[1]
    xc = jnp.concatenate([buf.astype(x.dtype), x], axis=1)
    out = xc[:, 0:L] * w[0]
    for j in range(1, width):
        out = out + xc[:, j:j + L] * w[j]
    return out, xc[:, L:]


def gdn_segment(q, k, v, g, beta, S):
    B, L, H, _ = q.shape
    c = min(GDN_CHUNK, L)
    n = -(-L // c)
    pad = n * c - L

    def blocks(t):
        t = jnp.pad(t, [(0, 0), (0, pad)] + [(0, 0)] * (t.ndim - 2))
        t = t.reshape((B, n, c) + t.shape[2:])
        return jnp.moveaxis(t, (1, 3), (0, 2))

    q, k, v, g, beta = blocks(q), blocks(k), blocks(v), blocks(g), blocks(beta)
    G = jnp.cumsum(g, axis=-1)
    idx = jnp.arange(c)
    causal = idx[:, None] >= idx[None, :]
    strict = idx[:, None] > idx[None, :]
    decay_mat = jnp.exp(jnp.where(causal, G[..., :, None] - G[..., None, :], -jnp.inf))
    kb = k * beta[..., None]
    kk = jnp.einsum('nbhid,nbhjd->nbhij', kb, k) * decay_mat
    M = jnp.eye(c, dtype=F32) + jnp.where(strict, kk, 0.0)
    rhs = jnp.concatenate([v * beta[..., None], kb * jnp.exp(G)[..., None]], axis=-1)
    sol = lax.linalg.triangular_solve(M, rhs, left_side=True, lower=True, unit_diagonal=True)
    u, w = sol[..., :GDN_DV], sol[..., GDN_DV:]
    qk = jnp.einsum('nbhid,nbhjd->nbhij', q, k) * decay_mat

    def step(S, xs):
        q_c, k_c, u_c, w_c, G_c, qk_c = xs
        v_new = u_c - jnp.einsum('bhik,bhkv->bhiv', w_c, S)
        o = (jnp.einsum('bhik,bhkv->bhiv', q_c * jnp.exp(G_c)[..., None], S)
             + jnp.einsum('bhij,bhjv->bhiv', qk_c, v_new))
        g_last = G_c[..., -1]
        k_dec = k_c * jnp.exp(g_last[..., None] - G_c)[..., None]
        S = S * jnp.exp(g_last)[..., None, None] + jnp.einsum('bhik,bhiv->bhkv', k_dec, v_new)
        return S, o

    S, o = lax.scan(step, S, (q, k, u, w, G, qk))
    o = jnp.transpose(o, (1, 0, 3, 2, 4)).reshape(B, n * c, H, GDN_DV)[:, :L]
    return o, S


def gdn_mixer(h, conv_buf, S0, w_in, conv_w, A_log, dt_bias, norm_w, w_out, segments):
    B, L, _ = h.shape
    proj = jnp.einsum('bld,de->ble', h, w_in)
    qkv = proj[..., :GDN_CONV_DIM]
    z = proj[..., GDN_CONV_DIM:GDN_CONV_DIM + GDN_V]
    a = proj[..., GDN_CONV_DIM + GDN_V:GDN_CONV_DIM + GDN_V + GDN_HEADS].astype(F32)
    b = proj[..., GDN_CONV_DIM + GDN_V + GDN_HEADS:].astype(F32)
    qkv_c, new_buf = causal_dwconv(conv_buf, qkv, conv_w)
    qkv_c = jax.nn.silu(qkv_c)
    q = l2norm(qkv_c[..., :GDN_QK].reshape(B, L, GDN_HEADS, GDN_DK)) * (GDN_DK ** -0.5)
    k = l2norm(qkv_c[..., GDN_QK:2 * GDN_QK].reshape(B, L, GDN_HEADS, GDN_DK))
    v = qkv_c[..., 2 * GDN_QK:].reshape(B, L, GDN_HEADS, GDN_DV).astype(F32)
    g = -jnp.exp(A_log.astype(F32)) * jax.nn.softplus(a + dt_bias.astype(F32))
    beta = jax.nn.sigmoid(b)
    S = S0.astype(F32)
    outs = []
    start = 0
    for seg in segments:
        sl = slice(start, start + seg)
        o_seg, S = gdn_segment(q[:, sl], k[:, sl], v[:, sl], g[:, sl], beta[:, sl], S)
        outs.append(o_seg)
        start += seg
    o = jnp.concatenate(outs, axis=1) if len(outs) > 1 else outs[0]
    o = o * lax.rsqrt(jnp.mean(o * o, axis=-1, keepdims=True) + RMS_EPS) * norm_w.astype(F32)
    o = o * jax.nn.silu(z.reshape(B, L, GDN_HEADS, GDN_DV).astype(F32))
    y = jnp.einsum('ble,ed->bld', o.reshape(B, L, GDN_V).astype(h.dtype), w_out)
    return y, new_buf.astype(conv_buf.dtype), S.astype(S0.dtype)


def rwkv_step(S, xs):
    r_t, w_t, k_t, v_t, kk_t, a_t = xs
    sa = jnp.einsum('bhvk,bhk->bhv', S, kk_t)
    S = (S * w_t[:, :, None, :] - sa[..., None] * (kk_t * a_t)[:, :, None, :]
         + v_t[..., None] * k_t[:, :, None, :])
    y = jnp.einsum('bhvk,bhk->bhv', S, r_t)
    return S, y


def rwkv_mixer(h, shift, S0, v_first, vres, mix, wr, wk, wv, wo, w0, w1, w2, a0, a1, a2,
               g1, g2, k_k, k_a, r_k, ln_w, ln_b):
    B, L, D = h.shape
    prev = jnp.concatenate([shift[:, None].astype(h.dtype), h[:, :-1]], axis=1)
    xx = prev - h
    xr = h + xx * mix[0]
    xw = h + xx * mix[1]
    xk = h + xx * mix[2]
    xv = h + xx * mix[3]
    xa = h + xx * mix[4]
    xg = h + xx * mix[5]
    r = xr @ wr
    k = xk @ wk
    v = xv @ wv
    w_log = -jax.nn.softplus(-(w0 + jnp.tanh(xw @ w1) @ w2).astype(F32)) - 0.5
    decay = jnp.exp(-jnp.exp(w_log))
    if vres is None:
        v_first = v
    else:
        v0, v1, v2 = vres
        v = v + (v_first - v) * jax.nn.sigmoid(v0 + (xv @ v1) @ v2)
    a = jax.nn.sigmoid((a0 + (xa @ a1) @ a2).astype(F32))
    gate = jax.nn.sigmoid(xg @ g1) @ g2

    def heads(t):
        return t.reshape(B, L, RWKV_HEADS, RWKV_N).astype(F32)

    kk = l2norm(heads(k * k_k))
    kf = k.astype(F32) * (1.0 + (a - 1.0) * k_a.astype(F32))
    rh, kh, vh, ah, dh = heads(r), heads(kf), heads(v), heads(a), heads(decay)
    tm = lambda t: jnp.moveaxis(t, 1, 0)
    S, y = lax.scan(rwkv_step, S0.astype(F32), (tm(rh), tm(dh), tm(kh), tm(vh), tm(kk), tm(ah)))
    y = jnp.moveaxis(y, 0, 1)
    mu = jnp.mean(y, axis=-1, keepdims=True)
    var = jnp.mean(jnp.square(y - mu), axis=-1, keepdims=True)
    y = ((y - mu) * lax.rsqrt(var + GN_EPS)).reshape(B, L, D) * ln_w.astype(F32) + ln_b.astype(F32)
    bonus = jnp.sum(rh * kh * r_k.astype(F32), axis=-1, keepdims=True) * vh
    y = y + bonus.reshape(B, L, D)
    out = (y * gate.astype(F32)).astype(h.dtype) @ wo
    return out, h[:, -1].astype(shift.dtype), S.astype(S0.dtype), v_first


def conv_ffn(h, buf, w_up, conv_w, w_down):
    up2 = h @ w_up
    gt, up = up2[..., :D_FF], up2[..., D_FF:]
    gc, new_buf = causal_dwconv(buf, gt, conv_w)
    y = (jax.nn.silu(gc) * up) @ w_down
    return y, new_buf.astype(buf.dtype)


def trunk(x, gdn_S, gdn_conv, rwkv_S, rwkv_shift, ffn_conv, segments, p):
    gS, gC, rS, rSh, fC = [], [], [], [], []
    v_first = None
    for i in range(DEPTH):
        hn = rmsnorm(x, p['norm_mix'][i])
        j = i // N_MIXERS
        if i % N_MIXERS == 0:
            y, cb, S = gdn_mixer(hn, gdn_conv[j], gdn_S[j], p['gdn_w_in'][j], p['gdn_conv_w'][j],
                                 p['gdn_A_log'][j], p['gdn_dt_bias'][j], p['gdn_norm_w'][j],
                                 p['gdn_w_out'][j], segments)
            gS.append(S)
            gC.append(cb)
        else:
            vres = None if j == 0 else (p['rwkv_v0'][j - 1], p['rwkv_v1'][j - 1], p['rwkv_v2'][j - 1])
            y, sh, S, v_first = rwkv_mixer(
                hn, rwkv_shift[j], rwkv_S[j], v_first, vres, p['rwkv_mix'][j], p['rwkv_wr'][j],
                p['rwkv_wk'][j], p['rwkv_wv'][j], p['rwkv_wo'][j], p['rwkv_w0'][j], p['rwkv_w1'][j],
                p['rwkv_w2'][j], p['rwkv_a0'][j], p['rwkv_a1'][j], p['rwkv_a2'][j], p['rwkv_g1'][j],
                p['rwkv_g2'][j], p['rwkv_k_k'][j], p['rwkv_k_a'][j], p['rwkv_r_k'][j],
                p['rwkv_ln_w'][j], p['rwkv_ln_b'][j])
            rS.append(S)
            rSh.append(sh)
        x = x + y
        hn = rmsnorm(x, p['norm_ffn'][i])
        y, fb = conv_ffn(hn, ffn_conv[i], p['ffn_w_up'][i], p['ffn_conv_w'][i], p['ffn_w_down'][i])
        fC.append(fb)
        x = x + y
    x = rmsnorm(x, p['norm_final'])
    return x, jnp.stack(gS), jnp.stack(gC), jnp.stack(rS), jnp.stack(rSh), jnp.stack(fC)


def setup_inputs(seed: int = 0) -> dict:
    key = jax.random.key(seed)
    ks = iter(jax.random.split(key, 64))
    D = D_MODEL

    def nrm(shape, scale):
        return jax.random.normal(next(ks), shape, F32) * scale

    def gain(shape):
        return 1.0 + nrm(shape, 0.02)

    def unif(shape, lo, hi):
        return jax.random.uniform(next(ks), shape, F32, lo, hi)

    dt = jnp.exp(unif((N_GDN, GDN_HEADS), math.log(1e-3), math.log(1e-1)))
    gdn_dt_bias = dt + jnp.log(-jnp.expm1(-dt))
    return {
        'x_prompt': nrm((BATCH, SEQ, D), 1.0),
        'x_sample': nrm((DEC_BATCH, DEC_SEQ, D), 1.0),
        'state_gdn_S': nrm((N_GDN, DEC_BATCH, GDN_HEADS, GDN_DK, GDN_DV), 0.1),
        'state_gdn_conv': nrm((N_GDN, DEC_BATCH, GDN_CONV - 1, GDN_CONV_DIM), 1.0),
        'state_rwkv_S': nrm((N_RWKV, DEC_BATCH, RWKV_HEADS, RWKV_N, RWKV_N), 0.3),
        'state_rwkv_shift': nrm((N_RWKV, DEC_BATCH, D), 1.0),
        'state_ffn_conv': nrm((DEPTH, DEC_BATCH, FFN_CONV - 1, D_FF), 1.0),
        'meta_tokens': nrm((N_META, D), 1.0),
        'norm_mix': gain((DEPTH, D)),
        'norm_ffn': gain((DEPTH, D)),
        'norm_final': gain((D,)),
        'gdn_w_in': nrm((N_GDN, D, GDN_IN), D ** -0.5),
        'gdn_conv_w': nrm((N_GDN, GDN_CONV, GDN_CONV_DIM), GDN_CONV ** -0.5),
        'gdn_A_log': jnp.log(unif((N_GDN, GDN_HEADS), 1.0, 16.0)),
        'gdn_dt_bias': gdn_dt_bias,
        'gdn_norm_w': gain((N_GDN, GDN_DV)),
        'gdn_w_out': nrm((N_GDN, GDN_V, D), GDN_V ** -0.5),
        'rwkv_mix': unif((N_RWKV, 6, D), 0.0, 1.0),
        'rwkv_wr': nrm((N_RWKV, D, D), D ** -0.5),
        'rwkv_wk': nrm((N_RWKV, D, D), D ** -0.5),
        'rwkv_wv': nrm((N_RWKV, D, D), D ** -0.5),
        'rwkv_wo': nrm((N_RWKV, D, D), D ** -0.5),
        'rwkv_w0': unif((N_RWKV, D), -4.0, 0.0),
        'rwkv_w1': nrm((N_RWKV, D, DECAY_LORA), D ** -0.5),
        'rwkv_w2': nrm((N_RWKV, DECAY_LORA, D), 0.1 * DECAY_LORA ** -0.5),
        'rwkv_a0': nrm((N_RWKV, D), 0.1),
        'rwkv_a1': nrm((N_RWKV, D, AAA_LORA), D ** -0.5),
        'rwkv_a2': nrm((N_RWKV, AAA_LORA, D), 0.1 * AAA_LORA ** -0.5),
        'rwkv_g1': nrm((N_RWKV, D, GATE_LORA), D ** -0.5),
        'rwkv_g2': nrm((N_RWKV, GATE_LORA, D), GATE_LORA ** -0.5),
        'rwkv_k_k': 0.85 + nrm((N_RWKV, D), 0.02),
        'rwkv_k_a': gain((N_RWKV, D)),
        'rwkv_r_k': nrm((N_RWKV, RWKV_HEADS, RWKV_N), 0.1),
        'rwkv_ln_w': gain((N_RWKV, D)),
        'rwkv_ln_b': nrm((N_RWKV, D), 0.01),
        'rwkv_v0': nrm((N_RWKV - 1, D), 0.1),
        'rwkv_v1': nrm((N_RWKV - 1, D, MV_LORA), D ** -0.5),
        'rwkv_v2': nrm((N_RWKV - 1, MV_LORA, D), 0.1 * MV_LORA ** -0.5),
        'ffn_w_up': nrm((DEPTH, D, 2 * D_FF), D ** -0.5),
        'ffn_conv_w': nrm((DEPTH, FFN_CONV, D_FF), FFN_CONV ** -0.5),
        'ffn_w_down': nrm((DEPTH, D_FF, D), D_FF ** -0.5),
    }


def reference(x_prompt, x_sample, state_gdn_S, state_gdn_conv, state_rwkv_S, state_rwkv_shift,
              state_ffn_conv, meta_tokens, norm_mix, norm_ffn, norm_final, gdn_w_in, gdn_conv_w,
              gdn_A_log, gdn_dt_bias, gdn_norm_w, gdn_w_out, rwkv_mix, rwkv_wr, rwkv_wk, rwkv_wv,
              rwkv_wo, rwkv_w0, rwkv_w1, rwkv_w2, rwkv_a0, rwkv_a1, rwkv_a2, rwkv_g1, rwkv_g2,
              rwkv_k_k, rwkv_k_a, rwkv_r_k, rwkv_ln_w, rwkv_ln_b, rwkv_v0, rwkv_v1, rwkv_v2,
              ffn_w_up, ffn_conv_w, ffn_w_down):
    p = dict(norm_mix=norm_mix, norm_ffn=norm_ffn, norm_final=norm_final, gdn_w_in=gdn_w_in,
             gdn_conv_w=gdn_conv_w, gdn_A_log=gdn_A_log, gdn_dt_bias=gdn_dt_bias,
             gdn_norm_w=gdn_norm_w, gdn_w_out=gdn_w_out, rwkv_mix=rwkv_mix, rwkv_wr=rwkv_wr,
             rwkv_wk=rwkv_wk, rwkv_wv=rwkv_wv, rwkv_wo=rwkv_wo, rwkv_w0=rwkv_w0, rwkv_w1=rwkv_w1,
             rwkv_w2=rwkv_w2, rwkv_a0=rwkv_a0, rwkv_a1=rwkv_a1, rwkv_a2=rwkv_a2, rwkv_g1=rwkv_g1,
             rwkv_g2=rwkv_g2, rwkv_k_k=rwkv_k_k, rwkv_k_a=rwkv_k_a, rwkv_r_k=rwkv_r_k,
             rwkv_ln_w=rwkv_ln_w, rwkv_ln_b=rwkv_ln_b, rwkv_v0=rwkv_v0, rwkv_v1=rwkv_v1,
             rwkv_v2=rwkv_v2, ffn_w_up=ffn_w_up, ffn_conv_w=ffn_conv_w, ffn_w_down=ffn_w_down)
    B = x_prompt.shape[0]
    dt = x_prompt.dtype
    meta = jnp.broadcast_to(meta_tokens.astype(dt)[None], (B, N_META, D_MODEL))
    xp = jnp.concatenate([meta, x_prompt], axis=1)
    Lp = xp.shape[1]
    z_gS = jnp.zeros((N_GDN, B, GDN_HEADS, GDN_DK, GDN_DV), dt)
    z_gC = jnp.zeros((N_GDN, B, GDN_CONV - 1, GDN_CONV_DIM), dt)
    z_rS = jnp.zeros((N_RWKV, B, RWKV_HEADS, RWKV_N, RWKV_N), dt)
    z_rSh = jnp.zeros((N_RWKV, B, D_MODEL), dt)
    z_fC = jnp.zeros((DEPTH, B, FFN_CONV - 1, D_FF), dt)
    yp, gS_p, gC_p, rS_p, rSh_p, fC_p = trunk(xp, z_gS, z_gC, z_rS, z_rSh, z_fC,
                                               [N_META, Lp - N_META], p)
    y_prompt = yp[:, N_META:]
    y_sample, gS_s, gC_s, rS_s, rSh_s, fC_s = trunk(x_sample, state_gdn_S, state_gdn_conv,
                                                     state_rwkv_S, state_rwkv_shift,
                                                     state_ffn_conv, [x_sample.shape[1]], p)
    return (y_prompt, y_sample, gS_p, gC_p, rS_p, rSh_p, fC_p, gS_s, gC_s, rS_s, rSh_s, fC_s)
```

```cpp
#include <hip/hip_runtime.h>
#include <hip/hip_cooperative_groups.h>
#include <cstdio>
#include <cstring>
#include <cstdint>
namespace cg = cooperative_groups;

#ifndef MULTI_LAUNCH
#define MULTI_LAUNCH 1
#endif

typedef unsigned short bf16_t;
typedef short bf16x8 __attribute__((ext_vector_type(8)));
typedef float f32x4 __attribute__((ext_vector_type(4)));
typedef float f32x2 __attribute__((ext_vector_type(2)));
typedef unsigned u32x4 __attribute__((ext_vector_type(4)));
typedef unsigned u32x2 __attribute__((ext_vector_type(2)));

constexpr int D = 1024;
constexpr int LP = 2064;
constexpr int TP = 8 * LP;
constexpr int TS = 512;
constexpr int T = TP + TS;
constexpr int MPAD = 17152;
constexpr int NSEQ = 136;
constexpr int DFF = 2816;
constexpr int NTH = 512;
constexpr int GIN_LD = 4096;
constexpr int GIN_NP = 4224;
constexpr int R1_N = 3712;
constexpr int NCHUNK = 33;
constexpr int CH_BYTES = 73728;
constexpr int SMEM_BYTES = 131072;

enum { PH_PREP = 0, PH_NORM_MIX, PH_GDN_IN, PH_GDN_PREP, PH_GDN_SCAN, PH_GDN_OUT, PH_NORM_FFN, PH_FFN_UP, PH_FFN_DOWN,
       PH_RWKV_IN, PH_RWKV_LORA, PH_RWKV_SCAN, PH_RWKV_POST, PH_RWKV_OUT, PH_FINAL };
constexpr int NPHASES = 36;

struct TJob { const float* src; bf16_t* dst; int K, N, Kd, Nd; };
constexpr int MAXJOBS = 40;

struct Params {
    const float *x_prompt, *x_sample, *st_gS, *st_gC, *st_rS, *st_rSh, *st_fC, *meta;
    const float *norm_mix, *norm_ffn, *norm_final;
    const float *gdn_conv_w, *gdn_A_log, *gdn_dt_bias, *gdn_norm_w;
    const float *rwkv_mix, *rwkv_w0, *rwkv_a0, *rwkv_k_k, *rwkv_k_a, *rwkv_r_k, *rwkv_ln_w, *rwkv_ln_b, *rwkv_v0;
    const float *ffn_conv_w;
    float *y_prompt, *y_sample, *gS_p, *gC_p, *rS_p, *rSh_p, *fC_p, *gS_s, *gC_s, *rS_s, *rSh_s, *fC_s;
    bf16_t *w_in_t, *w_out_t, *rwkv1_t, *w2t, *a2t, *g2t, *v2t, *wo_t, *up_t, *down_t;
    float* X; bf16_t* HN; bf16_t* SHIFT; bf16_t* RA; char* RB; float* AB; bf16_t* VFIRST; float* GL;
    unsigned* bar;
    int njobs; int pad0;
    TJob jobs[MAXJOBS];
};

typedef const __attribute__((address_space(4))) Params CParams;

__device__ __forceinline__ int otid() { int t = threadIdx.x; asm volatile("" : "+v"(t)); return t; }
__device__ __forceinline__ int obid() { int t = blockIdx.x; asm volatile("" : "+s"(t)); return t; }
__device__ __forceinline__ int ogrid() { int t = gridDim.x; asm volatile("" : "+s"(t)); return t; }
__device__ __forceinline__ float bf2f(unsigned h) { return __uint_as_float(h << 16); }
__device__ __forceinline__ unsigned f2bf(float f) { unsigned u = __float_as_uint(f); u += 0x7fffu + ((u >> 16) & 1u); return u >> 16; }
__device__ __forceinline__ unsigned pack2(float lo, float hi) { return f2bf(lo) | (f2bf(hi) << 16); }
__device__ __forceinline__ float lo16(unsigned u) { return __uint_as_float(u << 16); }
__device__ __forceinline__ float hi16(unsigned u) { return __uint_as_float(u & 0xffff0000u); }
__device__ __forceinline__ float sigmoidf_(float x) { return 1.f / (1.f + __expf(-x)); }
__device__ __forceinline__ float siluf_(float x) { return x / (1.f + __expf(-x)); }
__device__ __forceinline__ float softplusf_(float x) { return x > 20.f ? x : log1pf(__expf(x)); }
__device__ __forceinline__ float wave_sum(float v) {
#pragma unroll
    for (int o = 1; o < 64; o <<= 1) v += __shfl_xor(v, o);
    return v;
}
template <int CTRL> __device__ __forceinline__ float dpp_add(float x) {
    int v = __builtin_amdgcn_update_dpp(0, __float_as_int(x), CTRL, 0xf, 0xf, true);
    return x + __int_as_float(v);
}
__device__ __forceinline__ float row16_sum(float x) {
    x = dpp_add<0xB1>(x);
    x = dpp_add<0x4E>(x);
    x = dpp_add<0x141>(x);
    x = dpp_add<0x140>(x);
    return x;
}
__device__ __forceinline__ void tokdec(int m, int& seq, int& t, int& L) {
    if (m < TP) { seq = m / LP; t = m - seq * LP; L = LP; }
    else { int s = m - TP; seq = 8 + (s >> 2); t = s & 3; L = 4; }
}
__device__ __forceinline__ int gdn_ph(int q) { return q == 0 ? PH_NORM_MIX : q == 1 ? PH_GDN_IN : q == 2 ? PH_GDN_PREP : q == 3 ? PH_GDN_SCAN : q == 4 ? PH_GDN_OUT : q == 5 ? PH_NORM_FFN : q == 6 ? PH_FFN_UP : PH_FFN_DOWN; }
__device__ __forceinline__ int rwkv_ph(int q) { return q == 0 ? PH_NORM_MIX : q == 1 ? PH_RWKV_IN : q == 2 ? PH_RWKV_LORA : q == 3 ? PH_RWKV_SCAN : q == 4 ? PH_RWKV_POST : q == 5 ? PH_RWKV_OUT : q == 6 ? PH_NORM_FFN : q == 7 ? PH_FFN_UP : PH_FFN_DOWN; }
__device__ __forceinline__ void phase_info(int ph, int& type, int& layer) {
    if (ph == 0) { type = PH_PREP; layer = 0; return; }
    if (ph == NPHASES - 1) { type = PH_FINAL; layer = 0; return; }
    int q = ph - 1;
    if (q < 8) { layer = 0; type = gdn_ph(q); return; } q -= 8;
    if (q < 9) { layer = 1; type = rwkv_ph(q); return; } q -= 9;
    if (q < 8) { layer = 2; type = gdn_ph(q); return; } q -= 8;
    layer = 3; type = rwkv_ph(q);
}

#define XB_TMO      128
#define XB_XCNT(j)  (256  + 64 * (j))
#define XB_XSUB(j)  (1280 + 64 * (j))
#define XB_XGEN(j)  (2304 + 64 * (j))
#define XB_TOP      3328
#define XB_TOPGEN   3392
#define XCD_BAR_WORDS 3456
#define XB_SPIN_CAP (1u << 22)
#define LAS __attribute__((address_space(3)))
__device__ __forceinline__ unsigned xb_ld(unsigned* p)              { return __hip_atomic_load(p, __ATOMIC_RELAXED, __HIP_MEMORY_SCOPE_AGENT); }
__device__ __forceinline__ unsigned xb_add(unsigned* p, unsigned v) { return __hip_atomic_fetch_add(p, v, __ATOMIC_RELAXED, __HIP_MEMORY_SCOPE_AGENT); }
__device__ __forceinline__ unsigned xb_xcc_id() { return (unsigned)__builtin_amdgcn_s_getreg((3 << 11) | 20) & 0xFu; }
#define XB_SPIN(cond, bar) do { unsigned _sp = 0; while (cond) { __builtin_amdgcn_s_sleep(1); \
    if ((++_sp & 255u) == 0u) { if (xb_ld(&(bar)[XB_TMO])) break; if (_sp > XB_SPIN_CAP) { atomicAdd(&(bar)[XB_TMO], 1u); break; } } } } while (0)
struct XcdBarrier { unsigned* bar; unsigned x; volatile LAS unsigned* st; };
__device__ __forceinline__ XcdBarrier xcd_barrier_post(unsigned* bar, volatile LAS unsigned* st) {
    XcdBarrier b; b.bar = bar; b.x = xb_xcc_id(); b.st = st;
    if (threadIdx.x == 0) (void)xb_add(&bar[XB_XCNT(b.x)], 1u);
    return b;
}
__device__ __forceinline__ void xcd_barrier_complete(unsigned* bar, unsigned x, unsigned& nloc, unsigned& nx) {
    const unsigned G = gridDim.x * gridDim.y * gridDim.z;
    unsigned sum, cnt, mine, sp = 0u;
    for (;;) {
        sum = 0u; cnt = 0u; mine = 0u;
#pragma unroll
        for (unsigned j = 0; j < 16; ++j) { const unsigned c = xb_ld(&bar[XB_XCNT(j)]); sum += c; cnt += (c > 0u) ? 1u : 0u; mine = (j == x) ? c : mine; }
        if (sum == G) break;
        __builtin_amdgcn_s_sleep(1);
        if ((++sp & 255u) == 0u) { if (xb_ld(&bar[XB_TMO])) break; if (sp > XB_SPIN_CAP) { atomicAdd(&bar[XB_TMO], 1u); break; } }
    }
    nloc = mine > 0u ? mine : 1u; nx = cnt > 0u ? cnt : 1u;
}
__device__ __forceinline__ void xcd_barrier(const XcdBarrier& b) {
    asm volatile("s_waitcnt vmcnt(0)" ::: "memory");
    __syncthreads();
    if (threadIdx.x == 0) {
        unsigned* bar = b.bar;
        __builtin_amdgcn_s_waitcnt(0);
        unsigned nloc = b.st[0], nx = b.st[1];
        if (nloc == 0u) { xcd_barrier_complete(bar, b.x, nloc, nx); b.st[0] = nloc; b.st[1] = nx; }
        const unsigned old = xb_add(&bar[XB_XSUB(b.x)], 1u);
        const unsigned gen = old / nloc;
        if (old + 1u == (gen + 1u) * nloc) {
            __builtin_amdgcn_fence(__ATOMIC_RELEASE, "agent");
            asm volatile("s_waitcnt vmcnt(0)" ::: "memory");
            const unsigned og = xb_add(&bar[XB_TOP], 1u);
            const unsigned tg = og / nx;
            if (og + 1u == (tg + 1u) * nx) xb_add(&bar[XB_TOPGEN], 1u);
            else XB_SPIN(xb_ld(&bar[XB_TOPGEN]) == tg, bar);
            __builtin_amdgcn_fence(__ATOMIC_ACQUIRE, "agent");
            xb_add(&bar[XB_XGEN(b.x)], 1u);
            asm volatile("s_waitcnt vmcnt(0)" ::: "memory");
        } else {
            XB_SPIN(xb_ld(&bar[XB_XGEN(b.x)]) == gen, bar);
            __builtin_amdgcn_fence(__ATOMIC_ACQUIRE, "agent");
            asm volatile("s_waitcnt vmcnt(0)" ::: "memory");
        }
    }
    __syncthreads();
}

__device__ __forceinline__ void prep_phase(CParams& p, char* smem) {
    const int tid = otid(), lane = tid & 63, wave = tid >> 6;
    float* scr = (float*)(smem + wave * 8704);
    const int gw = obid() * 8 + wave, NGW = ogrid() * 8;
    int total = 0;
    for (int j = 0; j < p.njobs; ++j) total += (p.jobs[j].Kd >> 6) * (p.jobs[j].Nd >> 5);
    for (int it = gw; it < total; it += NGW) {
        int r = it, j = 0;
        for (;; ++j) { const int c = (p.jobs[j].Kd >> 6) * (p.jobs[j].Nd >> 5); if (r < c) break; r -= c; }
        TJob jb; jb.src = p.jobs[j].src; jb.dst = p.jobs[j].dst; jb.K = p.jobs[j].K; jb.N = p.jobs[j].N; jb.Kd = p.jobs[j].Kd; jb.Nd = p.jobs[j].Nd;
        const int nblk = jb.Nd >> 5, kb = r / nblk, nb = r - kb * nblk, k0 = kb * 64, n0 = nb * 32;
        const int n = n0 + (lane & 31);
#pragma unroll 8
        for (int i = 0; i < 32; ++i) {
            const int kk = 2 * i + (lane >> 5);
            float v = 0.f;
            if (k0 + kk < jb.K && n < jb.N) v = jb.src[(size_t)(k0 + kk) * jb.N + n];
            scr[kk * 33 + (lane & 31)] = v;
        }
        __builtin_amdgcn_s_waitcnt(0xc07f);
        asm volatile("" ::: "memory");
        const int c = lane & 7;
#pragma unroll
        for (int jj = 0; jj < 4; ++jj) {
            const int nn = (lane >> 3) + 8 * jj;
            const float* s = scr + (8 * c) * 33 + nn;
            u32x4 o;
            o.x = pack2(s[0], s[33]); o.y = pack2(s[66], s[99]); o.z = pack2(s[132], s[165]); o.w = pack2(s[198], s[231]);
            *(u32x4*)(jb.dst + (size_t)(n0 + nn) * jb.Kd + k0 + 8 * c) = o;
        }
        __builtin_amdgcn_s_waitcnt(0xc07f);
        asm volatile("" ::: "memory");
    }
}

__device__ __forceinline__ const float* xsrc_row(CParams& p, int m) {
    int seq, t, L; tokdec(m, seq, t, L);
    if (m < TP) return t < 16 ? p.meta + (size_t)t * D : p.x_prompt + ((size_t)seq * 2048 + (t - 16)) * D;
    return p.x_sample + (size_t)(m - TP) * D;
}
__device__ __forceinline__ void norm_phase(CParams& p, int layer, int mode) {
    const int tid = otid(), lane = tid & 63, wave = tid >> 6;
    const int gw = obid() * 8 + wave, NGW = ogrid() * 8;
    const float* g = mode == 0 ? p.norm_mix + layer * D : (mode == 1 ? p.norm_ffn + layer * D : p.norm_final);
    const bool first = (mode == 0 && layer == 0);
    const bool rw = (mode == 0 && (layer & 1));
    const int j = layer >> 1;
    f32x4 gv[4];
#pragma unroll
    for (int q = 0; q < 4; ++q) gv[q] = *(const f32x4*)(g + q * 256 + lane * 4);
    const int nrows = (mode == 2) ? T : MPAD + (rw ? NSEQ : 0);
    for (int m = gw; m < nrows; m += NGW) {
        if (m >= MPAD) {
            const int seq = m - MPAD;
            bf16_t* o = p.SHIFT + (size_t)seq * D;
#pragma unroll
            for (int q = 0; q < 4; ++q) {
                f32x4 v = {0.f, 0.f, 0.f, 0.f};
                if (seq >= 8) v = *(const f32x4*)(p.st_rSh + ((size_t)j * 128 + (seq - 8)) * D + q * 256 + lane * 4);
                u32x2 w; w.x = pack2(v.x, v.y); w.y = pack2(v.z, v.w);
                *(u32x2*)(o + q * 256 + lane * 4) = w;
            }
            continue;
        }
        if (m >= T) {
            u32x2 z; z.x = 0; z.y = 0;
#pragma unroll
            for (int q = 0; q < 4; ++q) *(u32x2*)(p.HN + (size_t)m * D + q * 256 + lane * 4) = z;
            if (first) { f32x4 zz = {0.f, 0.f, 0.f, 0.f};
#pragma unroll
                for (int q = 0; q < 4; ++q) *(f32x4*)(p.X + (size_t)m * D + q * 256 + lane * 4) = zz; }
            continue;
        }
        const float* src = first ? xsrc_row(p, m) : p.X + (size_t)m * D;
        f32x4 v[4]; float ss = 0.f;
#pragma unroll
        for (int q = 0; q < 4; ++q) { v[q] = *(const f32x4*)(src + q * 256 + lane * 4); ss += v[q].x * v[q].x + v[q].y * v[q].y + v[q].z * v[q].z + v[q].w * v[q].w; }
        ss = wave_sum(ss);
        const float rstd = rsqrtf(ss * (1.f / D) + 1e-6f);
        if (first) {
#pragma unroll
            for (int q = 0; q < 4; ++q) *(f32x4*)(p.X + (size_t)m * D + q * 256 + lane * 4) = v[q];
        }
        int seq, t, L; tokdec(m, seq, t, L);
#pragma unroll
        for (int q = 0; q < 4; ++q) v[q] = v[q] * rstd * gv[q];
        if (mode == 2) {
            float* o = nullptr;
            if (m < TP) { if (t >= 16) o = p.y_prompt + ((size_t)seq * 2048 + (t - 16)) * D; }
            else o = p.y_sample + (size_t)(m - TP) * D;
            if (o) {
#pragma unroll
                for (int q = 0; q < 4; ++q) *(f32x4*)(o + q * 256 + lane * 4) = v[q];
            }
            continue;
        }
#pragma unroll
        for (int q = 0; q < 4; ++q) { u32x2 w; w.x = pack2(v[q].x, v[q].y); w.y = pack2(v[q].z, v[q].w); *(u32x2*)(p.HN + (size_t)m * D + q * 256 + lane * 4) = w; }
        if (rw && t == L - 1) {
            float* o = (seq < 8) ? p.rSh_p + ((size_t)j * 8 + seq) * D : p.rSh_s + ((size_t)j * 128 + (seq - 8)) * D;
#pragma unroll
            for (int q = 0; q < 4; ++q) *(f32x4*)(o + q * 256 + lane * 4) = v[q];
        }
    }
}

constexpr int A_STAGE = 32768, B_STAGE = 16384;
__device__ __forceinline__ int lds_off(int r, int c) {
    const int st = (r >> 4) * 2 + (c >> 5), rr = r & 15, cc = c & 31, ob = rr * 64 + cc * 2;
    return st * 1024 + (ob ^ (((ob >> 9) & 1) << 5));
}
struct ALoadPlain {
    const bf16_t* p[4]; u32x4 r[4]; int lo[4];
    __device__ __forceinline__ void init(int tid, const bf16_t* A, int lda, int m0, int mmax) {
        const int row = tid >> 3, kc = tid & 7;
#pragma unroll
        for (int i = 0; i < 4; ++i) { int m = m0 + row + 64 * i; m = m < 0 ? 0 : (m > mmax ? mmax : m); p[i] = A + (size_t)m * lda + kc * 8; lo[i] = lds_off(row + 64 * i, kc * 8); }
    }
    __device__ __forceinline__ void issue(int kt) {
#pragma unroll
        for (int i = 0; i < 4; ++i) r[i] = *(const u32x4*)(p[i] + kt * 64);
    }
    __device__ __forceinline__ void commit(char* As) {
#pragma unroll
        for (int i = 0; i < 4; ++i) *(u32x4*)(As + lo[i]) = r[i];
    }
};
struct ALoadMix {
    const bf16_t* ph[4]; const bf16_t* pp[4]; const float* pm; u32x4 rh[4], rp[4]; f32x4 m0, m1; int lo[4];
    __device__ __forceinline__ void init(int tid, CParams& p, const float* mixv, int mbase) {
        const int row = tid >> 3, kc = tid & 7;
#pragma unroll
        for (int i = 0; i < 4; ++i) {
            int m = mbase + row + 64 * i; if (m > MPAD - 1) m = MPAD - 1;
            ph[i] = p.HN + (size_t)m * D + kc * 8; lo[i] = lds_off(row + 64 * i, kc * 8);
            if (m < T) { int seq, t, L; tokdec(m, seq, t, L); pp[i] = (t == 0) ? p.SHIFT + (size_t)seq * D + kc * 8 : ph[i] - D; }
            else pp[i] = ph[i];
        }
        pm = mixv + kc * 8;
    }
    __device__ __forceinline__ void issue(int kt) {
#pragma unroll
        for (int i = 0; i < 4; ++i) { rh[i] = *(const u32x4*)(ph[i] + kt * 64); rp[i] = *(const u32x4*)(pp[i] + kt * 64); }
        m0 = *(const f32x4*)(pm + kt * 64); m1 = *(const f32x4*)(pm + kt * 64 + 4);
    }
    __device__ __forceinline__ void commit(char* As) {
#pragma unroll
        for (int i = 0; i < 4; ++i) {
            u32x4 o;
#pragma unroll
            for (int q = 0; q < 4; ++q) {
                const unsigned hh = rh[i][q], pv = rp[i][q];
                const float h0 = lo16(hh), h1 = hi16(hh), p0 = lo16(pv), p1 = hi16(pv);
                const float ma = q < 2 ? m0[2 * q] : m1[2 * q - 4], mb = q < 2 ? m0[2 * q + 1] : m1[2 * q - 3];
                o[q] = pack2(h0 + (p0 - h0) * ma, h1 + (p1 - h1) * mb);
            }
            *(u32x4*)(As + lo[i]) = o;
        }
    }
};
struct BLoad {
    const bf16_t* p[2]; u32x4 r[2]; int lo[2];
    __device__ __forceinline__ void init(int tid, const bf16_t* B0, const bf16_t* B1, int ldb) {
        const int row = tid >> 3, kc = tid & 7;
        p[0] = B0 + (size_t)row * ldb + kc * 8;
        p[1] = B1 + (size_t)row * ldb + kc * 8;
        lo[0] = lds_off(row, kc * 8); lo[1] = lds_off(row + 64, kc * 8);
    }
    __device__ __forceinline__ void issue(int kt) { r[0] = *(const u32x4*)(p[0] + kt * 64); r[1] = *(const u32x4*)(p[1] + kt * 64); }
    __device__ __forceinline__ void commit(char* Bs) {
        *(u32x4*)(Bs + lo[0]) = r[0];
        *(u32x4*)(Bs + lo[1]) = r[1];
    }
};
template <bool PAIRED, class AL>
__device__ __forceinline__ void gemm_mainloop(int tid, char* smem, AL& al, BLoad& bl, int nkt, f32x4 (&acc)[4][4]) {
    const int lane = tid & 63, wid = tid >> 6, wr = wid >> 1, wc = wid & 1, fr = lane & 15, fq = lane >> 4;
#pragma unroll
    for (int a = 0; a < 4; ++a)
#pragma unroll
        for (int b = 0; b < 4; ++b) acc[a][b] = (f32x4){0.f, 0.f, 0.f, 0.f};
    char* As = smem; char* Bs = smem + 2 * A_STAGE;
    al.issue(0); bl.issue(0);
    al.commit(As); bl.commit(Bs);
    __syncthreads();
    for (int kt = 0; kt < nkt; ++kt) {
        const int cur = kt & 1;
        if (kt + 1 < nkt) { al.issue(kt + 1); bl.issue(kt + 1); }
        const char* Ac = As + cur * A_STAGE; const char* Bc = Bs + cur * B_STAGE;
#pragma unroll
        for (int ks = 0; ks < 2; ++ks) {
            bf16x8 af[4], bfr[4];
#pragma unroll
            for (int mf = 0; mf < 4; ++mf) af[mf] = *(const bf16x8*)(Ac + lds_off(wr * 64 + mf * 16 + fr, ks * 32 + fq * 8));
#pragma unroll
            for (int nf = 0; nf < 4; ++nf) {
                const int br = PAIRED ? ((nf >> 1) * 64 + wc * 32 + (nf & 1) * 16) : (wc * 64 + nf * 16);
                bfr[nf] = *(const bf16x8*)(Bc + lds_off(br + fr, ks * 32 + fq * 8));
            }
#pragma unroll
            for (int mf = 0; mf < 4; ++mf)
#pragma unroll
                for (int nf = 0; nf < 4; ++nf) acc[mf][nf] = __builtin_amdgcn_mfma_f32_16x16x32_bf16(bfr[nf], af[mf], acc[mf][nf], 0, 0, 0);
        }
        if (kt + 1 < nkt) { al.commit(As + (cur ^ 1) * A_STAGE); bl.commit(Bs + (cur ^ 1) * B_STAGE); }
        __syncthreads();
    }
}

__device__ __forceinline__ void gdn_in_phase(CParams& p, int j, char* smem) {
    const int tid = otid(), lane = tid & 63, wid = tid >> 6, wr = wid >> 1, wc = wid & 1, fr = lane & 15, fq = lane >> 4;
    const int nMt = MPAD / 256, nNt = GIN_NP / 128;
    const bf16_t* Bt = p.w_in_t + (size_t)j * GIN_NP * D;
    for (int u = obid(); u < nMt * nNt; u += ogrid()) {
        const int nt = u / nMt, mt = u - nt * nMt, m0 = mt * 256, n0 = nt * 128;
        ALoadPlain al; al.init(tid, p.HN, D, m0, MPAD - 1);
        BLoad bl; bl.init(tid, Bt + (size_t)n0 * D, Bt + (size_t)(n0 + 64) * D, D);
        f32x4 acc[4][4];
        gemm_mainloop<false>(tid, smem, al, bl, D / 64, acc);
#pragma unroll
        for (int mf = 0; mf < 4; ++mf) {
            const int m = m0 + wr * 64 + mf * 16 + fr;
            if (n0 < GIN_LD) {
#pragma unroll
                for (int nf = 0; nf < 4; ++nf) {
                    const int n = n0 + wc * 64 + nf * 16 + 4 * fq;
                    u32x2 w; w.x = pack2(acc[mf][nf][0], acc[mf][nf][1]); w.y = pack2(acc[mf][nf][2], acc[mf][nf][3]);
                    *(u32x2*)(p.RA + (size_t)m * GIN_LD + n) = w;
                }
            } else if (wc == 0) {
                *(f32x4*)(p.AB + (size_t)m * 16 + 4 * fq) = acc[mf][0];
            }
        }
    }
}
__device__ __forceinline__ void res_gemm_phase(CParams& p, const bf16_t* A, int K, const bf16_t* Bt, char* smem) {
    const int tid = otid(), lane = tid & 63, wid = tid >> 6, wr = wid >> 1, wc = wid & 1, fr = lane & 15, fq = lane >> 4;
    const int nMt = MPAD / 256, nNt = D / 128;
    for (int u = obid(); u < nMt * nNt; u += ogrid()) {
        const int nt = u / nMt, mt = u - nt * nMt, m0 = mt * 256, n0 = nt * 128;
        ALoadPlain al; al.init(tid, A, K, m0, MPAD - 1);
        BLoad bl; bl.init(tid, Bt + (size_t)n0 * K, Bt + (size_t)(n0 + 64) * K, K);
        f32x4 acc[4][4];
        gemm_mainloop<false>(tid, smem, al, bl, K / 64, acc);
#pragma unroll
        for (int mf = 0; mf < 4; ++mf) {
            const int m = m0 + wr * 64 + mf * 16 + fr;
#pragma unroll
            for (int nf = 0; nf < 4; ++nf) {
                f32x4* xp = (f32x4*)(p.X + (size_t)m * D + n0 + wc * 64 + nf * 16 + 4 * fq);
                *xp = *xp + acc[mf][nf];
            }
        }
    }
}

__device__ __forceinline__ void ffn_up_phase(CParams& p, int layer, char* smem) {
    const int tid = otid(), lane = tid & 63, wid = tid >> 6, wr = wid >> 1, wc = wid & 1, fr = lane & 15, fq = lane >> 4;
    const int nMt = 68, nNt = DFF / 64;
    const bf16_t* Bt = p.up_t + (size_t)layer * (2 * DFF) * D;
    const float* cw = p.ffn_conv_w + (size_t)layer * 3 * DFF;
    bf16_t* H = p.RA;
    float* Gs = (float*)smem;
    for (int u = obid(); u < nMt * nNt; u += ogrid()) {
        const int nt = u / nMt, mt = u - nt * nMt, mfirst = 254 * mt - 2, n0 = nt * 64;
        ALoadPlain al; al.init(tid, p.HN, D, mfirst, MPAD - 1);
        BLoad bl; bl.init(tid, Bt + (size_t)n0 * D, Bt + (size_t)(DFF + n0) * D, D);
        f32x4 acc[4][4];
        gemm_mainloop<true>(tid, smem, al, bl, D / 64, acc);
#pragma unroll
        for (int mf = 0; mf < 4; ++mf) {
            const int r = wr * 64 + mf * 16 + fr;
#pragma unroll
            for (int nf = 0; nf < 2; ++nf) *(f32x4*)(Gs + r * 68 + wc * 32 + nf * 16 + 4 * fq) = acc[mf][nf];
        }
        __syncthreads();
#pragma unroll
        for (int mf = 0; mf < 4; ++mf) {
            const int r = wr * 64 + mf * 16 + fr, m = mfirst + r;
            if (r >= 2 && m < T) {
                int seq, t, L; tokdec(m, seq, t, L);
#pragma unroll
                for (int nf = 0; nf < 2; ++nf) {
                    const int c = wc * 32 + nf * 16 + 4 * fq, ff = n0 + c;
                    const f32x4 g0 = acc[mf][nf], up = acc[mf][nf + 2];
                    f32x4 g1, g2;
                    if (t >= 2) { g1 = *(const f32x4*)(Gs + (r - 1) * 68 + c); g2 = *(const f32x4*)(Gs + (r - 2) * 68 + c); }
                    else {
                        f32x4 b0 = {0.f, 0.f, 0.f, 0.f}, b1 = {0.f, 0.f, 0.f, 0.f};
                        if (seq >= 8) {
                            const float* sb = p.st_fC + (((size_t)layer * 128 + (seq - 8)) * 2) * DFF + ff;
                            b0 = *(const f32x4*)sb; b1 = *(const f32x4*)(sb + DFF);
                        }
                        if (t == 0) { g1 = b1; g2 = b0; } else { g1 = *(const f32x4*)(Gs + (r - 1) * 68 + c); g2 = b1; }
                    }
                    const f32x4 w0 = *(const f32x4*)(cw + ff), w1 = *(const f32x4*)(cw + DFF + ff), w2 = *(const f32x4*)(cw + 2 * DFF + ff);
                    f32x4 cv = w0 * g2 + w1 * g1 + w2 * g0;
                    float h0 = siluf_(cv[0]) * up[0], h1 = siluf_(cv[1]) * up[1], h2 = siluf_(cv[2]) * up[2], h3 = siluf_(cv[3]) * up[3];
                    u32x2 w; w.x = pack2(h0, h1); w.y = pack2(h2, h3);
                    *(u32x2*)(H + (size_t)m * DFF + ff) = w;
                    if (t >= L - 2) {
                        float* o = (seq < 8) ? p.fC_p + (((size_t)layer * 8 + seq) * 2 + (t - (L - 2))) * DFF + ff
                                             : p.fC_s + (((size_t)layer * 128 + (seq - 8)) * 2 + (t - (L - 2))) * DFF + ff;
                        *(f32x4*)o = g0;
                    }
                }
            }
        }
        __syncthreads();
    }
}

__device__ __forceinline__ void rwkv_in_phase(CParams& p, int j, char* smem) {
    const int tid = otid(), lane = tid & 63, wid = tid >> 6, wr = wid >> 1, wc = wid & 1, fr = lane & 15, fq = lane >> 4;
    const int nMt = MPAD / 256, nNt = R1_N / 128;
    const bf16_t* Bt = p.rwkv1_t + (size_t)j * R1_N * D;
    bf16_t* C1 = p.RA;
    for (int u = obid(); u < nMt * nNt; u += ogrid()) {
        const int nt = u / nMt, mt = u - nt * nMt, m0 = mt * 256, n0 = nt * 128;
        const int msel = nt < 8 ? 0 : nt < 16 ? 2 : nt < 24 ? 3 : nt == 24 ? 1 : nt == 25 ? 4 : nt < 28 ? 5 : 3;
        ALoadMix al; al.init(tid, p, p.rwkv_mix + ((size_t)j * 6 + msel) * D, m0);
        BLoad bl; bl.init(tid, Bt + (size_t)n0 * D, Bt + (size_t)(n0 + 64) * D, D);
        f32x4 acc[4][4];
        gemm_mainloop<false>(tid, smem, al, bl, D / 64, acc);
        const int act = nt == 24 ? 1 : (nt == 26 || nt == 27) ? 2 : 0;
#pragma unroll
        for (int mf = 0; mf < 4; ++mf) {
            const int m = m0 + wr * 64 + mf * 16 + fr;
#pragma unroll
            for (int nf = 0; nf < 4; ++nf) {
                const int n = n0 + wc * 64 + nf * 16 + 4 * fq;
                f32x4 v = acc[mf][nf];
                if (act == 1) { v[0] = tanhf(v[0]); v[1] = tanhf(v[1]); v[2] = tanhf(v[2]); v[3] = tanhf(v[3]); }
                else if (act == 2) { v[0] = sigmoidf_(v[0]); v[1] = sigmoidf_(v[1]); v[2] = sigmoidf_(v[2]); v[3] = sigmoidf_(v[3]); }
                u32x2 w; w.x = pack2(v[0], v[1]); w.y = pack2(v[2], v[3]);
                *(u32x2*)(C1 + (size_t)m * R1_N + n) = w;
                if (j == 0 && nt >= 16 && nt < 24) *(u32x2*)(p.VFIRST + (size_t)m * D + (n - 2048)) = w;
            }
        }
    }
}
__device__ __forceinline__ void rwkv_lora_phase(CParams& p, int j, char* smem) {
    const int tid = otid(), lane = tid & 63, wid = tid >> 6, wr = wid >> 1, wc = wid & 1, fr = lane & 15, fq = lane >> 4;
    const int nMt = MPAD / 256, nNt = 8, ngrp = (j == 0) ? 3 : 4;
    const bf16_t* C1 = p.RA;
    for (int u = obid(); u < nMt * nNt * ngrp; u += ogrid()) {
        const int grp = u / (nMt * nNt), r = u - grp * nMt * nNt, nt = r / nMt, mt = r - nt * nMt, m0 = mt * 256, n0 = nt * 128;
        const int acol = grp == 0 ? 3072 : grp == 1 ? 3200 : grp == 2 ? 3328 : 3584;
        const int K = grp == 2 ? 192 : 64;
        const bf16_t* Bt = grp == 0 ? p.w2t + (size_t)j * D * 64 : grp == 1 ? p.a2t + (size_t)j * D * 64 : grp == 2 ? p.g2t + (size_t)j * D * 192 : p.v2t;
        ALoadPlain al; al.init(tid, C1 + acol, R1_N, m0, MPAD - 1);
        BLoad bl; bl.init(tid, Bt + (size_t)n0 * K, Bt + (size_t)(n0 + 64) * K, K);
        f32x4 acc[4][4];
        gemm_mainloop<false>(tid, smem, al, bl, K / 64, acc);
        bf16_t* O = (bf16_t*)(p.RB + (size_t)grp * MPAD * D * 2);
        const float* bias = grp == 0 ? p.rwkv_w0 + (size_t)j * D : grp == 1 ? p.rwkv_a0 + (size_t)j * D : grp == 3 ? p.rwkv_v0 : nullptr;
#pragma unroll
        for (int mf = 0; mf < 4; ++mf) {
            const int m = m0 + wr * 64 + mf * 16 + fr;
#pragma unroll
            for (int nf = 0; nf < 4; ++nf) {
                const int n = n0 + wc * 64 + nf * 16 + 4 * fq;
                f32x4 v = acc[mf][nf];
                if (bias) v = v + *(const f32x4*)(bias + n);
                if (grp != 2) { v[0] = sigmoidf_(v[0]); v[1] = sigmoidf_(v[1]); v[2] = sigmoidf_(v[2]); v[3] = sigmoidf_(v[3]); }
                if (grp == 0) v = v * 0.60653066f;
                u32x2 w; w.x = pack2(v[0], v[1]); w.y = pack2(v[2], v[3]);
                *(u32x2*)(O + (size_t)m * D + n) = w;
            }
        }
    }
}

__device__ __forceinline__ void gdn_prep_phase(CParams& p, int j, char* smem) {
    const int tid = otid(), lane = tid & 63, wid = tid >> 6, fr = lane & 15, fq = lane >> 4;
    bf16_t* qs = (bf16_t*)smem;
    bf16_t* ks = (bf16_t*)(smem + 17408);
    float* rhs = (float*)(smem + 34816);
    float* Am = (float*)(smem + 100352);
    float* Gs = (float*)(smem + 117760);
    float* betas = (float*)(smem + 118016);
    float* gs = (float*)(smem + 118272);
    const bf16_t* PROJ = p.RA;
    const int c8 = tid & 15, rg = tid >> 4, r0 = 2 * rg;
    for (int item = obid(); item < 64 * NCHUNK; item += ogrid()) {
        const int n = item % NCHUNK, bh = item / NCHUNK, h = bh & 7, b = bh >> 3;
        const int c = (n == 0) ? 16 : 64, tstart = (n == 0) ? 0 : 16 + 64 * (n - 1);
        const int mbase = b * LP + tstart;
        char* rec = p.RB + (size_t)item * CH_BYTES;
        const float Aexp = __expf(p.gdn_A_log[j * 8 + h]), dtb = p.gdn_dt_bias[j * 8 + h];
        float qkv[3][2][8];
#pragma unroll
        for (int part = 0; part < 3; ++part) {
            const int col = part * 1024 + h * 128 + c8 * 8;
            float raw[5][8];
#pragma unroll
            for (int i = 0; i < 5; ++i) {
                const int r = r0 - 3 + i, t = tstart + r;
                u32x4 v = {0u, 0u, 0u, 0u};
                if (t >= 0 && r < c) v = *(const u32x4*)(PROJ + (size_t)(b * LP + t) * GIN_LD + col);
#pragma unroll
                for (int q = 0; q < 4; ++q) { raw[i][2 * q] = lo16(v[q]); raw[i][2 * q + 1] = hi16(v[q]); }
            }
            float o[2][8];
#pragma unroll
            for (int e = 0; e < 8; ++e) { o[0][e] = 0.f; o[1][e] = 0.f; }
#pragma unroll
            for (int jj = 0; jj < 4; ++jj) {
                const float* cw = p.gdn_conv_w + ((size_t)j * 4 + jj) * 3072 + col;
                const f32x4 w0 = *(const f32x4*)cw, w1 = *(const f32x4*)(cw + 4);
#pragma unroll
                for (int e = 0; e < 8; ++e) { const float w = e < 4 ? w0[e] : w1[e - 4]; o[0][e] += w * raw[jj][e]; o[1][e] += w * raw[jj + 1][e]; }
            }
#pragma unroll
            for (int rr = 0; rr < 2; ++rr)
#pragma unroll
                for (int e = 0; e < 8; ++e) qkv[part][rr][e] = (r0 + rr < c) ? siluf_(o[rr][e]) : 0.f;
        }
        float bet[2], gg[2];
#pragma unroll
        for (int rr = 0; rr < 2; ++rr) {
            const int r = r0 + rr;
            if (r < c) {
                const float av = p.AB[(size_t)(mbase + r) * 16 + h], bv = p.AB[(size_t)(mbase + r) * 16 + 8 + h];
                gg[rr] = -Aexp * softplusf_(av + dtb); bet[rr] = sigmoidf_(bv);
            } else { gg[rr] = 0.f; bet[rr] = 0.f; }
            float sq = 0.f, sk = 0.f;
#pragma unroll
            for (int e = 0; e < 8; ++e) { sq += qkv[0][rr][e] * qkv[0][rr][e]; sk += qkv[1][rr][e] * qkv[1][rr][e]; }
            sq = row16_sum(sq); sk = row16_sum(sk);
            const float rq = rsqrtf(sq + 1e-6f) * 0.08838834764831845f, rk = rsqrtf(sk + 1e-6f);
#pragma unroll
            for (int e = 0; e < 8; ++e) { qkv[0][rr][e] *= rq; qkv[1][rr][e] *= rk; }
            u32x4 wq, wk;
#pragma unroll
            for (int q = 0; q < 4; ++q) { wq[q] = pack2(qkv[0][rr][2 * q], qkv[0][rr][2 * q + 1]); wk[q] = pack2(qkv[1][rr][2 * q], qkv[1][rr][2 * q + 1]); }
            *(u32x4*)(qs + r * 136 + c8 * 8) = wq;
            *(u32x4*)(ks + r * 136 + c8 * 8) = wk;
            f32x4 v0, v1;
#pragma unroll
            for (int e = 0; e < 4; ++e) { v0[e] = qkv[2][rr][e] * bet[rr]; v1[e] = qkv[2][rr][e + 4] * bet[rr]; }
            *(f32x4*)(rhs + r * 256 + c8 * 8) = v0; *(f32x4*)(rhs + r * 256 + c8 * 8 + 4) = v1;
            if (c8 == 0) { gs[r] = gg[rr]; betas[r] = bet[rr]; }
        }
        __syncthreads();
        if (wid == 0) {
            float x = gs[lane];
#pragma unroll
            for (int o = 1; o < 64; o <<= 1) { const float y = __shfl_up(x, o); if (lane >= o) x += y; }
            Gs[lane] = x;
        }
        __syncthreads();
        const float glast = Gs[63];
#pragma unroll
        for (int rr = 0; rr < 2; ++rr) {
            const int r = r0 + rr; const float eg = __expf(Gs[r]);
            f32x4 v0, v1;
#pragma unroll
            for (int e = 0; e < 4; ++e) { v0[e] = qkv[1][rr][e] * bet[rr] * eg; v1[e] = qkv[1][rr][e + 4] * bet[rr] * eg; }
            *(f32x4*)(rhs + r * 256 + 128 + c8 * 8) = v0; *(f32x4*)(rhs + r * 256 + 128 + c8 * 8 + 4) = v1;
            u32x4 wq;
#pragma unroll
            for (int q = 0; q < 4; ++q) wq[q] = pack2(qkv[0][rr][2 * q] * eg, qkv[0][rr][2 * q + 1] * eg);
            *(u32x4*)(rec + 32768 + ((size_t)r * 128 + c8 * 8) * 2) = wq;
        }
        {
            const int mat = wid >> 2, ifr = wid & 3;
            const bf16_t* Xs = mat ? qs : ks;
            f32x4 acc[4];
#pragma unroll
            for (int jf = 0; jf < 4; ++jf) acc[jf] = (f32x4){0.f, 0.f, 0.f, 0.f};
#pragma unroll
            for (int kk = 0; kk < 4; ++kk) {
                const bf16x8 xf = *(const bf16x8*)(Xs + (ifr * 16 + fr) * 136 + kk * 32 + fq * 8);
#pragma unroll
                for (int jf = 0; jf < 4; ++jf) {
                    if (jf <= ifr) {
                        const bf16x8 yf = *(const bf16x8*)(ks + (jf * 16 + fr) * 136 + kk * 32 + fq * 8);
                        acc[jf] = __builtin_amdgcn_mfma_f32_16x16x32_bf16(xf, yf, acc[jf], 0, 0, 0);
                    }
                }
            }
#pragma unroll
            for (int jf = 0; jf < 4; ++jf) {
                const int jc = jf * 16 + fr; const float Gj = Gs[jc];
#pragma unroll
                for (int reg = 0; reg < 4; ++reg) {
                    const int i = ifr * 16 + 4 * fq + reg;
                    const float dec = __expf(Gs[i] - Gj);
                    if (mat == 0) { Am[i * 68 + jc] = (i > jc) ? betas[i] * acc[jf][reg] * dec : 0.f; }
                    else { const float v = (i >= jc) ? acc[jf][reg] * dec : 0.f; *(bf16_t*)(rec + 65536 + ((size_t)i * 64 + jc) * 2) = (bf16_t)f2bf(v); }
                }
            }
        }
        __syncthreads();
        {
            const int k = tid >> 2, jq = tid & 3;
            u32x4 o0, o1;
#pragma unroll
            for (int e = 0; e < 8; ++e) {
                const int ja = jq * 16 + 2 * e, jb = ja + 1;
                const float va = bf2f(ks[ja * 136 + k]) * __expf(glast - Gs[ja]), vb = bf2f(ks[jb * 136 + k]) * __expf(glast - Gs[jb]);
                if (e < 4) o0[e] = pack2(va, vb); else o1[e - 4] = pack2(va, vb);
            }
            *(u32x4*)(rec + 49152 + ((size_t)k * 64 + jq * 16) * 2) = o0;
            *(u32x4*)(rec + 49152 + ((size_t)k * 64 + jq * 16 + 8) * 2) = o1;
        }
        if (tid == 0) p.GL[item] = __expf(glast);
        if (tid < 256) {
            float x[64];
#pragma unroll
            for (int i = 0; i < 64; ++i) {
                float s = rhs[i * 256 + tid];
#pragma unroll
                for (int j4 = 0; j4 < i; j4 += 4) {
                    const f32x4 a = *(const f32x4*)(Am + i * 68 + j4);
                    s -= a[0] * x[j4];
                    if (j4 + 1 < i) s -= a[1] * x[j4 + 1];
                    if (j4 + 2 < i) s -= a[2] * x[j4 + 2];
                    if (j4 + 3 < i) s -= a[3] * x[j4 + 3];
                }
                x[i] = s;
            }
            if (tid < 128) {
#pragma unroll
                for (int q = 0; q < 8; ++q) {
                    u32x4 o;
#pragma unroll
                    for (int e = 0; e < 4; ++e) o[e] = pack2(x[q * 8 + 2 * e], x[q * 8 + 2 * e + 1]);
                    *(u32x4*)(rec + ((size_t)tid * 64 + q * 8) * 2) = o;
                }
            } else {
                const int k = tid - 128;
#pragma unroll
                for (int i = 0; i < 64; ++i) *(bf16_t*)(rec + 16384 + ((size_t)i * 128 + k) * 2) = (bf16_t)f2bf(-x[i]);
            }
        }
        if (n == NCHUNK - 1) {
            for (int idx = tid; idx < 3 * 3 * 128; idx += NTH) {
                const int cc = idx & 127, part = (idx >> 7) % 3, r = idx / 384;
                const int col = part * 1024 + h * 128 + cc;
                p.gC_p[(((size_t)j * 8 + b) * 3 + r) * 3072 + col] = bf2f(PROJ[(size_t)(b * LP + LP - 3 + r) * GIN_LD + col]);
            }
        }
        __syncthreads();
    }
}

__device__ __forceinline__ bf16x8 xfrag(const char* base, int row, int stride, int kbase, int fq) {
    const u32x2 a = *(const u32x2*)(base + row * stride + (kbase + 4 * fq) * 2);
    const u32x2 b = *(const u32x2*)(base + row * stride + (kbase + 16 + 4 * fq) * 2);
    u32x4 r; r.x = a.x; r.y = a.y; r.z = b.x; r.w = b.y;
    return __builtin_bit_cast(bf16x8, r);
}
__device__ __forceinline__ bf16x8 pack8(const f32x4& a, const f32x4& b) {
    u32x4 r; r.x = pack2(a[0], a[1]); r.y = pack2(a[2], a[3]); r.z = pack2(b[0], b[1]); r.w = pack2(b[2], b[3]);
    return __builtin_bit_cast(bf16x8, r);
}
__device__ __forceinline__ void gdn_scan_prompt_item(CParams& p, int j, int bh, char* smem) {
    const int tid = otid(), lane = tid & 63, wid = tid >> 6, fr = lane & 15, fq = lane >> 4;
    const int h = bh & 7, b = bh >> 3, v0 = 16 * wid;
    char* UT = smem; char* WN = smem + 18432; char* QG = smem + 35840; char* KDT = smem + 53248; char* QKM = smem + 71680;
    float* OT = (float*)(smem + 80896);
    const bf16_t* PROJ = p.RA; bf16_t* OG = p.HN;
    f32x4 S[8];
#pragma unroll
    for (int kf = 0; kf < 8; ++kf) S[kf] = (f32x4){0.f, 0.f, 0.f, 0.f};
    const int cv = tid & 15, orow = tid >> 4;
    const f32x4 nw0 = *(const f32x4*)(p.gdn_norm_w + j * 128 + cv * 8), nw1 = *(const f32x4*)(p.gdn_norm_w + j * 128 + cv * 8 + 4);
    u32x4 pre[9], zpre[2];
    const char* rec0 = p.RB + (size_t)(bh * NCHUNK) * CH_BYTES;
#pragma unroll
    for (int i = 0; i < 9; ++i) pre[i] = *(const u32x4*)(rec0 + (size_t)(tid + 512 * i) * 16);
    float gl_pre = p.GL[bh * NCHUNK];
    for (int n = 0; n < NCHUNK; ++n) {
#pragma unroll
        for (int i = 0; i < 9; ++i) {
            const int idx = tid + 512 * i;
            char* dst;
            if (i < 2) { const int li = idx; dst = UT + (li >> 3) * 144 + (li & 7) * 16; }
            else if (i < 4) { const int li = idx - 1024; dst = WN + (li >> 4) * 272 + (li & 15) * 16; }
            else if (i < 6) { const int li = idx - 2048; dst = QG + (li >> 4) * 272 + (li & 15) * 16; }
            else if (i < 8) { const int li = idx - 3072; dst = KDT + (li >> 3) * 144 + (li & 7) * 16; }
            else { const int li = idx - 4096; dst = QKM + (li >> 3) * 144 + (li & 7) * 16; }
            *(u32x4*)dst = pre[i];
        }
        const float gl = gl_pre;
        __syncthreads();
        const int c = (n == 0) ? 16 : 64, tstart = (n == 0) ? 0 : 16 + 64 * (n - 1);
        if (n + 1 < NCHUNK) {
            const char* recn = rec0 + (size_t)(n + 1) * CH_BYTES;
#pragma unroll
            for (int i = 0; i < 9; ++i) pre[i] = *(const u32x4*)(recn + (size_t)(tid + 512 * i) * 16);
            gl_pre = p.GL[bh * NCHUNK + n + 1];
        }
#pragma unroll
        for (int q = 0; q < 2; ++q) {
            const int i = orow + 32 * q;
            const size_t m = (size_t)b * LP + tstart + (i < c ? i : 0);
            zpre[q] = *(const u32x4*)(PROJ + m * GIN_LD + 3072 + h * 128 + cv * 8);
        }
        bf16x8 Sb[4];
#pragma unroll
        for (int ks = 0; ks < 4; ++ks) Sb[ks] = pack8(S[2 * ks], S[2 * ks + 1]);
        f32x4 vn[4], o[4];
#pragma unroll
        for (int f = 0; f < 4; ++f) {
            const u32x2 raw = *(const u32x2*)(UT + (v0 + fr) * 144 + (16 * f + 4 * fq) * 2);
            vn[f] = (f32x4){lo16(raw.x), hi16(raw.x), lo16(raw.y), hi16(raw.y)};
            o[f] = (f32x4){0.f, 0.f, 0.f, 0.f};
        }
#pragma unroll
        for (int ks = 0; ks < 4; ++ks)
#pragma unroll
            for (int f = 0; f < 4; ++f) {
                vn[f] = __builtin_amdgcn_mfma_f32_16x16x32_bf16(xfrag(WN, 16 * f + fr, 272, 32 * ks, fq), Sb[ks], vn[f], 0, 0, 0);
                o[f] = __builtin_amdgcn_mfma_f32_16x16x32_bf16(xfrag(QG, 16 * f + fr, 272, 32 * ks, fq), Sb[ks], o[f], 0, 0, 0);
            }
        bf16x8 Vb[2];
        Vb[0] = pack8(vn[0], vn[1]); Vb[1] = pack8(vn[2], vn[3]);
#pragma unroll
        for (int js = 0; js < 2; ++js)
#pragma unroll
            for (int f = 0; f < 4; ++f) o[f] = __builtin_amdgcn_mfma_f32_16x16x32_bf16(xfrag(QKM, 16 * f + fr, 144, 32 * js, fq), Vb[js], o[f], 0, 0, 0);
#pragma unroll
        for (int f = 0; f < 4; ++f)
#pragma unroll
            for (int reg = 0; reg < 4; ++reg) OT[(16 * f + 4 * fq + reg) * 132 + v0 + fr] = o[f][reg];
#pragma unroll
        for (int kf = 0; kf < 8; ++kf) {
            S[kf] = S[kf] * gl;
#pragma unroll
            for (int js = 0; js < 2; ++js) S[kf] = __builtin_amdgcn_mfma_f32_16x16x32_bf16(xfrag(KDT, 16 * kf + fr, 144, 32 * js, fq), Vb[js], S[kf], 0, 0, 0);
        }
        __syncthreads();
#pragma unroll
        for (int q = 0; q < 2; ++q) {
            const int i = orow + 32 * q;
            const f32x4 a0 = *(const f32x4*)(OT + i * 132 + cv * 8), a1 = *(const f32x4*)(OT + i * 132 + cv * 8 + 4);
            float ss = a0[0] * a0[0] + a0[1] * a0[1] + a0[2] * a0[2] + a0[3] * a0[3] + a1[0] * a1[0] + a1[1] * a1[1] + a1[2] * a1[2] + a1[3] * a1[3];
            ss = row16_sum(ss);
            const float rstd = rsqrtf(ss * (1.f / 128.f) + 1e-6f);
            if (i < c) {
                const u32x4 z = zpre[q];
                u32x4 w;
                w.x = pack2(a0[0] * rstd * nw0[0] * siluf_(lo16(z.x)), a0[1] * rstd * nw0[1] * siluf_(hi16(z.x)));
                w.y = pack2(a0[2] * rstd * nw0[2] * siluf_(lo16(z.y)), a0[3] * rstd * nw0[3] * siluf_(hi16(z.y)));
                w.z = pack2(a1[0] * rstd * nw1[0] * siluf_(lo16(z.z)), a1[1] * rstd * nw1[1] * siluf_(hi16(z.z)));
                w.w = pack2(a1[2] * rstd * nw1[2] * siluf_(lo16(z.w)), a1[3] * rstd * nw1[3] * siluf_(hi16(z.w)));
                const size_t m = (size_t)b * LP + tstart + i;
                *(u32x4*)(OG + m * D + h * 128 + cv * 8) = w;
            }
        }
    }
    float* So = p.gS_p + (((size_t)j * 8 + b) * 8 + h) * 16384;
#pragma unroll
    for (int kf = 0; kf < 8; ++kf)
#pragma unroll
        for (int reg = 0; reg < 4; ++reg) So[(size_t)(16 * kf + 4 * fq + reg) * 128 + v0 + fr] = S[kf][reg];
    __syncthreads();
}
__device__ __forceinline__ void gdn_sample_item(CParams& p, int j, int item, char* smem) {
    const int tid = otid(), lane = tid & 63, wid = tid >> 6;
    const int h = item & 7, b = item >> 3;
    float* qn = (float*)smem;
    float* kn = qn + 512;
    float* vv = kn + 512;
    float* gb = vv + 512;
    float* wred = gb + 8;
    float* red = wred + 24;
    float* osum = red + 2048;
    const bf16_t* PROJ = p.RA; bf16_t* OG = p.HN;
    const int mbase = TP + b * 4;
    {
        const int t = tid >> 7, c = tid & 127;
        float val[3];
#pragma unroll
        for (int part = 0; part < 3; ++part) {
            const int col = part * 1024 + h * 128 + c;
            float acc = 0.f;
#pragma unroll
            for (int jj = 0; jj < 4; ++jj) {
                const int xi = t + jj;
                const float x = xi < 3 ? p.st_gC[(((size_t)j * 128 + b) * 3 + xi) * 3072 + col] : bf2f(PROJ[(size_t)(mbase + xi - 3) * GIN_LD + col]);
                acc += p.gdn_conv_w[((size_t)j * 4 + jj) * 3072 + col] * x;
            }
            val[part] = siluf_(acc);
        }
        float sq = wave_sum(val[0] * val[0]), sk = wave_sum(val[1] * val[1]);
        if (lane == 0) { wred[wid * 2] = sq; wred[wid * 2 + 1] = sk; }
        __syncthreads();
        sq = wred[(2 * t) * 2] + wred[(2 * t + 1) * 2]; sk = wred[(2 * t) * 2 + 1] + wred[(2 * t + 1) * 2 + 1];
        qn[t * 128 + c] = val[0] * rsqrtf(sq + 1e-6f) * 0.08838834764831845f;
        kn[t * 128 + c] = val[1] * rsqrtf(sk + 1e-6f);
        vv[t * 128 + c] = val[2];
        if (tid < 4) {
            const float av = p.AB[(size_t)(mbase + tid) * 16 + h], bv = p.AB[(size_t)(mbase + tid) * 16 + 8 + h];
            gb[tid] = -__expf(p.gdn_A_log[j * 8 + h]) * softplusf_(av + p.gdn_dt_bias[j * 8 + h]);
            gb[4 + tid] = sigmoidf_(bv);
        }
    }
    for (int idx = tid; idx < 3 * 3 * 128; idx += NTH) {
        const int cc = idx & 127, part = (idx >> 7) % 3, r = idx / 384;
        const int col = part * 1024 + h * 128 + cc;
        p.gC_s[(((size_t)j * 128 + b) * 3 + r) * 3072 + col] = bf2f(PROJ[(size_t)(mbase + 1 + r) * GIN_LD + col]);
    }
    const int v4 = (tid & 31) * 4, ks = tid >> 5;
    const float* Sin = p.st_gS + (((size_t)j * 128 + b) * 8 + h) * 16384;
    f32x4 S[8];
#pragma unroll
    for (int q = 0; q < 8; ++q) S[q] = *(const f32x4*)(Sin + (size_t)(ks * 8 + q) * 128 + v4);
    __syncthreads();
    for (int t = 0; t < 4; ++t) {
        const float a = __expf(gb[t]), beta = gb[4 + t];
        f32x4 part = {0.f, 0.f, 0.f, 0.f};
#pragma unroll
        for (int q = 0; q < 8; ++q) { S[q] = S[q] * a; part = part + S[q] * kn[t * 128 + ks * 8 + q]; }
        *(f32x4*)(red + ks * 128 + v4) = part;
        __syncthreads();
        f32x4 r = *(const f32x4*)(vv + t * 128 + v4);
#pragma unroll
        for (int s = 0; s < 16; ++s) r = r - *(const f32x4*)(red + s * 128 + v4);
        r = r * beta;
        f32x4 op = {0.f, 0.f, 0.f, 0.f};
#pragma unroll
        for (int q = 0; q < 8; ++q) { S[q] = S[q] + r * kn[t * 128 + ks * 8 + q]; op = op + S[q] * qn[t * 128 + ks * 8 + q]; }
        __syncthreads();
        *(f32x4*)(red + ks * 128 + v4) = op;
        __syncthreads();
        if (tid < 128) { float s = 0.f;
#pragma unroll
            for (int q = 0; q < 16; ++q) s += red[q * 128 + tid];
            osum[t * 128 + tid] = s; }
        __syncthreads();
    }
    float* So = p.gS_s + (((size_t)j * 128 + b) * 8 + h) * 16384;
#pragma unroll
    for (int q = 0; q < 8; ++q) *(f32x4*)(So + (size_t)(ks * 8 + q) * 128 + v4) = S[q];
    {
        const int t = tid >> 7, c = tid & 127;
        const float ov = osum[t * 128 + c];
        float ss = wave_sum(ov * ov);
        if (lane == 0) wred[wid * 2] = ss;
        __syncthreads();
        ss = wred[(2 * t) * 2] + wred[(2 * t + 1) * 2];
        const float rstd = rsqrtf(ss * (1.f / 128.f) + 1e-6f);
        const size_t m = (size_t)mbase + t;
        const float z = bf2f(PROJ[m * GIN_LD + 3072 + h * 128 + c]);
        OG[m * D + h * 128 + c] = (bf16_t)f2bf(ov * rstd * p.gdn_norm_w[j * 128 + c] * siluf_(z));
    }
    __syncthreads();
}
__device__ __forceinline__ void gdn_scan_phase(CParams& p, int j, char* smem) {
    const int G = ogrid(), bid = obid();
    if (G > 64) {
        if (bid < 64) gdn_scan_prompt_item(p, j, bid, smem);
        else for (int it = bid - 64; it < 1024; it += G - 64) gdn_sample_item(p, j, it, smem);
    } else {
        for (int it = bid; it < 64; it += G) gdn_scan_prompt_item(p, j, it, smem);
        for (int it = bid; it < 1024; it += G) gdn_sample_item(p, j, it, smem);
    }
}

constexpr size_t RWB = (size_t)MPAD * D * 2;
constexpr int TOKF = 352;
__device__ __forceinline__ void rwkv_scan_item(CParams& p, int j, int item, char* smem) {
    const int tid = otid(), lane = tid & 63, wid = tid >> 6;
    const int half = item & 1, h = (item >> 1) & 15, seq = item >> 5;
    const int L = seq < 8 ? LP : 4, mbase = seq < 8 ? seq * LP : TP + (seq - 8) * 4;
    float* bufs = (float*)smem;
    float* ybuf = (float*)(smem + 2 * 32 * TOKF * 4);
    const bf16_t* C1 = p.RA;
    const bf16_t* E = (const bf16_t*)p.RB; const bf16_t* AA = (const bf16_t*)(p.RB + RWB); const bf16_t* VM = (const bf16_t*)(p.RB + 3 * RWB);
    bf16_t* YRAW = (bf16_t*)(p.RB + 4 * RWB);
    const int rw = wid * 4 + (lane >> 4), k4 = (lane & 15) * 4, vrow = half * 32 + rw;
    f32x4 S = {0.f, 0.f, 0.f, 0.f};
    if (seq >= 8) S = *(const f32x4*)(p.st_rS + ((((size_t)j * 128 + (seq - 8)) * 16 + h) * 64 + vrow) * 64 + k4);
    const int ptok = tid >> 4, c4 = (tid & 15) * 4, col = h * 64 + c4;
    const f32x4 kkv = *(const f32x4*)(p.rwkv_k_k + (size_t)j * D + col), kav = *(const f32x4*)(p.rwkv_k_a + (size_t)j * D + col);
    u32x2 rr_, rk_, rv_, re_, ra_, rm_, rf_;
    auto load_raw = [&](int ch) {
        int tk = ch * 32 + ptok; if (tk > L - 1) tk = L - 1;
        const size_t m = (size_t)mbase + tk;
        rr_ = *(const u32x2*)(C1 + m * R1_N + col); rk_ = *(const u32x2*)(C1 + m * R1_N + 1024 + col); rv_ = *(const u32x2*)(C1 + m * R1_N + 2048 + col);
        re_ = *(const u32x2*)(E + m * D + col); ra_ = *(const u32x2*)(AA + m * D + col);
        if (j == 1) { rm_ = *(const u32x2*)(VM + m * D + col); rf_ = *(const u32x2*)(p.VFIRST + m * D + col); }
    };
    auto prep_write = [&](float* buf) {
        f32x4 r = {lo16(rr_.x), hi16(rr_.x), lo16(rr_.y), hi16(rr_.y)};
        f32x4 k = {lo16(rk_.x), hi16(rk_.x), lo16(rk_.y), hi16(rk_.y)};
        f32x4 v = {lo16(rv_.x), hi16(rv_.x), lo16(rv_.y), hi16(rv_.y)};
        f32x4 e = {lo16(re_.x), hi16(re_.x), lo16(re_.y), hi16(re_.y)};
        f32x4 a = {lo16(ra_.x), hi16(ra_.x), lo16(ra_.y), hi16(ra_.y)};
        if (j == 1) {
            f32x4 vm = {lo16(rm_.x), hi16(rm_.x), lo16(rm_.y), hi16(rm_.y)};
            f32x4 vf = {lo16(rf_.x), hi16(rf_.x), lo16(rf_.y), hi16(rf_.y)};
            v = v + (vf - v) * vm;
        }
        f32x4 kkr = k * kkv;
        float ss = kkr[0] * kkr[0] + kkr[1] * kkr[1] + kkr[2] * kkr[2] + kkr[3] * kkr[3];
        ss = row16_sum(ss);
        const f32x4 kk = kkr * rsqrtf(ss + 1e-6f);
        f32x4 w; w[0] = __expf(-e[0]); w[1] = __expf(-e[1]); w[2] = __expf(-e[2]); w[3] = __expf(-e[3]);
        const f32x4 kf = k * (1.f + (a - 1.f) * kav);
        const f32x4 kka = kk * a;
        float* tb = buf + ptok * TOKF;
        *(f32x4*)(tb + c4) = w; *(f32x4*)(tb + 64 + c4) = kka; *(f32x4*)(tb + 128 + c4) = kf; *(f32x4*)(tb + 192 + c4) = kk; *(f32x4*)(tb + 256 + c4) = r;
        if ((c4 >> 5) == half) *(f32x4*)(tb + 320 + (c4 & 31)) = v;
    };
    const int nch = (L + 31) >> 5;
    load_raw(0);
    prep_write(bufs);
    __syncthreads();
    for (int ch = 0; ch < nch; ++ch) {
        if (ch + 1 < nch) load_raw(ch + 1);
        const float* buf = bufs + (ch & 1) * 32 * TOKF;
        float* yb = ybuf + (ch & 1) * 1024;
        const int nt = (L - ch * 32) < 32 ? (L - ch * 32) : 32;
        for (int t = 0; t < nt; ++t) {
            const float* tb = buf + t * TOKF;
            const f32x4 w = *(const f32x4*)(tb + k4), kka = *(const f32x4*)(tb + 64 + k4), kf = *(const f32x4*)(tb + 128 + k4);
            const f32x4 kk = *(const f32x4*)(tb + 192 + k4), r = *(const f32x4*)(tb + 256 + k4);
            const float vv = tb[320 + rw];
            float sa = S[0] * kk[0] + S[1] * kk[1] + S[2] * kk[2] + S[3] * kk[3];
            sa = row16_sum(sa);
            S = S * w + (kf * vv - kka * sa);
            float y = S[0] * r[0] + S[1] * r[1] + S[2] * r[2] + S[3] * r[3];
            y = row16_sum(y);
            if ((lane & 15) == 0) yb[t * 32 + rw] = y;
        }
        if (ch + 1 < nch) prep_write(bufs + ((ch + 1) & 1) * 32 * TOKF);
        __syncthreads();
        {
            const int tk = tid >> 4, r2 = (tid & 15) * 2;
            if (tk < nt) {
                const size_t m = (size_t)mbase + ch * 32 + tk;
                *(unsigned*)(YRAW + m * D + h * 64 + half * 32 + r2) = pack2(yb[tk * 32 + r2], yb[tk * 32 + r2 + 1]);
            }
        }
    }
    float* So = (seq < 8) ? p.rS_p + ((((size_t)j * 8 + seq) * 16 + h) * 64 + vrow) * 64 + k4
                          : p.rS_s + ((((size_t)j * 128 + (seq - 8)) * 16 + h) * 64 + vrow) * 64 + k4;
    *(f32x4*)So = S;
    __syncthreads();
}
__device__ __forceinline__ void rwkv_scan_phase(CParams& p, int j, char* smem) {
    for (int it = obid(); it < NSEQ * 32; it += ogrid()) rwkv_scan_item(p, j, it, smem);
}
__device__ __forceinline__ void rwkv_post_phase(CParams& p, int j) {
    const int tid = otid();
    const bf16_t* C1 = p.RA;
    const bf16_t* AA = (const bf16_t*)(p.RB + RWB); const bf16_t* GATE = (const bf16_t*)(p.RB + 2 * RWB); const bf16_t* VM = (const bf16_t*)(p.RB + 3 * RWB);
    const bf16_t* YRAW = (const bf16_t*)(p.RB + 4 * RWB);
    bf16_t* YG = p.HN;
    const int c4 = (tid & 15) * 4;
    for (int base = obid() * 32; base < T * 16; base += ogrid() * 32) {
        const int it = base + (tid >> 4), m = it >> 4, h = it & 15, col = h * 64 + c4;
        const size_t mm = (size_t)m;
        const u32x2 ry = *(const u32x2*)(YRAW + mm * D + col), rr = *(const u32x2*)(C1 + mm * R1_N + col), rk = *(const u32x2*)(C1 + mm * R1_N + 1024 + col);
        const u32x2 rv = *(const u32x2*)(C1 + mm * R1_N + 2048 + col), ra = *(const u32x2*)(AA + mm * D + col), rg = *(const u32x2*)(GATE + mm * D + col);
        f32x4 y = {lo16(ry.x), hi16(ry.x), lo16(ry.y), hi16(ry.y)};
        f32x4 r = {lo16(rr.x), hi16(rr.x), lo16(rr.y), hi16(rr.y)};
        f32x4 k = {lo16(rk.x), hi16(rk.x), lo16(rk.y), hi16(rk.y)};
        f32x4 v = {lo16(rv.x), hi16(rv.x), lo16(rv.y), hi16(rv.y)};
        f32x4 a = {lo16(ra.x), hi16(ra.x), lo16(ra.y), hi16(ra.y)};
        f32x4 g = {lo16(rg.x), hi16(rg.x), lo16(rg.y), hi16(rg.y)};
        if (j == 1) {
            const u32x2 rm = *(const u32x2*)(VM + mm * D + col), rf = *(const u32x2*)(p.VFIRST + mm * D + col);
            f32x4 vm = {lo16(rm.x), hi16(rm.x), lo16(rm.y), hi16(rm.y)};
            f32x4 vf = {lo16(rf.x), hi16(rf.x), lo16(rf.y), hi16(rf.y)};
            v = v + (vf - v) * vm;
        }
        const f32x4 kav = *(const f32x4*)(p.rwkv_k_a + (size_t)j * D + col), rkv = *(const f32x4*)(p.rwkv_r_k + (size_t)j * D + col);
        const f32x4 lw = *(const f32x4*)(p.rwkv_ln_w + (size_t)j * D + col), lb = *(const f32x4*)(p.rwkv_ln_b + (size_t)j * D + col);
        const f32x4 kf = k * (1.f + (a - 1.f) * kav);
        const float mu = row16_sum(y[0] + y[1] + y[2] + y[3]) * (1.f / 64.f);
        const f32x4 yc = y - mu;
        const float var = row16_sum(yc[0] * yc[0] + yc[1] * yc[1] + yc[2] * yc[2] + yc[3] * yc[3]) * (1.f / 64.f);
        const f32x4 t3 = r * kf * rkv;
        const float bon = row16_sum(t3[0] + t3[1] + t3[2] + t3[3]);
        const f32x4 o = (yc * rsqrtf(var + 64e-5f) * lw + lb + v * bon) * g;
        u32x2 w; w.x = pack2(o[0], o[1]); w.y = pack2(o[2], o[3]);
        *(u32x2*)(YG + mm * D + col) = w;
    }
}

__global__ void __launch_bounds__(NTH) mega_kernel(Params p_arg, int ph_begin, int ph_end) {
    extern __shared__ __attribute__((aligned(16))) char smem[];
#if !MULTI_LAUNCH
    cg::grid_group grid = cg::this_grid();
    volatile LAS unsigned* xst = (volatile LAS unsigned*)(smem + SMEM_BYTES - 16);
    if (threadIdx.x == 0) { xst[0] = 0u; xst[1] = 0u; }
    __syncthreads();
    XcdBarrier xb = xcd_barrier_post(p_arg.bar, xst);
#endif
    for (int ph = ph_begin; ph < ph_end; ++ph) {
        CParams* pp = (CParams*)__builtin_amdgcn_kernarg_segment_ptr();
        asm volatile("" : "+s"(pp));
        CParams& p = *pp;
        int type, layer; phase_info(ph, type, layer);
        const int j = layer >> 1;
        switch (type) {
#ifndef ONLY
#define ONLY -1
#endif
#define EN(t) (ONLY < 0 || ONLY == (t))
            case PH_PREP: if (EN(PH_PREP)) { prep_phase(p, smem); } break;
            case PH_NORM_MIX: if (EN(PH_NORM_MIX)) { norm_phase(p, layer, 0); } break;
            case PH_NORM_FFN: if (EN(PH_NORM_FFN)) { norm_phase(p, layer, 1); } break;
            case PH_FINAL: if (EN(PH_FINAL)) { norm_phase(p, 0, 2); } break;
            case PH_GDN_IN: if (EN(PH_GDN_IN)) { gdn_in_phase(p, j, smem); } break;
            case PH_GDN_PREP: if (EN(PH_GDN_PREP)) { gdn_prep_phase(p, j, smem); } break;
            case PH_GDN_SCAN: if (EN(PH_GDN_SCAN)) { gdn_scan_phase(p, j, smem); } break;
            case PH_GDN_OUT: if (EN(PH_GDN_OUT)) { res_gemm_phase(p, p.HN, D, p.w_out_t + (size_t)j * D * D, smem); } break;
            case PH_FFN_UP: if (EN(PH_FFN_UP)) { ffn_up_phase(p, layer, smem); } break;
            case PH_FFN_DOWN: if (EN(PH_FFN_DOWN)) { res_gemm_phase(p, p.RA, DFF, p.down_t + (size_t)layer * D * DFF, smem); } break;
            case PH_RWKV_IN: if (EN(PH_RWKV_IN)) { rwkv_in_phase(p, j, smem); } break;
            case PH_RWKV_LORA: if (EN(PH_RWKV_LORA)) { rwkv_lora_phase(p, j, smem); } break;
            case PH_RWKV_SCAN: if (EN(PH_RWKV_SCAN)) { rwkv_scan_phase(p, j, smem); } break;
            case PH_RWKV_POST: if (EN(PH_RWKV_POST)) { rwkv_post_phase(p, j); } break;
            case PH_RWKV_OUT: if (EN(PH_RWKV_OUT)) { res_gemm_phase(p, p.HN, D, p.wo_t + (size_t)j * D * D, smem); } break;
            default: break;
        }
#if !MULTI_LAUNCH
        if (ph + 1 < ph_end) { if (ph == ph_begin) grid.sync(); else xcd_barrier(xb); }
#endif
    }
}

extern "C" void kernel_launch(void* const* d_in, const int* in_sizes, int n_in, void* d_out, int out_size, void* d_ws, size_t ws_size, hipStream_t stream) {
    static int grid = 0;
    if (grid == 0) {
        int dev = 0, cus = 0, per_cu = 0;
        hipGetDevice(&dev);
        hipDeviceGetAttribute(&cus, hipDeviceAttributeMultiprocessorCount, dev);
        hipFuncSetAttribute((const void*)mega_kernel, hipFuncAttributeMaxDynamicSharedMemorySize, SMEM_BYTES);
        hipOccupancyMaxActiveBlocksPerMultiprocessor(&per_cu, (const void*)mega_kernel, NTH, SMEM_BYTES);
        (void)hipGetLastError();
        if (per_cu < 1) { fprintf(stderr, "kernel_launch: occupancy query reports %d blocks per CU\n", per_cu); per_cu = 1; }
        grid = cus;
    }
    Params p; memset(&p, 0, sizeof(p));
    auto in = [&](int i) { return (const float*)d_in[i]; };
    p.x_prompt = in(0); p.x_sample = in(1); p.st_gS = in(2); p.st_gC = in(3); p.st_rS = in(4); p.st_rSh = in(5); p.st_fC = in(6); p.meta = in(7);
    p.norm_mix = in(8); p.norm_ffn = in(9); p.norm_final = in(10);
    p.gdn_conv_w = in(12); p.gdn_A_log = in(13); p.gdn_dt_bias = in(14); p.gdn_norm_w = in(15);
    p.rwkv_mix = in(17); p.rwkv_w0 = in(22); p.rwkv_a0 = in(25); p.rwkv_k_k = in(30); p.rwkv_k_a = in(31); p.rwkv_r_k = in(32); p.rwkv_ln_w = in(33); p.rwkv_ln_b = in(34); p.rwkv_v0 = in(35);
    p.ffn_conv_w = in(39);
    float* o = (float*)d_out; size_t off = 0;
    p.y_prompt = o + off; off += (size_t)8 * 2048 * 1024;
    p.y_sample = o + off; off += (size_t)128 * 4 * 1024;
    p.gS_p = o + off; off += (size_t)2 * 8 * 8 * 128 * 128;
    p.gC_p = o + off; off += (size_t)2 * 8 * 3 * 3072;
    p.rS_p = o + off; off += (size_t)2 * 8 * 16 * 64 * 64;
    p.rSh_p = o + off; off += (size_t)2 * 8 * 1024;
    p.fC_p = o + off; off += (size_t)4 * 8 * 2 * DFF;
    p.gS_s = o + off; off += (size_t)2 * 128 * 8 * 128 * 128;
    p.gC_s = o + off; off += (size_t)2 * 128 * 3 * 3072;
    p.rS_s = o + off; off += (size_t)2 * 128 * 16 * 64 * 64;
    p.rSh_s = o + off; off += (size_t)2 * 128 * 1024;
    p.fC_s = o + off; off += (size_t)4 * 128 * 2 * DFF;
    char* ws = (char*)d_ws; size_t w = 0;
    auto carve = [&](size_t bytes) { char* r = ws + w; w += (bytes + 255) & ~(size_t)255; return r; };
    p.bar = (unsigned*)carve(XCD_BAR_WORDS * 4);
    p.w_in_t = (bf16_t*)carve((size_t)2 * GIN_NP * D * 2);
    p.w_out_t = (bf16_t*)carve((size_t)2 * D * D * 2);
    p.rwkv1_t = (bf16_t*)carve((size_t)2 * R1_N * D * 2);
    p.w2t = (bf16_t*)carve((size_t)2 * D * 64 * 2);
    p.a2t = (bf16_t*)carve((size_t)2 * D * 64 * 2);
    p.g2t = (bf16_t*)carve((size_t)2 * D * 192 * 2);
    p.v2t = (bf16_t*)carve((size_t)D * 64 * 2);
    p.wo_t = (bf16_t*)carve((size_t)2 * D * D * 2);
    p.up_t = (bf16_t*)carve((size_t)4 * 2 * DFF * D * 2);
    p.down_t = (bf16_t*)carve((size_t)4 * D * DFF * 2);
    p.X = (float*)carve((size_t)MPAD * D * 4);
    p.HN = (bf16_t*)carve((size_t)MPAD * D * 2);
    p.RA = (bf16_t*)carve((size_t)MPAD * GIN_LD * 2);
    p.RB = carve((size_t)5 * MPAD * D * 2);
    if (w > ws_size) { fprintf(stderr, "kernel_launch: workspace too small: need %zu, have %zu\n", w, ws_size); return; }
    char* sc = (char*)p.y_prompt; size_t so = 0;
    auto scarve = [&](size_t bytes) { char* r = sc + so; so += (bytes + 255) & ~(size_t)255; return r; };
    p.VFIRST = (bf16_t*)scarve((size_t)MPAD * D * 2);
    p.AB = (float*)scarve((size_t)MPAD * 16 * 4);
    p.SHIFT = (bf16_t*)scarve((size_t)NSEQ * D * 2);
    p.GL = (float*)scarve((size_t)64 * NCHUNK * 4);
    int nj = 0;
    auto job = [&](const float* src, bf16_t* dst, int K, int N, int Kd, int Nd) { TJob& t = p.jobs[nj++]; t.src = src; t.dst = dst; t.K = K; t.N = N; t.Kd = Kd; t.Nd = Nd; };
    for (int j = 0; j < 2; ++j) {
        job(in(11) + (size_t)j * D * 4112, p.w_in_t + (size_t)j * GIN_NP * D, D, 4112, D, GIN_NP);
        job(in(16) + (size_t)j * D * D, p.w_out_t + (size_t)j * D * D, D, D, D, D);
        bf16_t* r1 = p.rwkv1_t + (size_t)j * R1_N * D;
        job(in(18) + (size_t)j * D * D, r1, D, D, D, D);
        job(in(19) + (size_t)j * D * D, r1 + (size_t)1024 * D, D, D, D, D);
        job(in(20) + (size_t)j * D * D, r1 + (size_t)2048 * D, D, D, D, D);
        job(in(23) + (size_t)j * D * 64, r1 + (size_t)3072 * D, D, 64, D, 128);
        job(in(26) + (size_t)j * D * 64, r1 + (size_t)3200 * D, D, 64, D, 128);
        job(in(28) + (size_t)j * D * 160, r1 + (size_t)3328 * D, D, 160, D, 256);
        job(in(36), r1 + (size_t)3584 * D, D, j == 1 ? 32 : 0, D, 128);
        job(in(24) + (size_t)j * 64 * D, p.w2t + (size_t)j * D * 64, 64, D, 64, D);
        job(in(27) + (size_t)j * 64 * D, p.a2t + (size_t)j * D * 64, 64, D, 64, D);
        job(in(29) + (size_t)j * 160 * D, p.g2t + (size_t)j * D * 192, 160, D, 192, D);
        job(in(21) + (size_t)j * D * D, p.wo_t + (size_t)j * D * D, D, D, D, D);
    }
    job(in(37), p.v2t, 32, D, 64, D);
    for (int i = 0; i < 4; ++i) {
        job(in(38) + (size_t)i * D * 2 * DFF, p.up_t + (size_t)i * 2 * DFF * D, D, 2 * DFF, D, 2 * DFF);
        job(in(40) + (size_t)i * DFF * D, p.down_t + (size_t)i * D * DFF, DFF, D, DFF, D);
    }
    p.njobs = nj;
#if MULTI_LAUNCH
    for (int ph = 0; ph < NPHASES; ++ph) hipLaunchKernelGGL(mega_kernel, dim3(grid), dim3(NTH), SMEM_BYTES, stream, p, ph, ph + 1);
#else
    hipMemsetAsync(p.bar, 0, XCD_BAR_WORDS * 4, stream);
    int b0 = 0, b1 = NPHASES;
    void* args[] = { &p, &b0, &b1 };
    hipError_t e = hipLaunchCooperativeKernel((const void*)mega_kernel, dim3(grid), dim3(NTH), args, SMEM_BYTES, stream);
    if (e != hipSuccess) fprintf(stderr, "cooperative launch failed: %s (grid %d)\n", hipGetErrorString(e), grid);
#endif
}
```

```cpp
#include <hip/hip_runtime.h>
#include <hip/hip_cooperative_groups.h>
#include <cstdio>
#include <cstring>
#include <cstdint>
namespace cg = cooperative_groups;

#ifndef MULTI_LAUNCH
#define MULTI_LAUNCH 0
#endif

typedef unsigned short bf16_t;
typedef short bf16x8 __attribute__((ext_vector_type(8)));
typedef float f32x4 __attribute__((ext_vector_type(4)));
typedef float f32x2 __attribute__((ext_vector_type(2)));
typedef unsigned u32x4 __attribute__((ext_vector_type(4)));
typedef unsigned u32x2 __attribute__((ext_vector_type(2)));

constexpr int D = 1024;
constexpr int LP = 2064;
constexpr int TP = 8 * LP;
constexpr int TS = 512;
constexpr int T = TP + TS;
constexpr int MPAD = 17152;
constexpr int NSEQ = 136;
constexpr int DFF = 2816;
constexpr int NTH = 512;
constexpr int GIN_LD = 4096;
constexpr int GIN_NP = 4352;
constexpr int R1_N = 3840;
constexpr int NCHUNK = 33;
constexpr int CH_BYTES = 73728;
constexpr int SMEM_BYTES = 131072 + 1024 + 4096;

enum { PH_PREP = 0, PH_NORM_MIX, PH_GDN_IN, PH_GDN_PREP, PH_GDN_SCAN, PH_GDN_OUT, PH_NORM_FFN, PH_FFN_UP, PH_FFN_DOWN,
       PH_RWKV_IN, PH_RWKV_LORA, PH_RWKV_SCAN, PH_RWKV_POST, PH_RWKV_OUT, PH_FINAL, PH_FFN_ACT };
constexpr int NPHASES = 35;

struct TJob { const float* src; bf16_t* dst; const float* scale; int K, N, Kd, Nd, ld, smode; };
constexpr int MAXJOBS = 56;

struct Params {
    const float *x_prompt, *x_sample, *st_gS, *st_gC, *st_rS, *st_rSh, *st_fC, *meta;
    const float *norm_mix, *norm_ffn, *norm_final;
    const float *gdn_conv_w, *gdn_A_log, *gdn_dt_bias, *gdn_norm_w;
    const float *rwkv_mix, *rwkv_w0, *rwkv_a0, *rwkv_k_k, *rwkv_k_a, *rwkv_r_k, *rwkv_ln_w, *rwkv_ln_b, *rwkv_v0;
    const float *ffn_conv_w;
    float *y_prompt, *y_sample, *gS_p, *gC_p, *rS_p, *rSh_p, *fC_p, *gS_s, *gC_s, *rS_s, *rSh_s, *fC_s;
    bf16_t *w_in_t, *w_out_t, *rwkv1_t, *l1t, *w2t, *a2t, *g2t, *v2t, *wo_t, *up_t, *down_t;
    float* X; bf16_t* HN; bf16_t* SHIFT; bf16_t* RA; char* RB; float* AB; bf16_t* VFIRST; float* GL;
    unsigned* bar;
    int njobs; int pad0; int pad1; int pad2;
    TJob jobs[MAXJOBS];
};

typedef const __attribute__((address_space(4))) Params CParams;

__device__ __forceinline__ void lds_barrier() { asm volatile("s_waitcnt lgkmcnt(0)" ::: "memory"); __builtin_amdgcn_s_barrier(); asm volatile("" ::: "memory"); }
__device__ __forceinline__ int otid() { int t = threadIdx.x; asm volatile("" : "+v"(t)); return t; }
__device__ __forceinline__ int obid() { int t = blockIdx.x; asm volatile("" : "+s"(t)); return t; }
__device__ __forceinline__ int ogrid() { int t = gridDim.x; asm volatile("" : "+s"(t)); return t; }
__device__ __forceinline__ float bf2f(unsigned h) { return __uint_as_float(h << 16); }
typedef __bf16 bf16x2_t __attribute__((ext_vector_type(2)));
__device__ __forceinline__ unsigned pack2(float lo, float hi) { const f32x2 v = {lo, hi}; return __builtin_bit_cast(unsigned, __builtin_convertvector(v, bf16x2_t)); }
__device__ __forceinline__ unsigned f2bf(float f) { return pack2(f, 0.f) & 0xffffu; }
__device__ __forceinline__ float lo16(unsigned u) { return __uint_as_float(u << 16); }
__device__ __forceinline__ float hi16(unsigned u) { return __uint_as_float(u & 0xffff0000u); }
__device__ __forceinline__ float sigmoidf_(float x) { return __builtin_amdgcn_rcpf(1.f + __expf(-x)); }
__device__ __forceinline__ float siluf_(float x) { return x * __builtin_amdgcn_rcpf(1.f + __expf(-x)); }
__device__ __forceinline__ float tanhf_(float x) { return 2.f * __builtin_amdgcn_rcpf(1.f + __expf(-2.f * x)) - 1.f; }
__device__ __forceinline__ float softplusf_(float x) { return fmaxf(x, 0.f) + __logf(1.f + __expf(-fabsf(x))); }
__device__ __forceinline__ float wave_sum(float v) {
#pragma unroll
    for (int o = 1; o < 64; o <<= 1) v += __shfl_xor(v, o);
    return v;
}
template <int CTRL> __device__ __forceinline__ float dpp_add(float x) {
    int v = __builtin_amdgcn_update_dpp(0, __float_as_int(x), CTRL, 0xf, 0xf, true);
    return x + __int_as_float(v);
}
__device__ __forceinline__ float row16_sum(float x) {
    x = dpp_add<0xB1>(x);
    x = dpp_add<0x4E>(x);
    x = dpp_add<0x141>(x);
    x = dpp_add<0x140>(x);
    return x;
}
__device__ __forceinline__ void tokdec(int m, int& seq, int& t, int& L) {
    if (m < TP) { seq = m / LP; t = m - seq * LP; L = LP; }
    else { int s = m - TP; seq = 8 + (s >> 2); t = s & 3; L = 4; }
}
__device__ __forceinline__ int gdn_ph(int q) { return q == 0 ? PH_NORM_MIX : q == 1 ? PH_GDN_IN : q == 2 ? PH_GDN_PREP : q == 3 ? PH_GDN_SCAN : q == 4 ? PH_GDN_OUT : q == 5 ? PH_NORM_FFN : q == 6 ? PH_FFN_UP : PH_FFN_DOWN; }
__device__ __forceinline__ int rwkv_ph(int q) { return q == 0 ? PH_NORM_MIX : q == 1 ? PH_RWKV_IN : q == 2 ? PH_RWKV_LORA : q == 3 ? PH_RWKV_SCAN : q == 4 ? PH_RWKV_POST : q == 5 ? PH_RWKV_OUT : q == 6 ? PH_NORM_FFN : q == 7 ? PH_FFN_UP : PH_FFN_DOWN; }
__device__ __forceinline__ void phase_info(int ph, int& type, int& layer) {
    if (ph == 0) { type = PH_PREP; layer = 0; return; }
    if (ph == NPHASES - 1) { type = PH_FINAL; layer = 0; return; }
    int q = ph - 1;
    if (q < 7) { layer = 0; type = gdn_ph(q + 1); return; } q -= 7;
    if (q < 9) { layer = 1; type = rwkv_ph(q); return; } q -= 9;
    if (q < 8) { layer = 2; type = gdn_ph(q); return; } q -= 8;
    layer = 3; type = rwkv_ph(q);
}

#define XB_TMO      128
#define XB_XCNT(j)  (256  + 64 * (j))
#define XB_XSUB(j)  (1280 + 64 * (j))
#define XB_XGEN(j)  (2304 + 64 * (j))
#define XB_TOP      3328
#define XB_TOPGEN   3392
#define XCD_BAR_WORDS 3456
#define XB_SPIN_CAP (1u << 22)
#define LAS __attribute__((address_space(3)))
__device__ __forceinline__ unsigned xb_ld(unsigned* p)              { return __hip_atomic_load(p, __ATOMIC_RELAXED, __HIP_MEMORY_SCOPE_AGENT); }
__device__ __forceinline__ unsigned xb_add(unsigned* p, unsigned v) { return __hip_atomic_fetch_add(p, v, __ATOMIC_RELAXED, __HIP_MEMORY_SCOPE_AGENT); }
__device__ __forceinline__ unsigned xb_xcc_id() { return (unsigned)__builtin_amdgcn_s_getreg((3 << 11) | 20) & 0xFu; }
#define XB_SPIN(cond, bar) do { unsigned _sp = 0; while (cond) { __builtin_amdgcn_s_sleep(1); \
    if ((++_sp & 255u) == 0u) { if (xb_ld(&(bar)[XB_TMO])) break; if (_sp > XB_SPIN_CAP) { atomicAdd(&(bar)[XB_TMO], 1u); break; } } } } while (0)
struct XcdBarrier { unsigned* bar; unsigned x; volatile LAS unsigned* st; };
__device__ __forceinline__ XcdBarrier xcd_barrier_post(unsigned* bar, volatile LAS unsigned* st) {
    XcdBarrier b; b.bar = bar; b.x = xb_xcc_id(); b.st = st;
    if (threadIdx.x == 0) (void)xb_add(&bar[XB_XCNT(b.x)], 1u);
    return b;
}
__device__ __forceinline__ void xcd_barrier_complete(unsigned* bar, unsigned x, unsigned& nloc, unsigned& nx) {
    const unsigned G = gridDim.x * gridDim.y * gridDim.z;
    unsigned sum, cnt, mine, sp = 0u;
    for (;;) {
        sum = 0u; cnt = 0u; mine = 0u;
#pragma unroll
        for (unsigned j = 0; j < 16; ++j) { const unsigned c = xb_ld(&bar[XB_XCNT(j)]); sum += c; cnt += (c > 0u) ? 1u : 0u; mine = (j == x) ? c : mine; }
        if (sum == G) break;
        __builtin_amdgcn_s_sleep(1);
        if ((++sp & 255u) == 0u) { if (xb_ld(&bar[XB_TMO])) break; if (sp > XB_SPIN_CAP) { atomicAdd(&bar[XB_TMO], 1u); break; } }
    }
    nloc = mine > 0u ? mine : 1u; nx = cnt > 0u ? cnt : 1u;
}
__device__ __forceinline__ void xcd_barrier(const XcdBarrier& b) {
    asm volatile("s_waitcnt vmcnt(0)" ::: "memory");
    __syncthreads();
    if (threadIdx.x == 0) {
        unsigned* bar = b.bar;
        __builtin_amdgcn_s_waitcnt(0);
        unsigned nloc = b.st[0], nx = b.st[1];
        if (nloc == 0u) { xcd_barrier_complete(bar, b.x, nloc, nx); b.st[0] = nloc; b.st[1] = nx; }
        const unsigned old = xb_add(&bar[XB_XSUB(b.x)], 1u);
        const unsigned gen = old / nloc;
        if (old + 1u == (gen + 1u) * nloc) {
            __builtin_amdgcn_fence(__ATOMIC_RELEASE, "agent");
            asm volatile("s_waitcnt vmcnt(0)" ::: "memory");
            const unsigned og = xb_add(&bar[XB_TOP], 1u);
            const unsigned tg = og / nx;
            if (og + 1u == (tg + 1u) * nx) xb_add(&bar[XB_TOPGEN], 1u);
            else XB_SPIN(xb_ld(&bar[XB_TOPGEN]) == tg, bar);
            __builtin_amdgcn_fence(__ATOMIC_ACQUIRE, "agent");
            xb_add(&bar[XB_XGEN(b.x)], 1u);
            asm volatile("s_waitcnt vmcnt(0)" ::: "memory");
        } else {
            XB_SPIN(xb_ld(&bar[XB_XGEN(b.x)]) == gen, bar);
            __builtin_amdgcn_fence(__ATOMIC_ACQUIRE, "agent");
            asm volatile("s_waitcnt vmcnt(0)" ::: "memory");
        }
    }
    __syncthreads();
}

__device__ __forceinline__ void prep_phase(CParams& p, char* smem, int j0, int j1, int widx, int nworkers) {
    const int tid = otid(), lane = tid & 63, wave = tid >> 6;
    float* scr = (float*)(smem + wave * 8704);
    const int gw = widx * 8 + wave, NGW = nworkers * 8;
    int total = 0;
    for (int j = j0; j < j1; ++j) total += (p.jobs[j].Kd >> 6) * (p.jobs[j].Nd >> 5);
    for (int it = gw; it < total; it += NGW) {
        int r = it, j = j0;
        for (;; ++j) { const int c = (p.jobs[j].Kd >> 6) * (p.jobs[j].Nd >> 5); if (r < c) break; r -= c; }
        TJob jb; jb.src = p.jobs[j].src; jb.dst = p.jobs[j].dst; jb.scale = p.jobs[j].scale; jb.K = p.jobs[j].K; jb.N = p.jobs[j].N; jb.Kd = p.jobs[j].Kd; jb.Nd = p.jobs[j].Nd; jb.ld = p.jobs[j].ld; jb.smode = p.jobs[j].smode;
        const int nblk = jb.Nd >> 5, kb = r / nblk, nb = r - kb * nblk, k0 = kb * 64, n0 = nb * 32;
        {
            const int n4 = (lane & 7) * 4, kr = lane >> 3;
            f32x4 v[8];
            const bool vec_ok = ((jb.N & 3) == 0) && (n0 + n4 + 3 < jb.N);
#pragma unroll
            for (int i = 0; i < 8; ++i) {
                const int kk = i * 8 + kr;
                v[i] = (f32x4){0.f, 0.f, 0.f, 0.f};
                if (k0 + kk < jb.K) {
                    const float* sp = jb.src + (size_t)(k0 + kk) * jb.N + n0 + n4;
                    if (vec_ok) v[i] = *(const f32x4*)sp;
                    else {
#pragma unroll
                        for (int e = 0; e < 4; ++e) if (n0 + n4 + e < jb.N) v[i][e] = sp[e];
                    }
                    if (jb.smode) { const float sc = jb.scale[k0 + kk]; v[i] = v[i] * (jb.smode == 1 ? 1.f - sc : sc); }
                }
            }
#pragma unroll
            for (int i = 0; i < 8; ++i) {
                const int kk = i * 8 + kr;
#pragma unroll
                for (int e = 0; e < 4; ++e) scr[kk * 33 + n4 + e] = v[i][e];
            }
        }
        __builtin_amdgcn_s_waitcnt(0xc07f);
        asm volatile("" ::: "memory");
        const int c = lane & 7;
#pragma unroll
        for (int jj = 0; jj < 4; ++jj) {
            const int nn = (lane >> 3) + 8 * jj;
            const float* s = scr + (8 * c) * 33 + nn;
            u32x4 o;
            o.x = pack2(s[0], s[33]); o.y = pack2(s[66], s[99]); o.z = pack2(s[132], s[165]); o.w = pack2(s[198], s[231]);
            *(u32x4*)(jb.dst + (size_t)(n0 + nn) * jb.ld + k0 + 8 * c) = o;
        }
        __builtin_amdgcn_s_waitcnt(0xc07f);
        asm volatile("" ::: "memory");
    }
}

__device__ __forceinline__ const float* xsrc_row(CParams& p, int m) {
    int seq, t, L; tokdec(m, seq, t, L);
    if (m < TP) return t < 16 ? p.meta + (size_t)t * D : p.x_prompt + ((size_t)seq * 2048 + (t - 16)) * D;
    return p.x_sample + (size_t)(m - TP) * D;
}
__device__ __forceinline__ void norm_phase(CParams& p, int layer, int mode) {
    const int tid = otid(), lane = tid & 63, wave = tid >> 6;
    const int gw = obid() * 8 + wave, NGW = ogrid() * 8;
    const float* g = mode == 0 ? p.norm_mix + layer * D : (mode == 1 ? p.norm_ffn + layer * D : p.norm_final);
    const bool first = (mode == 0 && layer == 0);
    const bool rw = (mode == 0 && (layer & 1));
    const int j = layer >> 1;
    f32x4 gv[4];
#pragma unroll
    for (int q = 0; q < 4; ++q) gv[q] = *(const f32x4*)(g + q * 256 + lane * 4);
    const int nrows = (mode == 2) ? T : MPAD + (rw ? NSEQ : 0);
    f32x4 nv[4];
    if (gw < T) { const float* s0 = first ? xsrc_row(p, gw) : p.X + (size_t)gw * D;
#pragma unroll
        for (int q = 0; q < 4; ++q) nv[q] = *(const f32x4*)(s0 + q * 256 + lane * 4); }
    for (int m = gw; m < nrows; m += NGW) {
        if (m >= MPAD) {
            const int seq = m - MPAD;
            bf16_t* o = p.SHIFT + (size_t)seq * D;
#pragma unroll
            for (int q = 0; q < 4; ++q) {
                f32x4 v = {0.f, 0.f, 0.f, 0.f};
                if (seq >= 8) v = *(const f32x4*)(p.st_rSh + ((size_t)j * 128 + (seq - 8)) * D + q * 256 + lane * 4);
                u32x2 w; w.x = pack2(v.x, v.y); w.y = pack2(v.z, v.w);
                *(u32x2*)(o + q * 256 + lane * 4) = w;
            }
            continue;
        }
        if (m >= T) {
            u32x2 z; z.x = 0; z.y = 0;
#pragma unroll
            for (int q = 0; q < 4; ++q) *(u32x2*)(p.HN + (size_t)m * D + q * 256 + lane * 4) = z;
            if (first) { f32x4 zz = {0.f, 0.f, 0.f, 0.f};
#pragma unroll
                for (int q = 0; q < 4; ++q) *(f32x4*)(p.X + (size_t)m * D + q * 256 + lane * 4) = zz; }
            continue;
        }
        f32x4 v[4]; float ss = 0.f;
#pragma unroll
        for (int q = 0; q < 4; ++q) { v[q] = nv[q]; ss += v[q].x * v[q].x + v[q].y * v[q].y + v[q].z * v[q].z + v[q].w * v[q].w; }
        if (m + NGW < T) { const float* s1 = first ? xsrc_row(p, m + NGW) : p.X + (size_t)(m + NGW) * D;
#pragma unroll
            for (int q = 0; q < 4; ++q) nv[q] = *(const f32x4*)(s1 + q * 256 + lane * 4); }
        ss = wave_sum(ss);
        const float rstd = rsqrtf(ss * (1.f / D) + 1e-6f);
        if (first) {
#pragma unroll
            for (int q = 0; q < 4; ++q) *(f32x4*)(p.X + (size_t)m * D + q * 256 + lane * 4) = v[q];
        }
        int seq, t, L; tokdec(m, seq, t, L);
#pragma unroll
        for (int q = 0; q < 4; ++q) v[q] = v[q] * rstd * gv[q];
        if (mode == 2) {
            float* o = nullptr;
            if (m < TP) { if (t >= 16) o = p.y_prompt + ((size_t)seq * 2048 + (t - 16)) * D; }
            else o = p.y_sample + (size_t)(m - TP) * D;
            if (o) {
#pragma unroll
                for (int q = 0; q < 4; ++q) *(f32x4*)(o + q * 256 + lane * 4) = v[q];
            }
            continue;
        }
#pragma unroll
        for (int q = 0; q < 4; ++q) { u32x2 w; w.x = pack2(v[q].x, v[q].y); w.y = pack2(v[q].z, v[q].w); *(u32x2*)(p.HN + (size_t)m * D + q * 256 + lane * 4) = w; }
        if (rw && t == L - 1) {
            float* o = (seq < 8) ? p.rSh_p + ((size_t)j * 8 + seq) * D : p.rSh_s + ((size_t)j * 128 + (seq - 8)) * D;
#pragma unroll
            for (int q = 0; q < 4; ++q) *(f32x4*)(o + q * 256 + lane * 4) = v[q];
        }
    }
}

constexpr int A_STAGE = 32768, B_STAGE = 16384;
__device__ __forceinline__ int lds_off(int r, int c) {
    const int st = (r >> 4) * 2 + (c >> 5), rr = r & 15, cc = c & 31, ob = rr * 64 + cc * 2;
    return st * 1024 + (ob ^ (((ob >> 9) & 1) << 5));
}
struct ALoadPlain {
    const bf16_t* p[4]; u32x4 r[4]; int lo[4];
    __device__ __forceinline__ void init(int tid, const bf16_t* A, int lda, int m0, int mmax) {
        const int row = tid >> 3, kc = tid & 7;
#pragma unroll
        for (int i = 0; i < 4; ++i) { int m = m0 + row + 64 * i; m = m < 0 ? 0 : (m > mmax ? mmax : m); p[i] = A + (size_t)m * lda + kc * 8; lo[i] = lds_off(row + 64 * i, kc * 8); }
    }
    __device__ __forceinline__ void issue(int kt) {
#pragma unroll
        for (int i = 0; i < 4; ++i) r[i] = *(const u32x4*)(p[i] + kt * 64);
    }
    __device__ __forceinline__ void commit(char* As) {
#pragma unroll
        for (int i = 0; i < 4; ++i) *(u32x4*)(As + lo[i]) = r[i];
    }
};
struct ALoadMix {
    const bf16_t* ph[4]; const bf16_t* pp[4]; const float* pm; u32x4 rh[4], rp[4]; f32x4 m0, m1; int lo[4];
    __device__ __forceinline__ void init(int tid, CParams& p, const float* mixv, int mbase) {
        const int row = tid >> 3, kc = tid & 7;
#pragma unroll
        for (int i = 0; i < 4; ++i) {
            int m = mbase + row + 64 * i; if (m > MPAD - 1) m = MPAD - 1;
            ph[i] = p.HN + (size_t)m * D + kc * 8; lo[i] = lds_off(row + 64 * i, kc * 8);
            if (m < T) { int seq, t, L; tokdec(m, seq, t, L); pp[i] = (t == 0) ? p.SHIFT + (size_t)seq * D + kc * 8 : ph[i] - D; }
            else pp[i] = ph[i];
        }
        pm = mixv + kc * 8;
    }
    __device__ __forceinline__ void issue(int kt) {
#pragma unroll
        for (int i = 0; i < 4; ++i) { rh[i] = *(const u32x4*)(ph[i] + kt * 64); rp[i] = *(const u32x4*)(pp[i] + kt * 64); }
        m0 = *(const f32x4*)(pm + kt * 64); m1 = *(const f32x4*)(pm + kt * 64 + 4);
    }
    __device__ __forceinline__ void commit(char* As) {
#pragma unroll
        for (int i = 0; i < 4; ++i) {
            u32x4 o;
#pragma unroll
            for (int q = 0; q < 4; ++q) {
                const unsigned hh = rh[i][q], pv = rp[i][q];
                const float h0 = lo16(hh), h1 = hi16(hh), p0 = lo16(pv), p1 = hi16(pv);
                const float ma = q < 2 ? m0[2 * q] : m1[2 * q - 4], mb = q < 2 ? m0[2 * q + 1] : m1[2 * q - 3];
                o[q] = pack2(h0 + (p0 - h0) * ma, h1 + (p1 - h1) * mb);
            }
            *(u32x4*)(As + lo[i]) = o;
        }
    }
};
struct BLoad {
    const bf16_t* p[2]; u32x4 r[2]; int lo[2];
    __device__ __forceinline__ void init(int tid, const bf16_t* B0, const bf16_t* B1, int ldb) {
        const int row = tid >> 3, kc = tid & 7;
        p[0] = B0 + (size_t)row * ldb + kc * 8;
        p[1] = B1 + (size_t)row * ldb + kc * 8;
        lo[0] = lds_off(row, kc * 8); lo[1] = lds_off(row + 64, kc * 8);
    }
    __device__ __forceinline__ void issue(int kt) { r[0] = *(const u32x4*)(p[0] + kt * 64); r[1] = *(const u32x4*)(p[1] + kt * 64); }
    __device__ __forceinline__ void commit(char* Bs) {
        *(u32x4*)(Bs + lo[0]) = r[0];
        *(u32x4*)(Bs + lo[1]) = r[1];
    }
};
template <bool PAIRED, class AL>
__device__ __forceinline__ void gemm_mainloop(int tid, char* smem, AL& al, BLoad& bl, int nkt, f32x4 (&acc)[4][4]) {
    const int lane = tid & 63, wid = tid >> 6, wr = wid >> 1, wc = wid & 1, fr = lane & 15, fq = lane >> 4;
#pragma unroll
    for (int a = 0; a < 4; ++a)
#pragma unroll
        for (int b = 0; b < 4; ++b) acc[a][b] = (f32x4){0.f, 0.f, 0.f, 0.f};
    char* As = smem; char* Bs = smem + 2 * A_STAGE;
    al.issue(0); bl.issue(0);
    al.commit(As); bl.commit(Bs);
    lds_barrier();
    for (int kt = 0; kt < nkt; ++kt) {
        const int cur = kt & 1;
        if (kt + 1 < nkt) { al.issue(kt + 1); bl.issue(kt + 1); }
        const char* Ac = As + cur * A_STAGE; const char* Bc = Bs + cur * B_STAGE;
#pragma unroll
        for (int ks = 0; ks < 2; ++ks) {
            bf16x8 af[4], bfr[4];
#pragma unroll
            for (int mf = 0; mf < 4; ++mf) af[mf] = *(const bf16x8*)(Ac + lds_off(wr * 64 + mf * 16 + fr, ks * 32 + fq * 8));
#pragma unroll
            for (int nf = 0; nf < 4; ++nf) {
                const int br = PAIRED ? ((nf >> 1) * 64 + wc * 32 + (nf & 1) * 16) : (wc * 64 + nf * 16);
                bfr[nf] = *(const bf16x8*)(Bc + lds_off(br + fr, ks * 32 + fq * 8));
            }
#pragma unroll
            for (int mf = 0; mf < 4; ++mf)
#pragma unroll
                for (int nf = 0; nf < 4; ++nf) acc[mf][nf] = __builtin_amdgcn_mfma_f32_16x16x32_bf16(bfr[nf], af[mf], acc[mf][nf], 0, 0, 0);
        }
        if (kt + 1 < nkt) { al.commit(As + (cur ^ 1) * A_STAGE); bl.commit(Bs + (cur ^ 1) * B_STAGE); }
        lds_barrier();
    }
}

namespace pg8 {
constexpr int BM = 256, BK = 64, HALF = 128, HTB = HALF * BK * 2, NXCD = 8, WGM = 8;
__device__ __forceinline__ void stage_rc(int b, int& R, int& C) { const int st = b / 1024, sb = b % 1024, swz = sb ^ (((sb >> 9) & 1) << 5); R = (st >> 1) * 16 + swz / 64; C = (st & 1) * 32 + (swz % 64) / 2; }
struct Unit { int pm, pn; };
struct Gemm { const bf16_t* A; const bf16_t* Bt; int lda, K, nM, nN; const bf16_t* A2; int ksplit; size_t agstride; int npg; int brows_tile, brows_half; int arows_tile, arow0; int perm; };
struct StaticOrder {
    int nM, nN, nwg, G, c;
    __device__ __forceinline__ void init(int nM_, int nN_, int G_, int c_) { nM = nM_; nN = nN_; nwg = nM * nN; G = G_; c = c_; }
    __device__ __forceinline__ bool next(int i, Unit& u) const {
        const int L = i * G + c; if (L >= nwg) return false;
        int wgid = L; { const int q = nwg / NXCD, r = nwg % NXCD, xcd = wgid % NXCD, off = wgid / NXCD; wgid = (xcd < r ? xcd * (q + 1) : r * (q + 1) + (xcd - r) * q) + off; }
        const int nig = WGM * nN, gid = wgid / nig, fm = gid * WGM, gsz = (nM - fm) < WGM ? (nM - fm) : WGM;
        u.pm = fm + ((wgid % nig) % gsz); u.pn = (wgid % nig) / gsz; return true;
    }
};
template <class Epi>
__device__ __forceinline__ void gemm_phase(int tid, char* smem, const Gemm g, int G, int c, const Epi& E) {
    LAS unsigned char* lds = (LAS unsigned char*)smem;
    const int wid = __builtin_amdgcn_readfirstlane(tid >> 6), lane = tid & 63, wr = wid >> 2, wc = wid & 3, fr = lane & 15, fq = lane >> 4;
    const int K = g.K, nt = K / BK;
    StaticOrder S; S.init(g.nM, g.nN, G, c);
    unsigned voffA[2], voffB[2];
#pragma unroll
    for (int i = 0; i < 2; ++i) { int R, C; stage_rc(tid * 16 + i * 8192, R, C); voffA[i] = (unsigned)(R * g.lda + C) * 2u;
        const int rho = R & 31, Rb = g.perm ? ((R & ~31) + 8 * ((rho & 15) >> 2) + 4 * (rho >> 4) + (rho & 3)) : R;
        voffB[i] = (unsigned)(Rb * K + C) * 2u; }
    const size_t kstep = (size_t)(BK * 2);
    const size_t hstepA = (size_t)HALF * g.lda * 2, hstepB = (size_t)g.brows_half * K * 2;
    const size_t tstepA = (size_t)g.arows_tile * g.lda * 2, tstepB = (size_t)g.brows_tile * K * 2;
    const ptrdiff_t a0off = (ptrdiff_t)g.arow0 * g.lda * 2;
    const unsigned ldsw = (unsigned)wid * 1024u;
    const int aoff = lds_off(wr * 64 + fr, fq * 8), boff = lds_off(wc * 32 + fr, fq * 8);
#define PG8_SA(b, h) (((b) * 2 + (h)) * HTB)
#define PG8_SB(b, h) ((4 + (b) * 2 + (h)) * HTB)
#define PG8_STAGE(bufoff, gbase, voff) do { _Pragma("unroll") for (int _i = 0; _i < 2; ++_i) \
        __builtin_amdgcn_global_load_lds((const unsigned*)((const char*)(gbase) + (voff)[_i]), (LAS unsigned*)(lds + (bufoff) + ldsw + _i * 8192), 16, 0, 0); } while (0)
#define PG8_LDA(dst, b, h) do { _Pragma("unroll") for (int m = 0; m < 4; ++m) _Pragma("unroll") for (int k = 0; k < 2; ++k) dst[m][k] = *(const LAS bf16x8*)(lds + PG8_SA(b, h) + aoff + m * 2048 + k * 1024); } while (0)
#define PG8_LDB(dst, b, h) do { _Pragma("unroll") for (int n = 0; n < 2; ++n) _Pragma("unroll") for (int k = 0; k < 2; ++k) dst[n][k] = *(const LAS bf16x8*)(lds + PG8_SB(b, h) + boff + n * 2048 + k * 1024); } while (0)
#define PG8_MMA(ai, bj, At, Bt) do { __builtin_amdgcn_s_setprio(1); _Pragma("unroll") for (int m = 0; m < 4; ++m) _Pragma("unroll") for (int n = 0; n < 2; ++n) _Pragma("unroll") for (int k = 0; k < 2; ++k) \
        acc[ai][bj][m][n] = __builtin_amdgcn_mfma_f32_16x16x32_bf16(Bt[n][k], At[m][k], acc[ai][bj][m][n], 0, 0, 0); __builtin_amdgcn_s_setprio(0); } while (0)
#define PG8_WAIT_V(n) asm volatile("s_waitcnt vmcnt(" #n ")" ::: "memory")
#define PG8_WAIT_L(n) asm volatile("s_waitcnt lgkmcnt(" #n ")" ::: "memory")
#define PG8_BAR __builtin_amdgcn_s_barrier()
#define PG8_SCHED __builtin_amdgcn_sched_barrier(0)
    Unit cur, nxt; int ui = 0;
    if (!S.next(0, cur)) return;
    f32x4 acc[2][2][4][2];
#pragma unroll
    for (int a = 0; a < 2; ++a)
#pragma unroll
        for (int b = 0; b < 2; ++b)
#pragma unroll
            for (int m = 0; m < 4; ++m)
#pragma unroll
                for (int n = 0; n < 2; ++n) acc[a][b][m][n] = (f32x4){0.f, 0.f, 0.f, 0.f};
    bf16x8 At[4][2], B0[2][2], B1[2][2];
    const int ksplit = g.ksplit;
    const char* cA = (const char*)g.A + (size_t)(cur.pn / g.npg) * g.agstride * 2 + (size_t)cur.pm * tstepA + a0off; const char* cA2 = (const char*)g.A2 + (size_t)cur.pm * tstepA - (size_t)ksplit * kstep;
    const char* cB = (const char*)g.Bt + (size_t)cur.pn * tstepB;
    PG8_STAGE(PG8_SB(0, 0), cB, voffB); PG8_STAGE(PG8_SB(0, 1), cB + hstepB, voffB); PG8_STAGE(PG8_SA(0, 0), cA, voffA); PG8_STAGE(PG8_SA(0, 1), cA + hstepA, voffA);
    if (wr == 1) PG8_BAR;
    PG8_WAIT_V(2); PG8_BAR;
    PG8_STAGE(PG8_SB(1, 0), cB + kstep, voffB); PG8_STAGE(PG8_SA(1, 0), cA + kstep, voffA); PG8_STAGE(PG8_SB(1, 1), cB + hstepB + kstep, voffB);
    PG8_WAIT_V(6); PG8_BAR;
    for (;;) {
        const bool has_next = S.next(ui + 1, nxt);
        const char* nA = has_next ? (const char*)g.A + (size_t)(nxt.pn / g.npg) * g.agstride * 2 + (size_t)nxt.pm * tstepA + a0off : cA; const char* nA2 = has_next ? (const char*)g.A2 + (size_t)nxt.pm * tstepA - (size_t)ksplit * kstep : cA2;
        const char* nB = has_next ? (const char*)g.Bt + (size_t)nxt.pn * tstepB : cB;
        for (int t = 0; t < nt; t += 2) {
            const bool last = (t == nt - 2);
            const char* a1 = ((t + 1 < ksplit) ? cA : cA2) + (size_t)(t + 1) * kstep;
            const char* a2 = last ? nA : ((t + 2 < ksplit) ? cA : cA2) + (size_t)(t + 2) * kstep; const char* b2 = last ? nB : cB + (size_t)(t + 2) * kstep;
            const char* a3 = last ? nA + kstep : ((t + 3 < ksplit) ? cA : cA2) + (size_t)(t + 3) * kstep; const char* b3 = b2 + kstep;
            PG8_LDB(B0, 0, 0); PG8_LDB(B1, 0, 1); PG8_SCHED; PG8_LDA(At, 0, 0); PG8_STAGE(PG8_SA(1, 1), a1 + hstepA, voffA);
            PG8_WAIT_V(8); PG8_WAIT_L(0); PG8_BAR; PG8_MMA(0, 0, At, B0); PG8_MMA(0, 1, At, B1); PG8_BAR; PG8_SCHED;
            PG8_LDA(At, 0, 1); PG8_STAGE(PG8_SB(0, 0), b2, voffB); PG8_STAGE(PG8_SB(0, 1), b2 + hstepB, voffB); PG8_STAGE(PG8_SA(0, 0), a2, voffA);
            PG8_WAIT_V(8); PG8_WAIT_L(0); PG8_BAR; PG8_MMA(1, 0, At, B0); PG8_MMA(1, 1, At, B1); PG8_BAR; PG8_SCHED;
            PG8_LDB(B0, 1, 0); PG8_LDB(B1, 1, 1); PG8_SCHED; PG8_LDA(At, 1, 0); PG8_STAGE(PG8_SA(0, 1), a2 + hstepA, voffA);
            PG8_WAIT_V(8); PG8_WAIT_L(0); PG8_BAR; PG8_MMA(0, 0, At, B0); PG8_MMA(0, 1, At, B1); PG8_BAR; PG8_SCHED;
            PG8_LDA(At, 1, 1); PG8_STAGE(PG8_SB(1, 0), b3, voffB); PG8_STAGE(PG8_SB(1, 1), b3 + hstepB, voffB); PG8_STAGE(PG8_SA(1, 0), a3, voffA);
            PG8_WAIT_V(8); PG8_WAIT_L(0); PG8_BAR; PG8_MMA(1, 0, At, B0); PG8_MMA(1, 1, At, B1); PG8_BAR; PG8_SCHED;
        }
        if (wr == 0) PG8_BAR;
        E(acc, cur, wr, wc, fr, fq);
        if (!has_next) break;
#pragma unroll
        for (int a = 0; a < 2; ++a)
#pragma unroll
            for (int b = 0; b < 2; ++b)
#pragma unroll
                for (int m = 0; m < 4; ++m)
#pragma unroll
                    for (int n = 0; n < 2; ++n) acc[a][b][m][n] = (f32x4){0.f, 0.f, 0.f, 0.f};
        cur = nxt; cA = nA; cA2 = nA2; cB = nB; ++ui;
        if (wr == 1) PG8_BAR;
    }
    PG8_WAIT_V(0);
    PG8_BAR;
#undef PG8_SA
#undef PG8_SB
#undef PG8_STAGE
#undef PG8_LDA
#undef PG8_LDB
#undef PG8_MMA
#undef PG8_WAIT_V
#undef PG8_WAIT_L
#undef PG8_BAR
#undef PG8_SCHED
}
struct EpiRes {
    float* X;
    __device__ __forceinline__ void operator()(const f32x4 (&acc)[2][2][4][2], const Unit& u, int wr, int wc, int fr, int fq) const {
        const int row0 = u.pm * BM + wr * 64 + fr, col0 = u.pn * BM + wc * 32 + 4 * fq;
#pragma unroll
        for (int ai = 0; ai < 2; ++ai) {
            f32x4 xv[4][2][2];
#pragma unroll
            for (int m = 0; m < 4; ++m) { const float* rowp = X + (size_t)(row0 + ai * HALF + m * 16) * D + col0;
#pragma unroll
                for (int bj = 0; bj < 2; ++bj)
#pragma unroll
                    for (int n = 0; n < 2; ++n) xv[m][bj][n] = *(const f32x4*)(rowp + bj * HALF + n * 16); }
#pragma unroll
            for (int m = 0; m < 4; ++m) { float* rowp = X + (size_t)(row0 + ai * HALF + m * 16) * D + col0;
#pragma unroll
                for (int bj = 0; bj < 2; ++bj)
#pragma unroll
                    for (int n = 0; n < 2; ++n) *(f32x4*)(rowp + bj * HALF + n * 16) = xv[m][bj][n] + acc[ai][bj][m][n]; }
        }
    }
};
struct EpiBf16 {
    bf16_t* O; int ldc; int ncol; float* AB;
    __device__ __forceinline__ void operator()(const f32x4 (&acc)[2][2][4][2], const Unit& u, int wr, int wc, int fr, int fq) const {
        const int row0 = u.pm * BM + wr * 64 + fr, col0 = u.pn * BM + wc * 32 + 8 * fq;
#pragma unroll
        for (int ai = 0; ai < 2; ++ai)
#pragma unroll
            for (int m = 0; m < 4; ++m) { const size_t row = (size_t)(row0 + ai * HALF + m * 16);
#pragma unroll
                for (int bj = 0; bj < 2; ++bj) {
                    const int col = col0 + bj * HALF; const f32x4 v0 = acc[ai][bj][m][0], v1 = acc[ai][bj][m][1];
                    if (col < ncol) { u32x4 w; w.x = pack2(v0[0], v0[1]); w.y = pack2(v0[2], v0[3]); w.z = pack2(v1[0], v1[1]); w.w = pack2(v1[2], v1[3]); *(u32x4*)(O + row * ldc + col) = w; }
                    else if (AB && col < ncol + 16) { *(f32x4*)(AB + row * 16 + (col - ncol)) = v0; *(f32x4*)(AB + row * 16 + (col - ncol) + 4) = v1; }
                } }
    }
};
struct EpiRwkv1 {
    bf16_t* C1; bf16_t* VF; int colbase; int lora; int rowbase;
    __device__ __forceinline__ void operator()(const f32x4 (&acc)[2][2][4][2], const Unit& u, int wr, int wc, int fr, int fq) const {
        const int row0 = rowbase + u.pm * BM + wr * 64 + fr, col0 = u.pn * BM + wc * 32 + 8 * fq;
#pragma unroll
        for (int ai = 0; ai < 2; ++ai)
#pragma unroll
            for (int m = 0; m < 4; ++m) { const size_t row = (size_t)(row0 + ai * HALF + m * 16);
#pragma unroll
                for (int bj = 0; bj < 2; ++bj) {
                    const int col = col0 + bj * HALF; f32x4 v0 = acc[ai][bj][m][0], v1 = acc[ai][bj][m][1];
                    if (lora) {
                        if (col < 128) {
#pragma unroll
                            for (int e = 0; e < 4; ++e) { v0[e] = tanhf_(v0[e]); v1[e] = tanhf_(v1[e]); } }
                        else if (col >= 256 && col < 512) {
#pragma unroll
                            for (int e = 0; e < 4; ++e) { v0[e] = sigmoidf_(v0[e]); v1[e] = sigmoidf_(v1[e]); } }
                    }
                    u32x4 w; w.x = pack2(v0[0], v0[1]); w.y = pack2(v0[2], v0[3]); w.z = pack2(v1[0], v1[1]); w.w = pack2(v1[2], v1[3]);
                    *(u32x4*)(C1 + row * R1_N + colbase + col) = w;
                    if (VF && col >= 2048) *(u32x4*)(VF + row * D + (col - 2048)) = w;
                } }
    }
};
template <int CTRL> __device__ __forceinline__ float dpp_shift(float oldv, float src) {
    return __int_as_float(__builtin_amdgcn_update_dpp(__float_as_int(oldv), __float_as_int(src), CTRL, 0xf, 0xf, false));
}
template <int CTRL> __device__ __forceinline__ float dpp_rot(float src) {
    return __int_as_float(__builtin_amdgcn_update_dpp(0, __float_as_int(src), CTRL, 0xf, 0xf, true));
}
struct EpiFfn {
    bf16_t* H; const float* cw; const float* stfc; float* fc_p; float* fc_s; int layer; float* xg;
    __device__ __forceinline__ void operator()(const f32x4 (&acc)[2][2][4][2], const Unit& u, int wr, int wc, int fr, int fq) const {
        if (fr >= 14) {
#pragma unroll
            for (int ai = 0; ai < 2; ++ai)
#pragma unroll
                for (int n = 0; n < 2; ++n) *(f32x4*)(xg + (((((ai * 2 + wr) * 4 + wc) * 2 + n) * 4 + fq) * 2 + (fr - 14)) * 4) = acc[ai][0][3][n];
        }
        asm volatile("s_waitcnt lgkmcnt(0)" ::: "memory");
        __builtin_amdgcn_s_barrier();
        asm volatile("" ::: "memory");
        const int mfirst = 254 * u.pm - 2, ff0 = 128 * u.pn + 32 * wc + 8 * fq;
        f32x4 cw0[2], cw1[2], cw2[2];
#pragma unroll
        for (int n = 0; n < 2; ++n) { cw0[n] = *(const f32x4*)(cw + ff0 + 4 * n); cw1[n] = *(const f32x4*)(cw + DFF + ff0 + 4 * n); cw2[n] = *(const f32x4*)(cw + 2 * DFF + ff0 + 4 * n); }
#pragma unroll
        for (int ai = 0; ai < 2; ++ai) {
#pragma unroll
            for (int m = 0; m < 4; ++m) {
                const int r = 128 * ai + 64 * wr + 16 * m + fr, mg = mfirst + r;
                int seq, t, L; tokdec(mg < 0 ? 0 : mg, seq, t, L);
                const bool live = (r >= 2) && (mg < T);
                u32x2 hw[2];
#pragma unroll
                for (int n = 0; n < 2; ++n) {
                    const int ff = ff0 + 4 * n;
                    const f32x4 g0 = acc[ai][0][m][n], up = acc[ai][1][m][n];
                    f32x4 pf;
                    if (m > 0) pf = acc[ai][0][m - 1][n];
                    else {
                        const int sai = (wr == 1) ? ai : 0, swr = (wr == 1) ? 0 : 1;
                        pf = (f32x4){0.f, 0.f, 0.f, 0.f};
                        if (fr >= 14 && (wr == 1 || ai == 1)) pf = *(const f32x4*)(xg + (((((sai * 2 + swr) * 4 + wc) * 2 + n) * 4 + fq) * 2 + (fr - 14)) * 4);
                    }
                    f32x4 g1, g2;
#pragma unroll
                    for (int e = 0; e < 4; ++e) {
                        g1[e] = dpp_shift<0x111>(dpp_rot<0x121>(pf[e]), g0[e]);
                        g2[e] = dpp_shift<0x112>(dpp_rot<0x122>(pf[e]), g0[e]);
                    }
                    if (live) {
                        if (t < 2) {
                            f32x4 b0 = {0.f, 0.f, 0.f, 0.f}, b1 = b0;
                            if (seq >= 8) { const float* sb = stfc + (((size_t)layer * 128 + (seq - 8)) * 2) * DFF + ff; b0 = *(const f32x4*)sb; b1 = *(const f32x4*)(sb + DFF); }
                            if (t == 0) { g1 = b1; g2 = b0; } else g2 = b1;
                        }
                        const f32x4 cv = cw0[n] * g2 + cw1[n] * g1 + cw2[n] * g0;
                        hw[n].x = pack2(siluf_(cv[0]) * up[0], siluf_(cv[1]) * up[1]); hw[n].y = pack2(siluf_(cv[2]) * up[2], siluf_(cv[3]) * up[3]);
                        if (t >= L - 2) {
                            float* od = (seq < 8) ? fc_p + (((size_t)layer * 8 + seq) * 2 + (t - (L - 2))) * DFF + ff : fc_s + (((size_t)layer * 128 + (seq - 8)) * 2 + (t - (L - 2))) * DFF + ff;
                            *(f32x4*)od = g0;
                        }
                    }
                }
                if (live) { u32x4 w; w.x = hw[0].x; w.y = hw[0].y; w.z = hw[1].x; w.w = hw[1].y; *(u32x4*)(H + (size_t)mg * DFF + ff0) = w; }
            }
        }
    }
};
}

__device__ __forceinline__ void gdn_in_phase(CParams& p, int j, char* smem) {
    const int tid = otid();
    pg8::Gemm g; g.A = p.HN; g.Bt = p.w_in_t + (size_t)j * GIN_NP * D; g.lda = D; g.K = D; g.nM = MPAD / 256; g.nN = GIN_NP / 256; g.A2 = g.A; g.ksplit = 1 << 20; g.agstride = 0; g.npg = 1 << 20; g.brows_tile = 256; g.brows_half = 128; g.arows_tile = 256; g.arow0 = 0; g.perm = 0;
    g.perm = 1;
    pg8::EpiBf16 E; E.O = p.RA; E.ldc = GIN_LD; E.ncol = GIN_LD; E.AB = p.AB;
    pg8::gemm_phase(tid, smem, g, ogrid(), obid(), E);
}
constexpr int RES_MAIN_TILES = 64, RES_ROW0 = RES_MAIN_TILES * 256;
__device__ __forceinline__ void res_gemm_phase(CParams& p, const bf16_t* A, int K, const bf16_t* Bt, char* smem, int rep = 0) {
    const int tid = otid(), lane = tid & 63, wid = tid >> 6, fr = lane & 15, fq = lane >> 4;
    float* X = rep ? (float*)p.RA : p.X;
    pg8::Gemm g; g.A = A; g.Bt = Bt; g.lda = K; g.K = K; g.nM = RES_MAIN_TILES; g.nN = D / 256; g.A2 = g.A; g.ksplit = 1 << 20; g.agstride = 0; g.npg = 1 << 20; g.brows_tile = 256; g.brows_half = 128; g.arows_tile = 256; g.arow0 = 0; g.perm = 0;
    pg8::EpiRes E; E.X = X;
    pg8::gemm_phase(tid, smem, g, ogrid(), obid(), E);
    float* red = (float*)smem;
    const int ksteps = K / 256;
    for (int st = obid(); st < 256; st += ogrid()) {
        const int rb = st >> 5, cb = st & 31;
        const bf16_t* ap = A + (size_t)(RES_ROW0 + rb * 80 + fr) * K + wid * (K / 8) + fq * 8;
        const bf16_t* bp = Bt + (size_t)(cb * 32 + fr) * K + wid * (K / 8) + fq * 8;
        f32x4 acc[5][2];
#pragma unroll
        for (int mf = 0; mf < 5; ++mf) { acc[mf][0] = (f32x4){0.f, 0.f, 0.f, 0.f}; acc[mf][1] = acc[mf][0]; }
        bf16x8 af[4][5], bf[4][2];
#pragma unroll
        for (int sl = 0; sl < 4; ++sl) {
            if (sl < ksteps) {
#pragma unroll
                for (int mf = 0; mf < 5; ++mf) af[sl][mf] = *(const bf16x8*)(ap + (size_t)(mf * 16) * K + sl * 32);
#pragma unroll
                for (int nf = 0; nf < 2; ++nf) bf[sl][nf] = *(const bf16x8*)(bp + (size_t)(nf * 16) * K + sl * 32);
            }
        }
        for (int ks0 = 0; ks0 < ksteps; ks0 += 4) {
#pragma unroll
            for (int sl = 0; sl < 4; ++sl) {
                const int ks = ks0 + sl;
                if (ks < ksteps) {
#pragma unroll
                    for (int mf = 0; mf < 5; ++mf)
#pragma unroll
                        for (int nf = 0; nf < 2; ++nf) acc[mf][nf] = __builtin_amdgcn_mfma_f32_16x16x32_bf16(bf[sl][nf], af[sl][mf], acc[mf][nf], 0, 0, 0);
                    if (ks + 4 < ksteps) {
#pragma unroll
                        for (int mf = 0; mf < 5; ++mf) af[sl][mf] = *(const bf16x8*)(ap + (size_t)(mf * 16) * K + (ks + 4) * 32);
#pragma unroll
                        for (int nf = 0; nf < 2; ++nf) bf[sl][nf] = *(const bf16x8*)(bp + (size_t)(nf * 16) * K + (ks + 4) * 32);
                    }
                }
            }
        }
        float xv[5];
#pragma unroll
        for (int q = 0; q < 5; ++q) { const int o = tid + q * NTH; xv[q] = X[(size_t)(RES_ROW0 + rb * 80 + (o >> 5)) * D + cb * 32 + (o & 31)]; }
#pragma unroll
        for (int mf = 0; mf < 5; ++mf)
#pragma unroll
            for (int nf = 0; nf < 2; ++nf) *(f32x4*)(red + (wid * 80 + mf * 16 + fr) * 32 + nf * 16 + 4 * fq) = acc[mf][nf];
        lds_barrier();
#pragma unroll
        for (int q = 0; q < 5; ++q) {
            const int o = tid + q * NTH, row = o >> 5, col = o & 31;
            float sum = xv[q];
#pragma unroll
            for (int w = 0; w < 8; ++w) sum += red[(w * 80 + row) * 32 + col];
            X[(size_t)(RES_ROW0 + rb * 80 + row) * D + cb * 32 + col] = sum;
        }
        lds_barrier();
    }
}
__device__ __forceinline__ void ffn_up_phase(CParams& p, int layer, char* smem) {
    const int tid = otid();
    pg8::Gemm g; g.A = p.HN; g.Bt = p.up_t + (size_t)layer * (2 * DFF) * D; g.lda = D; g.K = D; g.nM = 68; g.nN = DFF / 128;
    g.A2 = g.A; g.ksplit = 1 << 20; g.agstride = 0; g.npg = 1 << 20; g.brows_tile = 128; g.brows_half = DFF; g.arows_tile = 254; g.arow0 = -2; g.perm = 1;
    pg8::EpiFfn E; E.H = p.RA; E.cw = p.ffn_conv_w + (size_t)layer * 3 * DFF; E.stfc = p.st_fC; E.fc_p = p.fC_p; E.fc_s = p.fC_s; E.layer = layer;
    E.xg = (float*)(smem + 131072 + 1024);
    pg8::gemm_phase(tid, smem, g, ogrid(), obid(), E);
}
constexpr size_t H_OFF = 0;
__device__ __forceinline__ void ffn_act_phase(CParams& p, int layer) {
    const int tid = otid();
    const bf16_t* GU = p.RA; bf16_t* H = p.RA + H_OFF;
    const float* cw = p.ffn_conv_w + (size_t)layer * 3 * DFF;
    constexpr int NCK = DFF / 8, RB = 16, NRB = T / RB;
    for (int idx = obid() * NTH + tid; idx < NRB * NCK; idx += ogrid() * NTH) {
        const int rb = idx / NCK, ck = idx - rb * NCK, ff = ck * 8, mstart = rb * RB;
        float w0[8], w1[8], w2[8], g1[8], g2[8];
#pragma unroll
        for (int q = 0; q < 2; ++q) {
            const f32x4 a0 = *(const f32x4*)(cw + ff + 4 * q), a1 = *(const f32x4*)(cw + DFF + ff + 4 * q), a2 = *(const f32x4*)(cw + 2 * DFF + ff + 4 * q);
#pragma unroll
            for (int e = 0; e < 4; ++e) { w0[4 * q + e] = a0[e]; w1[4 * q + e] = a1[e]; w2[4 * q + e] = a2[e]; }
        }
        {
            const int ma = mstart >= 1 ? mstart - 1 : 0, mb = mstart >= 2 ? mstart - 2 : 0;
            const u32x4 r1 = *(const u32x4*)(GU + (size_t)ma * 2 * DFF + ff), r2 = *(const u32x4*)(GU + (size_t)mb * 2 * DFF + ff);
#pragma unroll
            for (int q = 0; q < 4; ++q) { g1[2 * q] = lo16(r1[q]); g1[2 * q + 1] = hi16(r1[q]); g2[2 * q] = lo16(r2[q]); g2[2 * q + 1] = hi16(r2[q]); }
        }
#pragma unroll 1
        for (int i0 = 0; i0 < RB; i0 += 4) {
            u32x4 g0rr[4], uprr[4];
#pragma unroll
            for (int ii = 0; ii < 4; ++ii) {
                const int m = mstart + i0 + ii;
                g0rr[ii] = *(const u32x4*)(GU + (size_t)m * 2 * DFF + ff); uprr[ii] = *(const u32x4*)(GU + (size_t)m * 2 * DFF + DFF + ff);
            }
#pragma unroll
        for (int ii = 0; ii < 4; ++ii) {
            const int m = mstart + i0 + ii;
            int seq, t, L; tokdec(m, seq, t, L);
            const u32x4 g0r = g0rr[ii], upr = uprr[ii];
            float g0[8], up[8];
#pragma unroll
            for (int q = 0; q < 4; ++q) { g0[2 * q] = lo16(g0r[q]); g0[2 * q + 1] = hi16(g0r[q]); up[2 * q] = lo16(upr[q]); up[2 * q + 1] = hi16(upr[q]); }
            if (t < 2) {
                f32x4 b0a = {0.f, 0.f, 0.f, 0.f}, b0b = b0a, b1a = b0a, b1b = b0a;
                if (seq >= 8) {
                    const float* sb = p.st_fC + (((size_t)layer * 128 + (seq - 8)) * 2) * DFF + ff;
                    b0a = *(const f32x4*)sb; b0b = *(const f32x4*)(sb + 4); b1a = *(const f32x4*)(sb + DFF); b1b = *(const f32x4*)(sb + DFF + 4);
                }
#pragma unroll
                for (int e = 0; e < 8; ++e) {
                    const float s0 = e < 4 ? b0a[e] : b0b[e - 4], s1 = e < 4 ? b1a[e] : b1b[e - 4];
                    if (t == 0) { g1[e] = s1; g2[e] = s0; } else { g2[e] = s1; }
                }
            }
            u32x4 o;
#pragma unroll
            for (int q = 0; q < 4; ++q) {
                const int e0 = 2 * q, e1 = 2 * q + 1;
                const float c0 = w0[e0] * g2[e0] + w1[e0] * g1[e0] + w2[e0] * g0[e0], c1 = w0[e1] * g2[e1] + w1[e1] * g1[e1] + w2[e1] * g0[e1];
                o[q] = pack2(siluf_(c0) * up[e0], siluf_(c1) * up[e1]);
            }
            *(u32x4*)(H + (size_t)m * DFF + ff) = o;
            if (t >= L - 2) {
                float* od = (seq < 8) ? p.fC_p + (((size_t)layer * 8 + seq) * 2 + (t - (L - 2))) * DFF + ff
                                      : p.fC_s + (((size_t)layer * 128 + (seq - 8)) * 2 + (t - (L - 2))) * DFF + ff;
                *(f32x4*)od = (f32x4){g0[0], g0[1], g0[2], g0[3]}; *(f32x4*)(od + 4) = (f32x4){g0[4], g0[5], g0[6], g0[7]};
            }
#pragma unroll
            for (int e = 0; e < 8; ++e) { g2[e] = g1[e]; g1[e] = g0[e]; }
        }
        }
    }
}

__device__ __forceinline__ void rwkv_norm_phase(CParams& p, int layer) {
    const int tid = otid(), lane = tid & 63, wave = tid >> 6;
    const int gw = obid() * 8 + wave, NGW = ogrid() * 8;
    const int j = layer >> 1;
    const float* g = p.norm_mix + layer * D;
    const float* mx = p.rwkv_mix + (size_t)j * 6 * D;
    bf16_t* XR = (bf16_t*)p.RB; bf16_t* XK = XR + (size_t)MPAD * D; bf16_t* XV = XK + (size_t)MPAD * D; bf16_t* PV = XV + (size_t)MPAD * D;
    f32x4 gv[4], mr[4], mk[4], mv[4];
#pragma unroll
    for (int q = 0; q < 4; ++q) {
        gv[q] = *(const f32x4*)(g + q * 256 + lane * 4);
        mr[q] = *(const f32x4*)(mx + 0 * D + q * 256 + lane * 4); mk[q] = *(const f32x4*)(mx + 2 * D + q * 256 + lane * 4); mv[q] = *(const f32x4*)(mx + 3 * D + q * 256 + lane * 4);
    }
    f32x4 nv[4], np_[4];
    auto load_rows = [&](int m) {
        int seq, t, L; tokdec(m, seq, t, L);
        const float* s0 = p.X + (size_t)m * D;
        const float* s1 = (t > 0) ? s0 - D : (seq >= 8 ? p.st_rSh + ((size_t)j * 128 + (seq - 8)) * D : nullptr);
#pragma unroll
        for (int q = 0; q < 4; ++q) { nv[q] = *(const f32x4*)(s0 + q * 256 + lane * 4); np_[q] = s1 ? *(const f32x4*)(s1 + q * 256 + lane * 4) : (f32x4){0.f, 0.f, 0.f, 0.f}; }
    };
    if (gw < T) load_rows(gw);
    for (int m = gw; m < MPAD; m += NGW) {
        if (m >= T) {
            u32x2 z; z.x = 0; z.y = 0;
#pragma unroll
            for (int q = 0; q < 4; ++q) { const size_t o = (size_t)m * D + q * 256 + lane * 4; *(u32x2*)(p.HN + o) = z; *(u32x2*)(XR + o) = z; *(u32x2*)(XK + o) = z; *(u32x2*)(XV + o) = z; *(u32x2*)(PV + o) = z; }
            continue;
        }
        int seq, t, L; tokdec(m, seq, t, L);
        f32x4 v[4], pv[4]; float ss = 0.f, sp = 0.f;
#pragma unroll
        for (int q = 0; q < 4; ++q) { v[q] = nv[q]; pv[q] = np_[q]; ss += v[q].x * v[q].x + v[q].y * v[q].y + v[q].z * v[q].z + v[q].w * v[q].w; sp += pv[q].x * pv[q].x + pv[q].y * pv[q].y + pv[q].z * pv[q].z + pv[q].w * pv[q].w; }
        if (m + NGW < T) load_rows(m + NGW);
        ss = wave_sum(ss); sp = wave_sum(sp);
        const float rstd = rsqrtf(ss * (1.f / D) + 1e-6f);
        const float rstp = (t > 0) ? rsqrtf(sp * (1.f / D) + 1e-6f) : 0.f;
#pragma unroll
        for (int q = 0; q < 4; ++q) {
            const f32x4 h = v[q] * rstd * gv[q];
            const f32x4 pr = (t > 0) ? pv[q] * rstp * gv[q] : pv[q];
            const f32x4 dd = pr - h;
            const f32x4 xr = h + dd * mr[q], xk = h + dd * mk[q], xv = h + dd * mv[q];
            const size_t o = (size_t)m * D + q * 256 + lane * 4;
            u32x2 w;
            w.x = pack2(h.x, h.y); w.y = pack2(h.z, h.w); *(u32x2*)(p.HN + o) = w;
            w.x = pack2(pr.x, pr.y); w.y = pack2(pr.z, pr.w); *(u32x2*)(PV + o) = w;
            w.x = pack2(xr.x, xr.y); w.y = pack2(xr.z, xr.w); *(u32x2*)(XR + o) = w;
            w.x = pack2(xk.x, xk.y); w.y = pack2(xk.z, xk.w); *(u32x2*)(XK + o) = w;
            w.x = pack2(xv.x, xv.y); w.y = pack2(xv.z, xv.w); *(u32x2*)(XV + o) = w;
            if (t == L - 1) {
                float* od = (seq < 8) ? p.rSh_p + ((size_t)j * 8 + seq) * D : p.rSh_s + ((size_t)j * 128 + (seq - 8)) * D;
                *(f32x4*)(od + q * 256 + lane * 4) = h;
            }
        }
    }
}
__device__ __forceinline__ void rwkv_in_phase(CParams& p, int j, char* smem) {
    const int tid = otid(), G = ogrid(), bid = obid();
    constexpr int NLORA = (MPAD / 256) * 3;
    const bool split = G > NLORA + 36;
    {
        pg8::Gemm g; g.A = (const bf16_t*)p.RB; g.Bt = p.rwkv1_t + (size_t)j * 3072 * D; g.lda = D; g.K = D; g.nM = split ? 64 : MPAD / 256; g.nN = 12;
        g.A2 = g.A; g.ksplit = 1 << 20; g.agstride = (size_t)MPAD * D; g.npg = 4; g.brows_tile = 256; g.brows_half = 128; g.arows_tile = 256; g.arow0 = 0; g.perm = 0;
        g.perm = 1;
        pg8::EpiRwkv1 E; E.C1 = p.RA; E.VF = (j == 0) ? p.VFIRST : nullptr; E.colbase = 0; E.lora = 0; E.rowbase = 0;
        pg8::gemm_phase(tid, smem, g, G, bid, E);
    }
    if (!split || bid < NLORA) {
        pg8::Gemm g; g.A = p.HN; g.Bt = p.l1t + (size_t)j * 768 * 2048; g.lda = D; g.K = 2048; g.nM = MPAD / 256; g.nN = 3;
        g.A2 = (const bf16_t*)(p.RB + 3 * (size_t)MPAD * D * 2); g.ksplit = 16; g.agstride = 0; g.npg = 1 << 20; g.brows_tile = 256; g.brows_half = 128; g.arows_tile = 256; g.arow0 = 0; g.perm = 0;
        g.perm = 1;
        pg8::EpiRwkv1 E; E.C1 = p.RA; E.VF = nullptr; E.colbase = 3072; E.lora = 1; E.rowbase = 0;
        pg8::gemm_phase(tid, smem, g, G, bid, E);
    } else {
        pg8::Gemm g; g.A = (const bf16_t*)p.RB; g.Bt = p.rwkv1_t + (size_t)j * 3072 * D; g.lda = D; g.K = D; g.nM = 3; g.nN = 12;
        g.A2 = g.A; g.ksplit = 1 << 20; g.agstride = (size_t)MPAD * D; g.npg = 4; g.brows_tile = 256; g.brows_half = 128; g.arows_tile = 256; g.arow0 = 64 * 256; g.perm = 0;
        g.perm = 1;
        pg8::EpiRwkv1 E; E.C1 = p.RA; E.VF = (j == 0) ? p.VFIRST : nullptr; E.colbase = 0; E.lora = 0; E.rowbase = 64 * 256;
        pg8::gemm_phase(tid, smem, g, G - NLORA, bid - NLORA, E);
    }
}
__device__ __forceinline__ void rwkv_lora_phase(CParams& p, int j, char* smem) {
    const int tid = otid(), lane = tid & 63, wid = tid >> 6, wr = wid >> 1, wc = wid & 1, fr = lane & 15, fq = lane >> 4;
    const int nMt = MPAD / 256, nNt = 8, ngrp = (j == 0) ? 3 : 4, total = nMt * nNt * ngrp, G = ogrid();
    const bf16_t* C1 = p.RA;
    char* As = smem; char* Bs = smem + 2 * A_STAGE;
    ALoadPlain al; BLoad bl;
    auto setup = [&](int u, int& grp, int& m0, int& n0, int& nkt) {
        grp = u / (nMt * nNt); const int r = u - grp * nMt * nNt, nt = r / nMt, mt = r - nt * nMt; m0 = mt * 256; n0 = nt * 128;
        const int acol = grp == 0 ? 3072 : grp == 1 ? 3200 : grp == 2 ? 3328 : 3584;
        const int K = grp == 2 ? 192 : 64; nkt = K / 64;
        const bf16_t* Bt = grp == 0 ? p.w2t + (size_t)j * D * 64 : grp == 1 ? p.a2t + (size_t)j * D * 64 : grp == 2 ? p.g2t + (size_t)j * D * 192 : p.v2t;
        al.init(tid, C1 + acol, R1_N, m0, MPAD - 1);
        bl.init(tid, Bt + (size_t)n0 * K, Bt + (size_t)(n0 + 64) * K, K);
    };
    int u = obid(), st = 0;
    int grp = 0, m0 = 0, n0 = 0, nkt = 1;
    if (u < total) { setup(u, grp, m0, n0, nkt); al.issue(0); bl.issue(0); }
    for (; u < total; u += G) {
        const int cgrp = grp, cm0 = m0, cn0 = n0, cnkt = nkt;
        f32x4 acc[4][4];
#pragma unroll
        for (int a = 0; a < 4; ++a)
#pragma unroll
            for (int b = 0; b < 4; ++b) acc[a][b] = (f32x4){0.f, 0.f, 0.f, 0.f};
        for (int kt = 0; kt < cnkt; ++kt) {
            al.commit(As + st * A_STAGE); bl.commit(Bs + st * B_STAGE);
            lds_barrier();
            if (kt + 1 < cnkt) { al.issue(kt + 1); bl.issue(kt + 1); }
            else if (u + G < total) { setup(u + G, grp, m0, n0, nkt); al.issue(0); bl.issue(0); }
            const char* Ac = As + st * A_STAGE; const char* Bc = Bs + st * B_STAGE;
#pragma unroll
            for (int ks = 0; ks < 2; ++ks) {
                bf16x8 af[4], bfr[4];
#pragma unroll
                for (int mf = 0; mf < 4; ++mf) af[mf] = *(const bf16x8*)(Ac + lds_off(wr * 64 + mf * 16 + fr, ks * 32 + fq * 8));
#pragma unroll
                for (int nf = 0; nf < 4; ++nf) bfr[nf] = *(const bf16x8*)(Bc + lds_off(wc * 64 + nf * 16 + fr, ks * 32 + fq * 8));
#pragma unroll
                for (int mf = 0; mf < 4; ++mf)
#pragma unroll
                    for (int nf = 0; nf < 4; ++nf) acc[mf][nf] = __builtin_amdgcn_mfma_f32_16x16x32_bf16(bfr[nf], af[mf], acc[mf][nf], 0, 0, 0);
            }
            st ^= 1;
        }
        bf16_t* O = (bf16_t*)(p.RB + (size_t)cgrp * MPAD * D * 2);
        const float* bias = cgrp == 0 ? p.rwkv_w0 + (size_t)j * D : cgrp == 1 ? p.rwkv_a0 + (size_t)j * D : cgrp == 3 ? p.rwkv_v0 : nullptr;
#pragma unroll
        for (int mf = 0; mf < 4; ++mf) {
            const int m = cm0 + wr * 64 + mf * 16 + fr;
#pragma unroll
            for (int nf = 0; nf < 4; ++nf) {
                const int n = cn0 + wc * 64 + nf * 16 + 4 * fq;
                f32x4 v = acc[mf][nf];
                if (bias) v = v + *(const f32x4*)(bias + n);
                if (cgrp != 2) { v[0] = sigmoidf_(v[0]); v[1] = sigmoidf_(v[1]); v[2] = sigmoidf_(v[2]); v[3] = sigmoidf_(v[3]); }
                if (cgrp == 0) v = v * 0.60653066f;
                u32x2 w; w.x = pack2(v[0], v[1]); w.y = pack2(v[2], v[3]);
                *(u32x2*)(O + (size_t)m * D + n) = w;
            }
        }
    }
    lds_barrier();
}

__device__ __forceinline__ int perm32k(int kl) { return 8 * ((kl >> 2) & 3) + 4 * (kl >> 4) + (kl & 3); }
__device__ __forceinline__ void gdn_prep_phase(CParams& p, int j, char* smem) {
    int tid = otid(), lane = tid & 63, wid = tid >> 6, fr = lane & 15, fq = lane >> 4;
    bf16_t* qs = (bf16_t*)smem;
    bf16_t* ks = (bf16_t*)(smem + 17408);
    float* rhs = (float*)(smem + 34816);
    float* Am = (float*)(smem + 100352);
    float* Gs = (float*)(smem + 117760);
    float* betas = (float*)(smem + 118016);
    float* gs = (float*)(smem + 118272);
    float* cwl = (float*)(smem + 118528);
    float* Tinv = (float*)(smem + 124672);
    bf16_t* AmB = qs;
    bf16_t* XT = ks;
    const bf16_t* PROJ = p.RA;
    int c8 = tid & 15, rg = tid >> 4, r0 = 2 * rg;
    const int G = ogrid(), bid = obid();
    const bool sticky = (G & 7) == 0;
    const int nitems = sticky ? 8 * NCHUNK : 64 * NCHUNK, istep = sticky ? (G >> 3) : G;
    int q0 = sticky ? (bid >> 3) : bid;
    auto item_of = [&](int q, int& b, int& h, int& n) { if (sticky) { h = bid & 7; b = q / NCHUNK; n = q - b * NCHUNK; } else { n = q % NCHUNK; const int bh = q / NCHUNK; h = bh & 7; b = bh >> 3; } };
    u32x4 rawp[3][5]; float abp[4];
    auto load_raw = [&](int q) {
        int b, h, n; item_of(q, b, h, n);
        const int c = (n == 0) ? 16 : 64, tstart = (n == 0) ? 0 : 16 + 64 * (n - 1);
#pragma unroll
        for (int part = 0; part < 3; ++part) {
            const int col = part * 1024 + h * 128 + c8 * 8;
#pragma unroll
            for (int i = 0; i < 5; ++i) {
                const int r = r0 - 3 + i, t = tstart + r;
                u32x4 v = {0u, 0u, 0u, 0u};
                if (t >= 0 && r < c) v = *(const u32x4*)(PROJ + (size_t)(b * LP + t) * GIN_LD + col);
                rawp[part][i] = v;
            }
        }
#pragma unroll
        for (int rr = 0; rr < 2; ++rr) {
            const int r = r0 + rr;
            abp[2 * rr] = 0.f; abp[2 * rr + 1] = 0.f;
            if (r < c) { abp[2 * rr] = p.AB[(size_t)(b * LP + tstart + r) * 16 + h]; abp[2 * rr + 1] = p.AB[(size_t)(b * LP + tstart + r) * 16 + 8 + h]; }
        }
    };
    int cur_h = -1; float Aexp = 0.f, dtb = 0.f;
    if (q0 < nitems) load_raw(q0);
    for (int q = q0; q < nitems; q += istep) {
        asm volatile("" : "+v"(tid));
        lane = tid & 63; wid = tid >> 6; fr = lane & 15; fq = lane >> 4; c8 = tid & 15; rg = tid >> 4; r0 = 2 * rg;
        int b, h, n; item_of(q, b, h, n);
        const int item = (b * 8 + h) * NCHUNK + n;
        const int c = (n == 0) ? 16 : 64;
        char* rec = p.RB + (size_t)item * CH_BYTES;
        if (h != cur_h) {
            lds_barrier();
            for (int idx = tid; idx < 3 * 4 * 128; idx += NTH) { const int cc = idx & 127, jj = (idx >> 7) & 3, part = idx >> 9; cwl[idx] = p.gdn_conv_w[((size_t)j * 4 + jj) * 3072 + part * 1024 + h * 128 + cc]; }
            Aexp = __expf(p.gdn_A_log[j * 8 + h]); dtb = p.gdn_dt_bias[j * 8 + h];
            cur_h = h;
            lds_barrier();
        }
        float bet[2], gg[2];
#pragma unroll
        for (int rr = 0; rr < 2; ++rr) {
            const int r = r0 + rr;
            if (r < c) { gg[rr] = -Aexp * softplusf_(abp[2 * rr] + dtb); bet[rr] = sigmoidf_(abp[2 * rr + 1]); }
            else { gg[rr] = 0.f; bet[rr] = 0.f; }
            if (c8 == 0) { gs[r] = gg[rr]; betas[r] = bet[rr]; }
        }
#pragma unroll
        for (int pi = 0; pi < 3; ++pi) {
            const int part = (pi == 0) ? 2 : (pi == 1 ? 0 : 1);
            float o[2][8];
#pragma unroll
            for (int e = 0; e < 8; ++e) { o[0][e] = 0.f; o[1][e] = 0.f; }
#pragma unroll
            for (int jj = 0; jj < 4; ++jj) {
                const f32x4 w0 = *(const f32x4*)(cwl + (part * 4 + jj) * 128 + c8 * 8), w1 = *(const f32x4*)(cwl + (part * 4 + jj) * 128 + c8 * 8 + 4);
                const u32x4 ra = rawp[part][jj], rb = rawp[part][jj + 1];
#pragma unroll
                for (int qq = 0; qq < 4; ++qq) {
                    const float wa = qq < 2 ? w0[2 * qq] : w1[2 * qq - 4], wb = qq < 2 ? w0[2 * qq + 1] : w1[2 * qq - 3];
                    o[0][2 * qq] += wa * lo16(ra[qq]); o[0][2 * qq + 1] += wb * hi16(ra[qq]);
                    o[1][2 * qq] += wa * lo16(rb[qq]); o[1][2 * qq + 1] += wb * hi16(rb[qq]);
                }
            }
#pragma unroll
            for (int rr = 0; rr < 2; ++rr) {
                const int r = r0 + rr;
#pragma unroll
                for (int e = 0; e < 8; ++e) o[rr][e] = (r < c) ? siluf_(o[rr][e]) : 0.f;
                if (part == 2) {
                    f32x4 v0, v1;
#pragma unroll
                    for (int e = 0; e < 4; ++e) { v0[e] = o[rr][e] * bet[rr]; v1[e] = o[rr][e + 4] * bet[rr]; }
                    *(f32x4*)(rhs + r * 256 + c8 * 8) = v0; *(f32x4*)(rhs + r * 256 + c8 * 8 + 4) = v1;
                } else {
                    float ss = 0.f;
#pragma unroll
                    for (int e = 0; e < 8; ++e) ss += o[rr][e] * o[rr][e];
                    ss = row16_sum(ss);
                    const float rn = rsqrtf(ss + 1e-6f) * (part == 0 ? 0.08838834764831845f : 1.f);
                    u32x4 w;
#pragma unroll
                    for (int qq = 0; qq < 4; ++qq) w[qq] = pack2(o[rr][2 * qq] * rn, o[rr][2 * qq + 1] * rn);
                    *(u32x4*)((part == 0 ? qs : ks) + r * 136 + c8 * 8) = w;
                }
            }
            __builtin_amdgcn_sched_barrier(0);
        }
        if (q + istep < nitems) load_raw(q + istep);
        lds_barrier();
        if (wid == 0) {
            float x = gs[lane];
#pragma unroll
            for (int o = 1; o < 64; o <<= 1) { const float y = __shfl_up(x, o); if (lane >= o) x += y; }
            Gs[lane] = x;
        }
        lds_barrier();
        const float glast = Gs[63];
#pragma unroll
        for (int rr = 0; rr < 2; ++rr) {
            const int r = r0 + rr; const float eg = __expf(Gs[r]), be = betas[r] * eg;
            const u32x4 kq = *(const u32x4*)(ks + r * 136 + c8 * 8), qq_ = *(const u32x4*)(qs + r * 136 + c8 * 8);
            f32x4 v0, v1;
            v0[0] = lo16(kq[0]) * be; v0[1] = hi16(kq[0]) * be; v0[2] = lo16(kq[1]) * be; v0[3] = hi16(kq[1]) * be;
            v1[0] = lo16(kq[2]) * be; v1[1] = hi16(kq[2]) * be; v1[2] = lo16(kq[3]) * be; v1[3] = hi16(kq[3]) * be;
            *(f32x4*)(rhs + r * 256 + 128 + c8 * 8) = v0; *(f32x4*)(rhs + r * 256 + 128 + c8 * 8 + 4) = v1;
            u32x4 wq;
#pragma unroll
            for (int e = 0; e < 4; ++e) wq[e] = pack2(lo16(qq_[e]) * eg, hi16(qq_[e]) * eg);
            { const int kb32 = (c8 * 8) & ~31, kl = (c8 * 8) & 31;
              u32x2 lo; lo.x = wq[0]; lo.y = wq[1]; u32x2 hi; hi.x = wq[2]; hi.y = wq[3];
              *(u32x2*)(rec + 32768 + ((size_t)r * 128 + kb32 + perm32k(kl)) * 2) = lo;
              *(u32x2*)(rec + 32768 + ((size_t)r * 128 + kb32 + perm32k(kl + 4)) * 2) = hi; }
        }
        {
            const int mat = wid >> 2, ifr = wid & 3;
            const bf16_t* Xs = mat ? qs : ks;
            f32x4 acc[4];
#pragma unroll
            for (int jf = 0; jf < 4; ++jf) acc[jf] = (f32x4){0.f, 0.f, 0.f, 0.f};
#pragma unroll
            for (int kk = 0; kk < 4; ++kk) {
                const bf16x8 xf = *(const bf16x8*)(Xs + (ifr * 16 + fr) * 136 + kk * 32 + fq * 8);
#pragma unroll
                for (int jf = 0; jf < 4; ++jf) {
                    if (jf <= ifr) {
                        const bf16x8 yf = *(const bf16x8*)(ks + (jf * 16 + fr) * 136 + kk * 32 + fq * 8);
                        acc[jf] = __builtin_amdgcn_mfma_f32_16x16x32_bf16(xf, yf, acc[jf], 0, 0, 0);
                    }
                }
            }
#pragma unroll
            for (int jf = 0; jf < 4; ++jf) {
                const int jc = jf * 16 + fr; const float Gj = Gs[jc];
#pragma unroll
                for (int reg = 0; reg < 4; ++reg) {
                    const int i = ifr * 16 + 4 * fq + reg;
                    const float dec = __expf(Gs[i] - Gj);
                    if (mat == 0) { Am[i * 68 + jc] = (i > jc) ? betas[i] * acc[jf][reg] * dec : 0.f; }
                    else { const float v = (i >= jc) ? acc[jf][reg] * dec : 0.f; *(bf16_t*)(rec + 65536 + ((size_t)i * 64 + (jc & ~31) + perm32k(jc & 31)) * 2) = (bf16_t)f2bf(v); }
                }
            }
        }
        lds_barrier();
        {
            const int k = tid >> 2, jq = tid & 3;
            u32x4 o0, o1;
#pragma unroll
            for (int e = 0; e < 8; ++e) {
                const int ja = jq * 16 + 2 * e, jb = ja + 1;
                const float va = bf2f(ks[ja * 136 + k]) * __expf(glast - Gs[ja]), vb = bf2f(ks[jb * 136 + k]) * __expf(glast - Gs[jb]);
                if (e < 4) o0[e] = pack2(va, vb); else o1[e - 4] = pack2(va, vb);
            }
            { const int jb32 = (jq >> 1) * 32, hh = jq & 1;
              u32x2 g0; g0.x = o0[0]; g0.y = o0[1]; u32x2 g1; g1.x = o0[2]; g1.y = o0[3]; u32x2 g2; g2.x = o1[0]; g2.y = o1[1]; u32x2 g3; g3.x = o1[2]; g3.y = o1[3];
              char* kb_ = rec + 49152 + ((size_t)k * 64 + jb32 + 4 * hh) * 2;
              *(u32x2*)(kb_) = g0; *(u32x2*)(kb_ + 16) = g1; *(u32x2*)(kb_ + 32) = g2; *(u32x2*)(kb_ + 48) = g3; }
        }
        if (tid == 0) p.GL[item] = __expf(glast);
        lds_barrier();
        if (wid == 0) {
            const int bk = lane >> 4, cidx = lane & 15;
            float tcol[16];
#pragma unroll
            for (int i = 0; i < 16; ++i) {
                float sacc = (i == cidx) ? 1.f : 0.f;
#pragma unroll
                for (int jj = 0; jj < i; ++jj) sacc -= Am[(16 * bk + i) * 68 + 16 * bk + jj] * tcol[jj];
                tcol[i] = sacc;
            }
#pragma unroll
            for (int i = 0; i < 16; ++i) Tinv[(bk * 16 + i) * 16 + cidx] = tcol[i];
        } else {
            for (int idx = tid - 64; idx < 64 * 32; idx += NTH - 64) { const int i = idx >> 5, j2 = (idx & 31) * 2; *(unsigned*)(AmB + i * 72 + j2) = pack2(-Am[i * 68 + j2], -Am[i * 68 + j2 + 1]); }
        }
        lds_barrier();
#pragma unroll 1
        for (int blk = 0; blk < 4; ++blk) {
#pragma unroll
            for (int c2 = 0; c2 < 2; ++c2) {
                const int ct = wid * 2 + c2;
                f32x4 xacc = {0.f, 0.f, 0.f, 0.f};
#pragma unroll
                for (int kq = 0; kq < 4; ++kq) {
                    const float av = Tinv[(blk * 16 + fr) * 16 + 4 * kq + fq];
                    const float bv = rhs[(16 * blk + 4 * kq + fq) * 256 + ct * 16 + fr];
                    xacc = __builtin_amdgcn_mfma_f32_16x16x4f32(av, bv, xacc, 0, 0, 0);
                }
#pragma unroll
                for (int reg = 0; reg < 4; ++reg) rhs[(16 * blk + 4 * fq + reg) * 256 + ct * 16 + fr] = xacc[reg];
                u32x2 xt; xt.x = pack2(xacc[0], xacc[1]); xt.y = pack2(xacc[2], xacc[3]);
                *(u32x2*)(XT + (ct * 16 + fr) * 24 + 4 * fq) = xt;
            }
            lds_barrier();
            if (blk < 3) {
                const int ntile = (3 - blk) * 16;
                for (int tl = wid; tl < ntile; tl += 8) {
                    const int rt = blk + 1 + (tl >> 4), ct = tl & 15;
                    f32x4 cacc;
#pragma unroll
                    for (int reg = 0; reg < 4; ++reg) cacc[reg] = rhs[(rt * 16 + 4 * fq + reg) * 256 + ct * 16 + fr];
                    u32x4 az = {0u, 0u, 0u, 0u}, bz = az;
                    if (fq < 2) { az = *(const u32x4*)(AmB + (rt * 16 + fr) * 72 + 16 * blk + 8 * fq); bz = *(const u32x4*)(XT + (ct * 16 + fr) * 24 + 8 * fq); }
                    cacc = __builtin_amdgcn_mfma_f32_16x16x32_bf16(__builtin_bit_cast(bf16x8, az), __builtin_bit_cast(bf16x8, bz), cacc, 0, 0, 0);
#pragma unroll
                    for (int reg = 0; reg < 4; ++reg) rhs[(rt * 16 + 4 * fq + reg) * 256 + ct * 16 + fr] = cacc[reg];
                }
                lds_barrier();
            }
        }
#pragma unroll
        for (int qq = 0; qq < 2; ++qq) {
            const int ch = tid + qq * NTH;
            { const int v = ch >> 3, i8 = (ch & 7) * 8;
              u32x4 o;
#pragma unroll
              for (int e = 0; e < 4; ++e) o[e] = pack2(rhs[(i8 + 2 * e) * 256 + v], rhs[(i8 + 2 * e + 1) * 256 + v]);
              *(u32x4*)(rec + ((size_t)v * 64 + i8) * 2) = o; }
            { const int i = ch >> 4, k8 = (ch & 15) * 8;
              const f32x4 a0 = *(const f32x4*)(rhs + i * 256 + 128 + k8), a1 = *(const f32x4*)(rhs + i * 256 + 128 + k8 + 4);
              u32x2 lo; lo.x = pack2(-a0[0], -a0[1]); lo.y = pack2(-a0[2], -a0[3]); u32x2 hi; hi.x = pack2(-a1[0], -a1[1]); hi.y = pack2(-a1[2], -a1[3]);
              const int kb32 = k8 & ~31, kl = k8 & 31;
              *(u32x2*)(rec + 16384 + ((size_t)i * 128 + kb32 + perm32k(kl)) * 2) = lo;
              *(u32x2*)(rec + 16384 + ((size_t)i * 128 + kb32 + perm32k(kl + 4)) * 2) = hi; }
        }
        if (n == NCHUNK - 1) {
            for (int idx = tid; idx < 3 * 3 * 128; idx += NTH) {
                const int cc = idx & 127, part = (idx >> 7) % 3, r = idx / 384;
                const int col = part * 1024 + h * 128 + cc;
                p.gC_p[(((size_t)j * 8 + b) * 3 + r) * 3072 + col] = bf2f(PROJ[(size_t)(b * LP + LP - 3 + r) * GIN_LD + col]);
            }
        }
        lds_barrier();
    }
}

__device__ __forceinline__ bf16x8 xfrag(const char* base, int row, int stride, int kbase, int fq) {
    return *(const bf16x8*)(base + row * stride + (kbase + 8 * fq) * 2);
}
__device__ __forceinline__ bf16x8 pack8(const f32x4& a, const f32x4& b) {
    u32x4 r; r.x = pack2(a[0], a[1]); r.y = pack2(a[2], a[3]); r.z = pack2(b[0], b[1]); r.w = pack2(b[2], b[3]);
    return __builtin_bit_cast(bf16x8, r);
}
__device__ __forceinline__ void gdn_scan_prompt_item(CParams& p, int j, int bh, char* smem) {
    int tid = otid(), lane = tid & 63, wid = tid >> 6, fr = lane & 15, fq = lane >> 4;
    const int h = bh & 7, b = bh >> 3; int v0 = 16 * wid;
    char* UT = smem; char* WN = smem + 18432; char* QG = smem + 35840; char* KDT = smem + 53248; char* QKM = smem + 71680;
    float* OT = (float*)(smem + 80896);
    const bf16_t* PROJ = p.RA; bf16_t* OG = p.HN;
    f32x4 S[8];
#pragma unroll
    for (int kf = 0; kf < 8; ++kf) S[kf] = (f32x4){0.f, 0.f, 0.f, 0.f};
    int cv = tid & 15, orow = tid >> 4;
    const f32x4 nw0 = *(const f32x4*)(p.gdn_norm_w + j * 128 + cv * 8), nw1 = *(const f32x4*)(p.gdn_norm_w + j * 128 + cv * 8 + 4);
    u32x4 pre[9], zpre[2];
    const char* rec0 = p.RB + (size_t)(bh * NCHUNK) * CH_BYTES;
#pragma unroll
    for (int i = 0; i < 9; ++i) pre[i] = *(const u32x4*)(rec0 + (size_t)(tid + 512 * i) * 16);
    float gl_pre = p.GL[bh * NCHUNK];
    for (int n = 0; n < NCHUNK; ++n) {
        asm volatile("" : "+v"(tid));
        lane = tid & 63; wid = tid >> 6; fr = lane & 15; fq = lane >> 4; v0 = 16 * wid; cv = tid & 15; orow = tid >> 4;
#pragma unroll
        for (int i = 0; i < 9; ++i) {
            const int idx = tid + 512 * i;
            char* dst;
            if (i < 2) { const int li = idx; dst = UT + (li >> 3) * 144 + (li & 7) * 16; }
            else if (i < 4) { const int li = idx - 1024; dst = WN + (li >> 4) * 272 + (li & 15) * 16; }
            else if (i < 6) { const int li = idx - 2048; dst = QG + (li >> 4) * 272 + (li & 15) * 16; }
            else if (i < 8) { const int li = idx - 3072; dst = KDT + (li >> 3) * 144 + (li & 7) * 16; }
            else { const int li = idx - 4096; dst = QKM + (li >> 3) * 144 + (li & 7) * 16; }
            *(u32x4*)dst = pre[i];
        }
        const float gl = gl_pre;
        lds_barrier();
        const int c = (n == 0) ? 16 : 64, tstart = (n == 0) ? 0 : 16 + 64 * (n - 1);
        if (n + 1 < NCHUNK) {
            const char* recn = rec0 + (size_t)(n + 1) * CH_BYTES;
#pragma unroll
            for (int i = 0; i < 9; ++i) pre[i] = *(const u32x4*)(recn + (size_t)(tid + 512 * i) * 16);
            gl_pre = p.GL[bh * NCHUNK + n + 1];
        }
#pragma unroll
        for (int q = 0; q < 2; ++q) {
            const int i = orow + 32 * q;
            const size_t m = (size_t)b * LP + tstart + (i < c ? i : 0);
            zpre[q] = *(const u32x4*)(PROJ + m * GIN_LD + 3072 + h * 128 + cv * 8);
        }
        bf16x8 Sb[4];
#pragma unroll
        for (int ks = 0; ks < 4; ++ks) Sb[ks] = pack8(S[2 * ks], S[2 * ks + 1]);
        f32x4 vn[4], o[4];
#pragma unroll
        for (int f = 0; f < 4; ++f) {
            const u32x2 raw = *(const u32x2*)(UT + (v0 + fr) * 144 + (16 * f + 4 * fq) * 2);
            vn[f] = (f32x4){lo16(raw.x), hi16(raw.x), lo16(raw.y), hi16(raw.y)};
            o[f] = (f32x4){0.f, 0.f, 0.f, 0.f};
        }
#pragma unroll
        for (int kb = 0; kb < 2; ++kb) {
            bf16x8 xw[2][4], xq[2][4];
#pragma unroll
            for (int k2 = 0; k2 < 2; ++k2)
#pragma unroll
                for (int f = 0; f < 4; ++f) { xw[k2][f] = xfrag(WN, 16 * f + fr, 272, 32 * (2 * kb + k2), fq); xq[k2][f] = xfrag(QG, 16 * f + fr, 272, 32 * (2 * kb + k2), fq); }
            __builtin_amdgcn_sched_barrier(0);
#pragma unroll
            for (int k2 = 0; k2 < 2; ++k2)
#pragma unroll
                for (int f = 0; f < 4; ++f) {
                    vn[f] = __builtin_amdgcn_mfma_f32_16x16x32_bf16(xw[k2][f], Sb[2 * kb + k2], vn[f], 0, 0, 0);
                    o[f] = __builtin_amdgcn_mfma_f32_16x16x32_bf16(xq[k2][f], Sb[2 * kb + k2], o[f], 0, 0, 0);
                }
            __builtin_amdgcn_sched_barrier(0);
        }
        bf16x8 Vb[2];
        Vb[0] = pack8(vn[0], vn[1]); Vb[1] = pack8(vn[2], vn[3]);
        {
            bf16x8 xm[2][4], xk0[2][4];
#pragma unroll
            for (int js = 0; js < 2; ++js)
#pragma unroll
                for (int f = 0; f < 4; ++f) { xm[js][f] = xfrag(QKM, 16 * f + fr, 144, 32 * js, fq); xk0[js][f] = xfrag(KDT, 16 * f + fr, 144, 32 * js, fq); }
            __builtin_amdgcn_sched_barrier(0);
#pragma unroll
            for (int js = 0; js < 2; ++js)
#pragma unroll
                for (int f = 0; f < 4; ++f) o[f] = __builtin_amdgcn_mfma_f32_16x16x32_bf16(xm[js][f], Vb[js], o[f], 0, 0, 0);
#pragma unroll
            for (int kf = 0; kf < 4; ++kf) {
                S[kf] = S[kf] * gl;
#pragma unroll
                for (int js = 0; js < 2; ++js) S[kf] = __builtin_amdgcn_mfma_f32_16x16x32_bf16(xk0[js][kf], Vb[js], S[kf], 0, 0, 0);
            }
            __builtin_amdgcn_sched_barrier(0);
        }
        {
            bf16x8 xk1[2][4];
#pragma unroll
            for (int js = 0; js < 2; ++js)
#pragma unroll
                for (int f = 0; f < 4; ++f) xk1[js][f] = xfrag(KDT, 16 * (4 + f) + fr, 144, 32 * js, fq);
#pragma unroll
            for (int f = 0; f < 4; ++f)
#pragma unroll
                for (int reg = 0; reg < 4; ++reg) OT[(16 * f + 4 * fq + reg) * 132 + v0 + fr] = o[f][reg];
            __builtin_amdgcn_sched_barrier(0);
#pragma unroll
            for (int kf = 4; kf < 8; ++kf) {
                S[kf] = S[kf] * gl;
#pragma unroll
                for (int js = 0; js < 2; ++js) S[kf] = __builtin_amdgcn_mfma_f32_16x16x32_bf16(xk1[js][kf - 4], Vb[js], S[kf], 0, 0, 0);
            }
        }
        lds_barrier();
#pragma unroll
        for (int q = 0; q < 2; ++q) {
            const int i = orow + 32 * q;
            const f32x4 a0 = *(const f32x4*)(OT + i * 132 + cv * 8), a1 = *(const f32x4*)(OT + i * 132 + cv * 8 + 4);
            float ss = a0[0] * a0[0] + a0[1] * a0[1] + a0[2] * a0[2] + a0[3] * a0[3] + a1[0] * a1[0] + a1[1] * a1[1] + a1[2] * a1[2] + a1[3] * a1[3];
            ss = row16_sum(ss);
            const float rstd = rsqrtf(ss * (1.f / 128.f) + 1e-6f);
            if (i < c) {
                const u32x4 z = zpre[q];
                u32x4 w;
                w.x = pack2(a0[0] * rstd * nw0[0] * siluf_(lo16(z.x)), a0[1] * rstd * nw0[1] * siluf_(hi16(z.x)));
                w.y = pack2(a0[2] * rstd * nw0[2] * siluf_(lo16(z.y)), a0[3] * rstd * nw0[3] * siluf_(hi16(z.y)));
                w.z = pack2(a1[0] * rstd * nw1[0] * siluf_(lo16(z.z)), a1[1] * rstd * nw1[1] * siluf_(hi16(z.z)));
                w.w = pack2(a1[2] * rstd * nw1[2] * siluf_(lo16(z.w)), a1[3] * rstd * nw1[3] * siluf_(hi16(z.w)));
                const size_t m = (size_t)b * LP + tstart + i;
                *(u32x4*)(OG + m * D + h * 128 + cv * 8) = w;
            }
        }
    }
    float* So = p.gS_p + (((size_t)j * 8 + b) * 8 + h) * 16384;
#pragma unroll
    for (int kf = 0; kf < 8; ++kf)
#pragma unroll
        for (int reg = 0; reg < 4; ++reg) So[(size_t)(16 * kf + 4 * fq + reg) * 128 + v0 + fr] = S[kf][reg];
    lds_barrier();
}
__device__ __forceinline__ void gdn_sample_item(CParams& p, int j, int item, char* smem) {
    const int tid = otid(), lane = tid & 63, wid = tid >> 6;
    const int h = item & 7, b = item >> 3;
    float* qn = (float*)smem;
    float* kn = qn + 512;
    float* vv = kn + 512;
    float* gb = vv + 512;
    float* wred = gb + 8;
    float* red = wred + 24;
    float* osum = red + 2048;
    const bf16_t* PROJ = p.RA; bf16_t* OG = p.HN;
    const int mbase = TP + b * 4;
    {
        const int t = tid >> 7, c = tid & 127;
        float val[3];
#pragma unroll
        for (int part = 0; part < 3; ++part) {
            const int col = part * 1024 + h * 128 + c;
            float acc = 0.f;
#pragma unroll
            for (int jj = 0; jj < 4; ++jj) {
                const int xi = t + jj;
                const float x = xi < 3 ? p.st_gC[(((size_t)j * 128 + b) * 3 + xi) * 3072 + col] : bf2f(PROJ[(size_t)(mbase + xi - 3) * GIN_LD + col]);
                acc += p.gdn_conv_w[((size_t)j * 4 + jj) * 3072 + col] * x;
            }
            val[part] = siluf_(acc);
        }
        float sq = wave_sum(val[0] * val[0]), sk = wave_sum(val[1] * val[1]);
        if (lane == 0) { wred[wid * 2] = sq; wred[wid * 2 + 1] = sk; }
        lds_barrier();
        sq = wred[(2 * t) * 2] + wred[(2 * t + 1) * 2]; sk = wred[(2 * t) * 2 + 1] + wred[(2 * t + 1) * 2 + 1];
        qn[t * 128 + c] = val[0] * rsqrtf(sq + 1e-6f) * 0.08838834764831845f;
        kn[t * 128 + c] = val[1] * rsqrtf(sk + 1e-6f);
        vv[t * 128 + c] = val[2];
        if (tid < 4) {
            const float av = p.AB[(size_t)(mbase + tid) * 16 + h], bv = p.AB[(size_t)(mbase + tid) * 16 + 8 + h];
            gb[tid] = -__expf(p.gdn_A_log[j * 8 + h]) * softplusf_(av + p.gdn_dt_bias[j * 8 + h]);
            gb[4 + tid] = sigmoidf_(bv);
        }
    }
    for (int idx = tid; idx < 3 * 3 * 128; idx += NTH) {
        const int cc = idx & 127, part = (idx >> 7) % 3, r = idx / 384;
        const int col = part * 1024 + h * 128 + cc;
        p.gC_s[(((size_t)j * 128 + b) * 3 + r) * 3072 + col] = bf2f(PROJ[(size_t)(mbase + 1 + r) * GIN_LD + col]);
    }
    const int v4 = (tid & 31) * 4, ks = tid >> 5;
    const float* Sin = p.st_gS + (((size_t)j * 128 + b) * 8 + h) * 16384;
    f32x4 S[8];
#pragma unroll
    for (int q = 0; q < 8; ++q) S[q] = *(const f32x4*)(Sin + (size_t)(ks * 8 + q) * 128 + v4);
    lds_barrier();
    for (int t = 0; t < 4; ++t) {
        const float a = __expf(gb[t]), beta = gb[4 + t];
        f32x4 part = {0.f, 0.f, 0.f, 0.f};
#pragma unroll
        for (int q = 0; q < 8; ++q) { S[q] = S[q] * a; part = part + S[q] * kn[t * 128 + ks * 8 + q]; }
        *(f32x4*)(red + ks * 128 + v4) = part;
        lds_barrier();
        f32x4 r = *(const f32x4*)(vv + t * 128 + v4);
#pragma unroll
        for (int s = 0; s < 16; ++s) r = r - *(const f32x4*)(red + s * 128 + v4);
        r = r * beta;
        f32x4 op = {0.f, 0.f, 0.f, 0.f};
#pragma unroll
        for (int q = 0; q < 8; ++q) { S[q] = S[q] + r * kn[t * 128 + ks * 8 + q]; op = op + S[q] * qn[t * 128 + ks * 8 + q]; }
        lds_barrier();
        *(f32x4*)(red + ks * 128 + v4) = op;
        lds_barrier();
        if (tid < 128) { float s = 0.f;
#pragma unroll
            for (int q = 0; q < 16; ++q) s += red[q * 128 + tid];
            osum[t * 128 + tid] = s; }
        lds_barrier();
    }
    float* So = p.gS_s + (((size_t)j * 128 + b) * 8 + h) * 16384;
#pragma unroll
    for (int q = 0; q < 8; ++q) *(f32x4*)(So + (size_t)(ks * 8 + q) * 128 + v4) = S[q];
    {
        const int t = tid >> 7, c = tid & 127;
        const float ov = osum[t * 128 + c];
        float ss = wave_sum(ov * ov);
        if (lane == 0) wred[wid * 2] = ss;
        lds_barrier();
        ss = wred[(2 * t) * 2] + wred[(2 * t + 1) * 2];
        const float rstd = rsqrtf(ss * (1.f / 128.f) + 1e-6f);
        const size_t m = (size_t)mbase + t;
        const float z = bf2f(PROJ[m * GIN_LD + 3072 + h * 128 + c]);
        OG[m * D + h * 128 + c] = (bf16_t)f2bf(ov * rstd * p.gdn_norm_w[j * 128 + c] * siluf_(z));
    }
    lds_barrier();
}
__device__ __forceinline__ void gdn_scan_phase(CParams& p, int j, char* smem) {
    const int G = ogrid(), bid = obid();
    if (G > 64) {
        if (bid < 64) gdn_scan_prompt_item(p, j, bid, smem);
        else {
            for (int it = bid - 64; it < 1024; it += G - 64) gdn_sample_item(p, j, it, smem);
            lds_barrier();
            if (j == 0) prep_phase(p, smem, p.pad0, p.pad1, bid - 64, G - 64); else prep_phase(p, smem, p.pad1, p.njobs, bid - 64, G - 64);
        }
    } else {
        if (j == 0) prep_phase(p, smem, p.pad0, p.pad1, bid, G); else prep_phase(p, smem, p.pad1, p.njobs, bid, G);
        lds_barrier();
        for (int it = bid; it < 64; it += G) gdn_scan_prompt_item(p, j, it, smem);
        for (int it = bid; it < 1024; it += G) gdn_sample_item(p, j, it, smem);
    }
}

constexpr size_t RWB = (size_t)MPAD * D * 2;
constexpr int TOKF = 352;
__device__ __forceinline__ float row8_sum(float x) {
    x = dpp_add<0xB1>(x); x = dpp_add<0x4E>(x); x = dpp_add<0x141>(x);
    return x;
}
struct RVec { f32x4 w0, w1, a0, a1, f0, f1, k0, k1, r0, r1; float vv; };
__device__ __forceinline__ void rvec_load(RVec& V, const float* tb, int k8, int rw) {
    V.w0 = *(const f32x4*)(tb + k8); V.w1 = *(const f32x4*)(tb + k8 + 4);
    V.a0 = *(const f32x4*)(tb + 64 + k8); V.a1 = *(const f32x4*)(tb + 64 + k8 + 4);
    V.f0 = *(const f32x4*)(tb + 128 + k8); V.f1 = *(const f32x4*)(tb + 128 + k8 + 4);
    V.k0 = *(const f32x4*)(tb + 192 + k8); V.k1 = *(const f32x4*)(tb + 192 + k8 + 4);
    V.r0 = *(const f32x4*)(tb + 256 + k8); V.r1 = *(const f32x4*)(tb + 256 + k8 + 4);
    V.vv = tb[320 + rw];
}
__device__ __forceinline__ float rvec_step(f32x4& S0, f32x4& S1, const RVec& V) {
    const f32x4 d = S0 * V.k0 + S1 * V.k1;
    const float sa = row8_sum((d[0] + d[1]) + (d[2] + d[3]));
    const f32x4 P0 = S0 * V.w0 + V.f0 * V.vv, P1 = S1 * V.w1 + V.f1 * V.vv;
    S0 = P0 - V.a0 * sa; S1 = P1 - V.a1 * sa;
    const f32x4 e = S0 * V.r0 + S1 * V.r1;
    return row8_sum((e[0] + e[1]) + (e[2] + e[3]));
}
__device__ __forceinline__ void rwkv_scan_stream(CParams& p, int j, int h, int half, int m0, int ntok, int seglen, int seq0, char* smem) {
    const int tid = otid(), lane = tid & 63, wid = tid >> 6;
    float* bufs = (float*)smem;
    float* ybuf = (float*)(smem + 2 * 32 * TOKF * 4);
    const bf16_t* C1 = p.RA;
    const bf16_t* E = (const bf16_t*)p.RB; const bf16_t* AA = (const bf16_t*)(p.RB + RWB); const bf16_t* VM = (const bf16_t*)(p.RB + 3 * RWB);
    bf16_t* YRAW = (bf16_t*)(p.RB + 4 * RWB);
    const int nch = (ntok + 31) >> 5;
    if (wid >= 4) {
        const int pt = tid - 256, ptok = pt >> 3, c8 = (pt & 7) * 8, col = h * 64 + c8;
        const f32x4 kk0 = *(const f32x4*)(p.rwkv_k_k + (size_t)j * D + col), kk1 = *(const f32x4*)(p.rwkv_k_k + (size_t)j * D + col + 4);
        const f32x4 ka0 = *(const f32x4*)(p.rwkv_k_a + (size_t)j * D + col), ka1 = *(const f32x4*)(p.rwkv_k_a + (size_t)j * D + col + 4);
        u32x4 rr_, rk_, rv_, re_, ra_, rm_, rf_;
        auto load_raw = [&](int ch) {
            int tk = ch * 32 + ptok; if (tk > ntok - 1) tk = ntok - 1;
            const size_t m = (size_t)m0 + tk;
            rr_ = *(const u32x4*)(C1 + m * R1_N + col); rk_ = *(const u32x4*)(C1 + m * R1_N + 1024 + col); rv_ = *(const u32x4*)(C1 + m * R1_N + 2048 + col);
            re_ = *(const u32x4*)(E + m * D + col); ra_ = *(const u32x4*)(AA + m * D + col);
            if (j == 1) { rm_ = *(const u32x4*)(VM + m * D + col); rf_ = *(const u32x4*)(p.VFIRST + m * D + col); }
        };
        auto prep_write = [&](float* buf) {
            float r[8], k[8], v[8], e[8], a[8];
#pragma unroll
            for (int q = 0; q < 4; ++q) {
                r[2 * q] = lo16(rr_[q]); r[2 * q + 1] = hi16(rr_[q]); k[2 * q] = lo16(rk_[q]); k[2 * q + 1] = hi16(rk_[q]);
                v[2 * q] = lo16(rv_[q]); v[2 * q + 1] = hi16(rv_[q]); e[2 * q] = lo16(re_[q]); e[2 * q + 1] = hi16(re_[q]);
                a[2 * q] = lo16(ra_[q]); a[2 * q + 1] = hi16(ra_[q]);
            }
            if (j == 1) {
#pragma unroll
                for (int q = 0; q < 4; ++q) {
                    const float m0_ = lo16(rm_[q]), m1_ = hi16(rm_[q]), f0_ = lo16(rf_[q]), f1_ = hi16(rf_[q]);
                    v[2 * q] += (f0_ - v[2 * q]) * m0_; v[2 * q + 1] += (f1_ - v[2 * q + 1]) * m1_;
                }
            }
            float kkr[8], ss = 0.f;
#pragma unroll
            for (int q = 0; q < 8; ++q) { kkr[q] = k[q] * (q < 4 ? kk0[q] : kk1[q - 4]); ss += kkr[q] * kkr[q]; }
            ss = row8_sum(ss);
            const float rn = rsqrtf(ss + 1e-6f);
            f32x4 o[10];
#pragma unroll
            for (int q = 0; q < 8; ++q) {
                const float kkq = kkr[q] * rn, ka = (q < 4 ? ka0[q] : ka1[q - 4]);
                o[0 + (q >> 2)][q & 3] = __expf(-e[q]);
                o[2 + (q >> 2)][q & 3] = kkq * a[q];
                o[4 + (q >> 2)][q & 3] = k[q] * (1.f + (a[q] - 1.f) * ka);
                o[6 + (q >> 2)][q & 3] = kkq;
                o[8 + (q >> 2)][q & 3] = r[q];
            }
            float* tb = buf + ptok * TOKF;
#pragma unroll
            for (int q = 0; q < 5; ++q) { *(f32x4*)(tb + q * 64 + c8) = o[2 * q]; *(f32x4*)(tb + q * 64 + c8 + 4) = o[2 * q + 1]; }
            if ((c8 >> 5) == half) { *(f32x4*)(tb + 320 + (c8 & 31)) = (f32x4){v[0], v[1], v[2], v[3]}; *(f32x4*)(tb + 320 + (c8 & 31) + 4) = (f32x4){v[4], v[5], v[6], v[7]}; }
        };
        load_raw(0);
        prep_write(bufs);
        lds_barrier();
        for (int ch = 0; ch < nch; ++ch) {
            if (ch + 1 < nch) { load_raw(ch + 1); prep_write(bufs + ((ch + 1) & 1) * 32 * TOKF); }
            lds_barrier();
            const float* yb = ybuf + (ch & 1) * 1024;
            const int nt = (ntok - ch * 32) < 32 ? (ntok - ch * 32) : 32;
            const int tk = pt >> 3, r4 = (pt & 7) * 4;
            if (tk < nt) {
                const size_t m = (size_t)m0 + ch * 32 + tk;
                const f32x4 yv = *(const f32x4*)(yb + tk * 32 + r4);
                u32x2 w; w.x = pack2(yv[0], yv[1]); w.y = pack2(yv[2], yv[3]);
                *(u32x2*)(YRAW + m * D + h * 64 + half * 32 + r4) = w;
            }
        }
    } else {
        const int rw = wid * 8 + (lane >> 3), k8 = (lane & 7) * 8, vrow = half * 32 + rw;
        auto state_ptr = [&](int seq, bool out) -> float* {
            if (seq < 8) return (float*)(out ? p.rS_p : nullptr) + ((((size_t)j * 8 + seq) * 16 + h) * 64 + vrow) * 64 + k8;
            return (float*)(out ? p.rS_s : const_cast<float*>(p.st_rS)) + ((((size_t)j * 128 + (seq - 8)) * 16 + h) * 64 + vrow) * 64 + k8;
        };
        f32x4 S0 = {0.f, 0.f, 0.f, 0.f}, S1 = {0.f, 0.f, 0.f, 0.f}, N0 = S0, N1 = S0;
        const bool carried = (seq0 >= 8);
        if (carried) { const float* sp = state_ptr(seq0, false); N0 = *(const f32x4*)sp; N1 = *(const f32x4*)(sp + 4); }
        lds_barrier();
        int seg = 0, tin = 0;
        for (int ch = 0; ch < nch; ++ch) {
            const float* buf = bufs + (ch & 1) * 32 * TOKF;
            float* yb = ybuf + (ch & 1) * 1024;
            const int nt = (ntok - ch * 32) < 32 ? (ntok - ch * 32) : 32;
            RVec VA, VB, VC, VD;
            rvec_load(VA, buf, k8, rw); rvec_load(VB, buf + TOKF, k8, rw); rvec_load(VC, buf + 2 * TOKF, k8, rw);
            for (int t = 0; t < nt; t += 4) {
                if (tin == 0) {
                    S0 = N0; S1 = N1;
                    if (carried && (seg + 1) * seglen < ntok) { const float* sp = state_ptr(seq0 + seg + 1, false); N0 = *(const f32x4*)sp; N1 = *(const f32x4*)(sp + 4); }
                }
                rvec_load(VD, buf + (t + 3) * TOKF, k8, rw);
                yb[t * 32 + rw] = rvec_step(S0, S1, VA);
                rvec_load(VA, buf + (t + 4) * TOKF, k8, rw);
                yb[(t + 1) * 32 + rw] = rvec_step(S0, S1, VB);
                rvec_load(VB, buf + (t + 5) * TOKF, k8, rw);
                yb[(t + 2) * 32 + rw] = rvec_step(S0, S1, VC);
                rvec_load(VC, buf + (t + 6) * TOKF, k8, rw);
                yb[(t + 3) * 32 + rw] = rvec_step(S0, S1, VD);
                tin += 4;
                if (tin == seglen) {
                    float* so = state_ptr(seq0 + seg, true);
                    *(f32x4*)so = S0; *(f32x4*)(so + 4) = S1;
                    tin = 0; ++seg;
                }
            }
            lds_barrier();
        }
    }
    lds_barrier();
}
__device__ __forceinline__ void rwkv_scan_phase(CParams& p, int j, char* smem) {
    const int G = ogrid(), bid = obid();
    for (int it = bid; it < 256; it += G) rwkv_scan_stream(p, j, (it >> 1) & 15, it & 1, (it >> 5) * LP, LP, LP, it >> 5, smem);
    for (int it = bid; it < 256; it += G) rwkv_scan_stream(p, j, (it >> 1) & 15, it & 1, TP + (it >> 5) * 64, 64, 4, 8 + (it >> 5) * 16, smem);
}
__device__ __forceinline__ void rwkv_post_phase(CParams& p, int j) {
    const int tid = otid();
    const bf16_t* C1 = p.RA;
    const bf16_t* AA = (const bf16_t*)(p.RB + RWB); const bf16_t* GATE = (const bf16_t*)(p.RB + 2 * RWB); const bf16_t* VM = (const bf16_t*)(p.RB + 3 * RWB);
    const bf16_t* YRAW = (const bf16_t*)(p.RB + 4 * RWB);
    bf16_t* YG = p.HN;
    const int c4 = (tid & 15) * 4;
    struct Raw { u32x2 ry, rr, rk, rv, ra, rg, rm, rf; };
    auto load = [&](Raw& R, int base) {
        const int it = base + (tid >> 4), m = it >> 4, h = it & 15, col = h * 64 + c4;
        const size_t mm = (size_t)m;
        R.ry = *(const u32x2*)(YRAW + mm * D + col); R.rr = *(const u32x2*)(C1 + mm * R1_N + col); R.rk = *(const u32x2*)(C1 + mm * R1_N + 1024 + col);
        R.rv = *(const u32x2*)(C1 + mm * R1_N + 2048 + col); R.ra = *(const u32x2*)(AA + mm * D + col); R.rg = *(const u32x2*)(GATE + mm * D + col);
        if (j == 1) { R.rm = *(const u32x2*)(VM + mm * D + col); R.rf = *(const u32x2*)(p.VFIRST + mm * D + col); }
    };
    const int stride = ogrid() * 32;
    int base = obid() * 32;
    Raw cur, nxt;
    if (base < T * 16) load(cur, base);
    for (; base < T * 16; base += stride) {
        if (base + stride < T * 16) load(nxt, base + stride);
        const int it = base + (tid >> 4), m = it >> 4, h = it & 15, col = h * 64 + c4;
        const size_t mm = (size_t)m;
        const u32x2 ry = cur.ry, rr = cur.rr, rk = cur.rk, rv = cur.rv, ra = cur.ra, rg = cur.rg;
        f32x4 y = {lo16(ry.x), hi16(ry.x), lo16(ry.y), hi16(ry.y)};
        f32x4 r = {lo16(rr.x), hi16(rr.x), lo16(rr.y), hi16(rr.y)};
        f32x4 k = {lo16(rk.x), hi16(rk.x), lo16(rk.y), hi16(rk.y)};
        f32x4 v = {lo16(rv.x), hi16(rv.x), lo16(rv.y), hi16(rv.y)};
        f32x4 a = {lo16(ra.x), hi16(ra.x), lo16(ra.y), hi16(ra.y)};
        f32x4 g = {lo16(rg.x), hi16(rg.x), lo16(rg.y), hi16(rg.y)};
        if (j == 1) {
            const u32x2 rm = cur.rm, rf = cur.rf;
            f32x4 vm = {lo16(rm.x), hi16(rm.x), lo16(rm.y), hi16(rm.y)};
            f32x4 vf = {lo16(rf.x), hi16(rf.x), lo16(rf.y), hi16(rf.y)};
            v = v + (vf - v) * vm;
        }
        const f32x4 kav = *(const f32x4*)(p.rwkv_k_a + (size_t)j * D + col), rkv = *(const f32x4*)(p.rwkv_r_k + (size_t)j * D + col);
        const f32x4 lw = *(const f32x4*)(p.rwkv_ln_w + (size_t)j * D + col), lb = *(const f32x4*)(p.rwkv_ln_b + (size_t)j * D + col);
        const f32x4 kf = k * (1.f + (a - 1.f) * kav);
        const float mu = row16_sum(y[0] + y[1] + y[2] + y[3]) * (1.f / 64.f);
        const f32x4 yc = y - mu;
        const float var = row16_sum(yc[0] * yc[0] + yc[1] * yc[1] + yc[2] * yc[2] + yc[3] * yc[3]) * (1.f / 64.f);
        const f32x4 t3 = r * kf * rkv;
        const float bon = row16_sum(t3[0] + t3[1] + t3[2] + t3[3]);
        const f32x4 o = (yc * rsqrtf(var + 64e-5f) * lw + lb + v * bon) * g;
        u32x2 w; w.x = pack2(o[0], o[1]); w.y = pack2(o[2], o[3]);
        *(u32x2*)(YG + mm * D + col) = w;
        cur = nxt;
    }
}

__global__ void __launch_bounds__(NTH) mega_kernel(Params p_arg, int ph_begin, int ph_end) {
    extern __shared__ __attribute__((aligned(16))) char smem[];
#if !MULTI_LAUNCH
    cg::grid_group grid = cg::this_grid();
    volatile LAS unsigned* xst = (volatile LAS unsigned*)(smem + 131072);
    if (threadIdx.x == 0) { xst[0] = 0u; xst[1] = 0u; }
    __syncthreads();
    XcdBarrier xb = xcd_barrier_post(p_arg.bar, xst);
#endif
    for (int ph = ph_begin; ph < ph_end; ++ph) {
        CParams* pp = (CParams*)__builtin_amdgcn_kernarg_segment_ptr();
        asm volatile("" : "+s"(pp));
        CParams& p = *pp;
        int type, layer; phase_info(ph, type, layer);
        const int j = layer >> 1;
#ifndef DUP
#define DUP -1
#endif
        for (int rep = 0; rep < ((type == DUP) ? 2 : 1); ++rep) {
#if !MULTI_LAUNCH
        if (rep) xcd_barrier(xb);
#endif
        switch (type) {
#ifndef ONLY
#define ONLY -1
#endif
#define EN(t) (ONLY < 0 || ONLY == (t))
            case PH_PREP: if (EN(PH_PREP)) { prep_phase(p, smem, 0, p.pad0, obid(), ogrid()); norm_phase(p, 0, 0); } break;
            case PH_NORM_MIX: if (EN(PH_NORM_MIX)) { if (layer & 1) rwkv_norm_phase(p, layer); else norm_phase(p, layer, 0); } break;
            case PH_NORM_FFN: if (EN(PH_NORM_FFN)) { norm_phase(p, layer, 1); } break;
            case PH_FINAL: if (EN(PH_FINAL)) { norm_phase(p, 0, 2); } break;
            case PH_GDN_IN: if (EN(PH_GDN_IN)) { gdn_in_phase(p, j, smem); } break;
            case PH_GDN_PREP: if (EN(PH_GDN_PREP)) { gdn_prep_phase(p, j, smem); } break;
            case PH_GDN_SCAN: if (EN(PH_GDN_SCAN)) { gdn_scan_phase(p, j, smem); } break;
            case PH_GDN_OUT: if (EN(PH_GDN_OUT)) { res_gemm_phase(p, p.HN, D, p.w_out_t + (size_t)j * D * D, smem, rep); } break;
            case PH_FFN_UP: if (EN(PH_FFN_UP)) { ffn_up_phase(p, layer, smem); } break;
            case PH_FFN_DOWN: if (EN(PH_FFN_DOWN)) { res_gemm_phase(p, p.RA + H_OFF, DFF, p.down_t + (size_t)layer * D * DFF, smem, rep); } break;
            case PH_FFN_ACT: if (EN(PH_FFN_ACT)) { ffn_act_phase(p, layer); } break;
            case PH_RWKV_IN: if (EN(PH_RWKV_IN)) { rwkv_in_phase(p, j, smem); } break;
            case PH_RWKV_LORA: if (EN(PH_RWKV_LORA)) { rwkv_lora_phase(p, j, smem); } break;
            case PH_RWKV_SCAN: if (EN(PH_RWKV_SCAN)) { rwkv_scan_phase(p, j, smem); } break;
            case PH_RWKV_POST: if (EN(PH_RWKV_POST)) { rwkv_post_phase(p, j); } break;
            case PH_RWKV_OUT: if (EN(PH_RWKV_OUT)) { res_gemm_phase(p, p.HN, D, p.wo_t + (size_t)j * D * D, smem, rep); } break;
            default: break;
        }
        }
#if !MULTI_LAUNCH
        if (ph + 1 < ph_end) { if (ph == ph_begin) grid.sync(); else xcd_barrier(xb); }
#endif
    }
}

extern "C" void kernel_launch(void* const* d_in, const int* in_sizes, int n_in, void* d_out, int out_size, void* d_ws, size_t ws_size, hipStream_t stream) {
    static int grid = 0;
    if (grid == 0) {
        int dev = 0, cus = 0, per_cu = 0;
        hipGetDevice(&dev);
        hipDeviceGetAttribute(&cus, hipDeviceAttributeMultiprocessorCount, dev);
        hipFuncSetAttribute((const void*)mega_kernel, hipFuncAttributeMaxDynamicSharedMemorySize, SMEM_BYTES);
        hipOccupancyMaxActiveBlocksPerMultiprocessor(&per_cu, (const void*)mega_kernel, NTH, SMEM_BYTES);
        (void)hipGetLastError();
        if (per_cu < 1) { fprintf(stderr, "kernel_launch: occupancy query reports %d blocks per CU\n", per_cu); per_cu = 1; }
        grid = cus;
    }
    Params p; memset(&p, 0, sizeof(p));
    auto in = [&](int i) { return (const float*)d_in[i]; };
    p.x_prompt = in(0); p.x_sample = in(1); p.st_gS = in(2); p.st_gC = in(3); p.st_rS = in(4); p.st_rSh = in(5); p.st_fC = in(6); p.meta = in(7);
    p.norm_mix = in(8); p.norm_ffn = in(9); p.norm_final = in(10);
    p.gdn_conv_w = in(12); p.gdn_A_log = in(13); p.gdn_dt_bias = in(14); p.gdn_norm_w = in(15);
    p.rwkv_mix = in(17); p.rwkv_w0 = in(22); p.rwkv_a0 = in(25); p.rwkv_k_k = in(30); p.rwkv_k_a = in(31); p.rwkv_r_k = in(32); p.rwkv_ln_w = in(33); p.rwkv_ln_b = in(34); p.rwkv_v0 = in(35);
    p.ffn_conv_w = in(39);
    float* o = (float*)d_out; size_t off = 0;
    p.y_prompt = o + off; off += (size_t)8 * 2048 * 1024;
    p.y_sample = o + off; off += (size_t)128 * 4 * 1024;
    p.gS_p = o + off; off += (size_t)2 * 8 * 8 * 128 * 128;
    p.gC_p = o + off; off += (size_t)2 * 8 * 3 * 3072;
    p.rS_p = o + off; off += (size_t)2 * 8 * 16 * 64 * 64;
    p.rSh_p = o + off; off += (size_t)2 * 8 * 1024;
    p.fC_p = o + off; off += (size_t)4 * 8 * 2 * DFF;
    p.gS_s = o + off; off += (size_t)2 * 128 * 8 * 128 * 128;
    p.gC_s = o + off; off += (size_t)2 * 128 * 3 * 3072;
    p.rS_s = o + off; off += (size_t)2 * 128 * 16 * 64 * 64;
    p.rSh_s = o + off; off += (size_t)2 * 128 * 1024;
    p.fC_s = o + off; off += (size_t)4 * 128 * 2 * DFF;
    char* ws = (char*)d_ws; size_t w = 0;
    auto carve = [&](size_t bytes) { char* r = ws + w; w += (bytes + 255) & ~(size_t)255; return r; };
    p.bar = (unsigned*)carve(XCD_BAR_WORDS * 4);
    p.w_in_t = (bf16_t*)carve((size_t)2 * GIN_NP * D * 2);
    p.w_out_t = (bf16_t*)carve((size_t)2 * D * D * 2);
    p.rwkv1_t = (bf16_t*)carve((size_t)2 * 3072 * D * 2);
    p.w2t = (bf16_t*)carve((size_t)2 * D * 64 * 2);
    p.a2t = (bf16_t*)carve((size_t)2 * D * 64 * 2);
    p.g2t = (bf16_t*)carve((size_t)2 * D * 192 * 2);
    p.v2t = (bf16_t*)carve((size_t)D * 64 * 2);
    p.wo_t = (bf16_t*)carve((size_t)2 * D * D * 2);
    p.up_t = (bf16_t*)carve((size_t)4 * 2 * DFF * D * 2);
    p.down_t = (bf16_t*)carve((size_t)4 * D * DFF * 2);
    p.X = (float*)carve((size_t)MPAD * D * 4);
    p.HN = (bf16_t*)carve((size_t)MPAD * D * 2);
    p.RA = (bf16_t*)carve((size_t)MPAD * GIN_LD * 2);
    p.RB = carve((size_t)5 * MPAD * D * 2);
    if (w > ws_size) { fprintf(stderr, "kernel_launch: workspace too small: need %zu, have %zu\n", w, ws_size); return; }
    char* sc = (char*)p.y_prompt; size_t so = 0;
    auto scarve = [&](size_t bytes) { char* r = sc + so; so += (bytes + 255) & ~(size_t)255; return r; };
    p.VFIRST = (bf16_t*)scarve((size_t)MPAD * D * 2);
    p.AB = (float*)scarve((size_t)MPAD * 16 * 4);
    p.SHIFT = (bf16_t*)scarve((size_t)NSEQ * D * 2);
    p.GL = (float*)scarve((size_t)64 * NCHUNK * 4);
    p.l1t = (bf16_t*)scarve((size_t)2 * 768 * 2048 * 2);
    int nj = 0;
    auto jobx = [&](const float* src, bf16_t* dst, int K, int N, int Kd, int Nd, int ld, const float* scale, int smode) {
        TJob& t = p.jobs[nj++]; t.src = src; t.dst = dst; t.scale = scale; t.K = K; t.N = N; t.Kd = Kd; t.Nd = Nd; t.ld = ld; t.smode = smode; };
    auto job = [&](const float* src, bf16_t* dst, int K, int N, int Kd, int Nd) { jobx(src, dst, K, N, Kd, Nd, Kd, nullptr, 0); };
    auto gdn_jobs = [&](int j) {
        job(in(11) + (size_t)j * D * 4112, p.w_in_t + (size_t)j * GIN_NP * D, D, 4112, D, GIN_NP);
        job(in(16) + (size_t)j * D * D, p.w_out_t + (size_t)j * D * D, D, D, D, D);
    };
    auto ffn_jobs = [&](int i) {
        job(in(38) + (size_t)i * D * 2 * DFF, p.up_t + (size_t)i * 2 * DFF * D, D, 2 * DFF, D, 2 * DFF);
        job(in(40) + (size_t)i * DFF * D, p.down_t + (size_t)i * D * DFF, DFF, D, DFF, D);
    };
    auto rwkv_jobs = [&](int j) {
        bf16_t* r1 = p.rwkv1_t + (size_t)j * 3072 * D;
        job(in(18) + (size_t)j * D * D, r1, D, D, D, D);
        job(in(19) + (size_t)j * D * D, r1 + (size_t)1024 * D, D, D, D, D);
        job(in(20) + (size_t)j * D * D, r1 + (size_t)2048 * D, D, D, D, D);
        bf16_t* l1 = p.l1t + (size_t)j * 768 * 2048;
        const float* mixb = in(17) + (size_t)j * 6 * D;
        auto lora = [&](const float* src, int N, int Nd, int row0, int ms) {
            jobx(src, l1 + (size_t)row0 * 2048, D, N, D, Nd, 2048, mixb + (size_t)ms * D, 1);
            jobx(src, l1 + (size_t)row0 * 2048 + 1024, D, N, D, Nd, 2048, mixb + (size_t)ms * D, 2);
        };
        lora(in(23) + (size_t)j * D * 64, 64, 128, 0, 1);
        lora(in(26) + (size_t)j * D * 64, 64, 128, 128, 4);
        lora(in(28) + (size_t)j * D * 160, 160, 256, 256, 5);
        lora(in(36), j == 1 ? 32 : 0, 128, 512, 3);
        lora(in(36), 0, 128, 640, 3);
        job(in(24) + (size_t)j * 64 * D, p.w2t + (size_t)j * D * 64, 64, D, 64, D);
        job(in(27) + (size_t)j * 64 * D, p.a2t + (size_t)j * D * 64, 64, D, 64, D);
        job(in(29) + (size_t)j * 160 * D, p.g2t + (size_t)j * D * 192, 160, D, 192, D);
        job(in(21) + (size_t)j * D * D, p.wo_t + (size_t)j * D * D, D, D, D, D);
    };
    gdn_jobs(0); ffn_jobs(0);
    p.pad0 = nj;
    rwkv_jobs(0); ffn_jobs(1); gdn_jobs(1);
    p.pad1 = nj;
    ffn_jobs(2); rwkv_jobs(1); job(in(37), p.v2t, 32, D, 64, D); ffn_jobs(3);
    p.njobs = nj;
#if MULTI_LAUNCH
    for (int ph = 0; ph < NPHASES; ++ph) hipLaunchKernelGGL(mega_kernel, dim3(grid), dim3(NTH), SMEM_BYTES, stream, p, ph, ph + 1);
#else
    hipMemsetAsync(p.bar, 0, XCD_BAR_WORDS * 4, stream);
    int b0 = 0, b1 = NPHASES;
    void* args[] = { &p, &b0, &b1 };
    hipError_t e = hipLaunchCooperativeKernel((const void*)mega_kernel, dim3(grid), dim3(NTH), args, SMEM_BYTES, stream);
    if (e != hipSuccess) fprintf(stderr, "cooperative launch failed: %s (grid %d)\n", hipGetErrorString(e), grid);
#endif
}
```

```cpp
#include <hip/hip_runtime.h>
#include <hip/hip_cooperative_groups.h>
#include <cstdio>
#include <cstring>
#include <cstdint>
namespace cg = cooperative_groups;

#ifndef MULTI_LAUNCH
#define MULTI_LAUNCH 0
#endif

typedef unsigned short bf16_t;
typedef short bf16x8 __attribute__((ext_vector_type(8)));
typedef float f32x4 __attribute__((ext_vector_type(4)));
typedef float f32x2 __attribute__((ext_vector_type(2)));
typedef unsigned u32x4 __attribute__((ext_vector_type(4)));
typedef unsigned u32x2 __attribute__((ext_vector_type(2)));

constexpr int D = 1024;
constexpr int LP = 2064;
constexpr int TP = 8 * LP;
constexpr int TS = 512;
constexpr int T = TP + TS;
constexpr int MPAD = 17152;
constexpr int NSEQ = 136;
constexpr int DFF = 2816;
constexpr int NTH = 512;
constexpr int GIN_LD = 4096;
constexpr int GIN_NP = 4352;
constexpr int R1_N = 3840;
constexpr int NCHUNK = 33;
constexpr int CH_BYTES = 73728;
constexpr int SMEM_BYTES = 131072 + 1024 + 4096;

enum { PH_PREP = 0, PH_NORM_MIX, PH_GDN_IN, PH_GDN_PREP, PH_GDN_SCAN, PH_GDN_OUT, PH_NORM_FFN, PH_FFN_UP, PH_FFN_DOWN,
       PH_RWKV_IN, PH_RWKV_LORA, PH_RWKV_SCAN, PH_RWKV_POST, PH_RWKV_OUT, PH_FINAL, PH_FFN_ACT };
constexpr int NPHASES = 35;

struct TJob { const float* src; bf16_t* dst; const float* scale; int K, N, Kd, Nd, ld, smode; };
constexpr int MAXJOBS = 56;

struct Params {
    const float *x_prompt, *x_sample, *st_gS, *st_gC, *st_rS, *st_rSh, *st_fC, *meta;
    const float *norm_mix, *norm_ffn, *norm_final;
    const float *gdn_conv_w, *gdn_A_log, *gdn_dt_bias, *gdn_norm_w;
    const float *rwkv_mix, *rwkv_w0, *rwkv_a0, *rwkv_k_k, *rwkv_k_a, *rwkv_r_k, *rwkv_ln_w, *rwkv_ln_b, *rwkv_v0;
    const float *ffn_conv_w;
    float *y_prompt, *y_sample, *gS_p, *gC_p, *rS_p, *rSh_p, *fC_p, *gS_s, *gC_s, *rS_s, *rSh_s, *fC_s;
    bf16_t *w_in_t, *w_out_t, *rwkv1_t, *l1t, *w2t, *a2t, *g2t, *v2t, *wo_t, *up_t, *down_t;
    float* X; bf16_t* HN; bf16_t* SHIFT; bf16_t* RA; char* RB; float* AB; bf16_t* VFIRST; float* GL;
    unsigned* bar;
    int njobs; int pad0; int pad1; int pad2;
    TJob jobs[MAXJOBS];
};

typedef const __attribute__((address_space(4))) Params CParams;

__device__ __forceinline__ void lds_barrier() { asm volatile("s_waitcnt lgkmcnt(0)" ::: "memory"); __builtin_amdgcn_s_barrier(); asm volatile("" ::: "memory"); }
__device__ __forceinline__ int otid() { int t = threadIdx.x; asm volatile("" : "+v"(t)); return t; }
__device__ __forceinline__ int obid() { int t = blockIdx.x; asm volatile("" : "+s"(t)); return t; }
__device__ __forceinline__ int ogrid() { int t = gridDim.x; asm volatile("" : "+s"(t)); return t; }
__device__ __forceinline__ float bf2f(unsigned h) { return __uint_as_float(h << 16); }
typedef __bf16 bf16x2_t __attribute__((ext_vector_type(2)));
__device__ __forceinline__ unsigned pack2(float lo, float hi) { const f32x2 v = {lo, hi}; return __builtin_bit_cast(unsigned, __builtin_convertvector(v, bf16x2_t)); }
__device__ __forceinline__ unsigned f2bf(float f) { return pack2(f, 0.f) & 0xffffu; }
__device__ __forceinline__ float lo16(unsigned u) { return __uint_as_float(u << 16); }
__device__ __forceinline__ float hi16(unsigned u) { return __uint_as_float(u & 0xffff0000u); }
__device__ __forceinline__ float sigmoidf_(float x) { return __builtin_amdgcn_rcpf(1.f + __expf(-x)); }
__device__ __forceinline__ float siluf_(float x) { return x * __builtin_amdgcn_rcpf(1.f + __expf(-x)); }
__device__ __forceinline__ float tanhf_(float x) { return 2.f * __builtin_amdgcn_rcpf(1.f + __expf(-2.f * x)) - 1.f; }
__device__ __forceinline__ float softplusf_(float x) { return fmaxf(x, 0.f) + __logf(1.f + __expf(-fabsf(x))); }
__device__ __forceinline__ float wave_sum(float v) {
#pragma unroll
    for (int o = 1; o < 64; o <<= 1) v += __shfl_xor(v, o);
    return v;
}
template <int CTRL> __device__ __forceinline__ float dpp_add(float x) {
    int v = __builtin_amdgcn_update_dpp(0, __float_as_int(x), CTRL, 0xf, 0xf, true);
    return x + __int_as_float(v);
}
__device__ __forceinline__ float row16_sum(float x) {
    x = dpp_add<0xB1>(x);
    x = dpp_add<0x4E>(x);
    x = dpp_add<0x141>(x);
    x = dpp_add<0x140>(x);
    return x;
}
__device__ __forceinline__ void tokdec(int m, int& seq, int& t, int& L) {
    if (m < TP) { seq = m / LP; t = m - seq * LP; L = LP; }
    else { int s = m - TP; seq = 8 + (s >> 2); t = s & 3; L = 4; }
}
__device__ __forceinline__ int gdn_ph(int q) { return q == 0 ? PH_NORM_MIX : q == 1 ? PH_GDN_IN : q == 2 ? PH_GDN_PREP : q == 3 ? PH_GDN_SCAN : q == 4 ? PH_GDN_OUT : q == 5 ? PH_NORM_FFN : q == 6 ? PH_FFN_UP : PH_FFN_DOWN; }
__device__ __forceinline__ int rwkv_ph(int q) { return q == 0 ? PH_NORM_MIX : q == 1 ? PH_RWKV_IN : q == 2 ? PH_RWKV_LORA : q == 3 ? PH_RWKV_SCAN : q == 4 ? PH_RWKV_POST : q == 5 ? PH_RWKV_OUT : q == 6 ? PH_NORM_FFN : q == 7 ? PH_FFN_UP : PH_FFN_DOWN; }
__device__ __forceinline__ void phase_info(int ph, int& type, int& layer) {
    if (ph == 0) { type = PH_PREP; layer = 0; return; }
    if (ph == NPHASES - 1) { type = PH_FINAL; layer = 0; return; }
    int q = ph - 1;
    if (q < 7) { layer = 0; type = gdn_ph(q + 1); return; } q -= 7;
    if (q < 9) { layer = 1; type = rwkv_ph(q); return; } q -= 9;
    if (q < 8) { layer = 2; type = gdn_ph(q); return; } q -= 8;
    layer = 3; type = rwkv_ph(q);
}

#define XB_TMO      128
#define XB_XCNT(j)  (256  + 64 * (j))
#define XB_XSUB(j)  (1280 + 64 * (j))
#define XB_XGEN(j)  (2304 + 64 * (j))
#define XB_TOP      3328
#define XB_TOPGEN   3392
#define XCD_BAR_WORDS 3456
#define XB_SPIN_CAP (1u << 22)
#define LAS __attribute__((address_space(3)))
__device__ __forceinline__ unsigned xb_ld(unsigned* p)              { return __hip_atomic_load(p, __ATOMIC_RELAXED, __HIP_MEMORY_SCOPE_AGENT); }
__device__ __forceinline__ unsigned xb_add(unsigned* p, unsigned v) { return __hip_atomic_fetch_add(p, v, __ATOMIC_RELAXED, __HIP_MEMORY_SCOPE_AGENT); }
__device__ __forceinline__ unsigned xb_xcc_id() { return (unsigned)__builtin_amdgcn_s_getreg((3 << 11) | 20) & 0xFu; }
#define XB_SPIN(cond, bar) do { unsigned _sp = 0; while (cond) { __builtin_amdgcn_s_sleep(1); \
    if ((++_sp & 255u) == 0u) { if (xb_ld(&(bar)[XB_TMO])) break; if (_sp > XB_SPIN_CAP) { atomicAdd(&(bar)[XB_TMO], 1u); break; } } } } while (0)
struct XcdBarrier { unsigned* bar; unsigned x; volatile LAS unsigned* st; };
__device__ __forceinline__ XcdBarrier xcd_barrier_post(unsigned* bar, volatile LAS unsigned* st) {
    XcdBarrier b; b.bar = bar; b.x = xb_xcc_id(); b.st = st;
    if (threadIdx.x == 0) (void)xb_add(&bar[XB_XCNT(b.x)], 1u);
    return b;
}
__device__ __forceinline__ void xcd_barrier_complete(unsigned* bar, unsigned x, unsigned& nloc, unsigned& nx) {
    const unsigned G = gridDim.x * gridDim.y * gridDim.z;
    unsigned sum, cnt, mine, sp = 0u;
    for (;;) {
        sum = 0u; cnt = 0u; mine = 0u;
#pragma unroll
        for (unsigned j = 0; j < 16; ++j) { const unsigned c = xb_ld(&bar[XB_XCNT(j)]); sum += c; cnt += (c > 0u) ? 1u : 0u; mine = (j == x) ? c : mine; }
        if (sum == G) break;
        __builtin_amdgcn_s_sleep(1);
        if ((++sp & 255u) == 0u) { if (xb_ld(&bar[XB_TMO])) break; if (sp > XB_SPIN_CAP) { atomicAdd(&bar[XB_TMO], 1u); break; } }
    }
    nloc = mine > 0u ? mine : 1u; nx = cnt > 0u ? cnt : 1u;
}
__device__ __forceinline__ void xcd_barrier(const XcdBarrier& b) {
    asm volatile("s_waitcnt vmcnt(0)" ::: "memory");
    __syncthreads();
    if (threadIdx.x == 0) {
        unsigned* bar = b.bar;
        __builtin_amdgcn_s_waitcnt(0);
        unsigned nloc = b.st[0], nx = b.st[1];
        if (nloc == 0u) { xcd_barrier_complete(bar, b.x, nloc, nx); b.st[0] = nloc; b.st[1] = nx; }
        const unsigned old = xb_add(&bar[XB_XSUB(b.x)], 1u);
        const unsigned gen = old / nloc;
        if (old + 1u == (gen + 1u) * nloc) {
            __builtin_amdgcn_fence(__ATOMIC_RELEASE, "agent");
            asm volatile("s_waitcnt vmcnt(0)" ::: "memory");
            const unsigned og = xb_add(&bar[XB_TOP], 1u);
            const unsigned tg = og / nx;
            if (og + 1u == (tg + 1u) * nx) xb_add(&bar[XB_TOPGEN], 1u);
            else XB_SPIN(xb_ld(&bar[XB_TOPGEN]) == tg, bar);
            __builtin_amdgcn_fence(__ATOMIC_ACQUIRE, "agent");
            xb_add(&bar[XB_XGEN(b.x)], 1u);
            asm volatile("s_waitcnt vmcnt(0)" ::: "memory");
        } else {
            XB_SPIN(xb_ld(&bar[XB_XGEN(b.x)]) == gen, bar);
            __builtin_amdgcn_fence(__ATOMIC_ACQUIRE, "agent");
            asm volatile("s_waitcnt vmcnt(0)" ::: "memory");
        }
    }
    __syncthreads();
}

__device__ __forceinline__ void prep_phase(CParams& p, char* smem, int j0, int j1, int widx, int nworkers) {
    const int tid = otid(), lane = tid & 63, wave = tid >> 6;
    float* scr = (float*)(smem + wave * 8704);
    const int gw = widx * 8 + wave, NGW = nworkers * 8;
    int total = 0;
    for (int j = j0; j < j1; ++j) total += (p.jobs[j].Kd >> 6) * (p.jobs[j].Nd >> 5);
    for (int it = gw; it < total; it += NGW) {
        int r = it, j = j0;
        for (;; ++j) { const int c = (p.jobs[j].Kd >> 6) * (p.jobs[j].Nd >> 5); if (r < c) break; r -= c; }
        TJob jb; jb.src = p.jobs[j].src; jb.dst = p.jobs[j].dst; jb.scale = p.jobs[j].scale; jb.K = p.jobs[j].K; jb.N = p.jobs[j].N; jb.Kd = p.jobs[j].Kd; jb.Nd = p.jobs[j].Nd; jb.ld = p.jobs[j].ld; jb.smode = p.jobs[j].smode;
        const int nblk = jb.Nd >> 5, kb = r / nblk, nb = r - kb * nblk, k0 = kb * 64, n0 = nb * 32;
        {
            const int n4 = (lane & 7) * 4, kr = lane >> 3;
            f32x4 v[8];
            const bool vec_ok = ((jb.N & 3) == 0) && (n0 + n4 + 3 < jb.N);
#pragma unroll
            for (int i = 0; i < 8; ++i) {
                const int kk = i * 8 + kr;
                v[i] = (f32x4){0.f, 0.f, 0.f, 0.f};
                if (k0 + kk < jb.K) {
                    const float* sp = jb.src + (size_t)(k0 + kk) * jb.N + n0 + n4;
                    if (vec_ok) v[i] = *(const f32x4*)sp;
                    else {
#pragma unroll
                        for (int e = 0; e < 4; ++e) if (n0 + n4 + e < jb.N) v[i][e] = sp[e];
                    }
                    if (jb.smode) { const float sc = jb.scale[k0 + kk]; v[i] = v[i] * (jb.smode == 1 ? 1.f - sc : sc); }
                }
            }
#pragma unroll
            for (int i = 0; i < 8; ++i) {
                const int kk = i * 8 + kr;
#pragma unroll
                for (int e = 0; e < 4; ++e) scr[kk * 33 + n4 + e] = v[i][e];
            }
        }
        __builtin_amdgcn_s_waitcnt(0xc07f);
        asm volatile("" ::: "memory");
        const int c = lane & 7;
#pragma unroll
        for (int jj = 0; jj < 4; ++jj) {
            const int nn = (lane >> 3) + 8 * jj;
            const float* s = scr + (8 * c) * 33 + nn;
            u32x4 o;
            o.x = pack2(s[0], s[33]); o.y = pack2(s[66], s[99]); o.z = pack2(s[132], s[165]); o.w = pack2(s[198], s[231]);
            *(u32x4*)(jb.dst + (size_t)(n0 + nn) * jb.ld + k0 + 8 * c) = o;
        }
        __builtin_amdgcn_s_waitcnt(0xc07f);
        asm volatile("" ::: "memory");
    }
}

__device__ __forceinline__ const float* xsrc_row(CParams& p, int m) {
    int seq, t, L; tokdec(m, seq, t, L);
    if (m < TP) return t < 16 ? p.meta + (size_t)t * D : p.x_prompt + ((size_t)seq * 2048 + (t - 16)) * D;
    return p.x_sample + (size_t)(m - TP) * D;
}
__device__ __forceinline__ void norm_phase(CParams& p, int layer, int mode) {
    const int tid = otid(), lane = tid & 63, wave = tid >> 6;
    const int gw = obid() * 8 + wave, NGW = ogrid() * 8;
    const float* g = mode == 0 ? p.norm_mix + layer * D : (mode == 1 ? p.norm_ffn + layer * D : p.norm_final);
    const bool first = (mode == 0 && layer == 0);
    const bool rw = (mode == 0 && (layer & 1));
    const int j = layer >> 1;
    f32x4 gv[4];
#pragma unroll
    for (int q = 0; q < 4; ++q) gv[q] = *(const f32x4*)(g + q * 256 + lane * 4);
    const int nrows = (mode == 2) ? T : MPAD + (rw ? NSEQ : 0);
    f32x4 nv[4];
    if (gw < T) { const float* s0 = first ? xsrc_row(p, gw) : p.X + (size_t)gw * D;
#pragma unroll
        for (int q = 0; q < 4; ++q) nv[q] = *(const f32x4*)(s0 + q * 256 + lane * 4); }
    for (int m = gw; m < nrows; m += NGW) {
        if (m >= MPAD) {
            const int seq = m - MPAD;
            bf16_t* o = p.SHIFT + (size_t)seq * D;
#pragma unroll
            for (int q = 0; q < 4; ++q) {
                f32x4 v = {0.f, 0.f, 0.f, 0.f};
                if (seq >= 8) v = *(const f32x4*)(p.st_rSh + ((size_t)j * 128 + (seq - 8)) * D + q * 256 + lane * 4);
                u32x2 w; w.x = pack2(v.x, v.y); w.y = pack2(v.z, v.w);
                *(u32x2*)(o + q * 256 + lane * 4) = w;
            }
            continue;
        }
        if (m >= T) {
            u32x2 z; z.x = 0; z.y = 0;
#pragma unroll
            for (int q = 0; q < 4; ++q) *(u32x2*)(p.HN + (size_t)m * D + q * 256 + lane * 4) = z;
            if (first) { f32x4 zz = {0.f, 0.f, 0.f, 0.f};
#pragma unroll
                for (int q = 0; q < 4; ++q) *(f32x4*)(p.X + (size_t)m * D + q * 256 + lane * 4) = zz; }
            continue;
        }
        f32x4 v[4]; float ss = 0.f;
#pragma unroll
        for (int q = 0; q < 4; ++q) { v[q] = nv[q]; ss += v[q].x * v[q].x + v[q].y * v[q].y + v[q].z * v[q].z + v[q].w * v[q].w; }
        if (m + NGW < T) { const float* s1 = first ? xsrc_row(p, m + NGW) : p.X + (size_t)(m + NGW) * D;
#pragma unroll
            for (int q = 0; q < 4; ++q) nv[q] = *(const f32x4*)(s1 + q * 256 + lane * 4); }
        ss = wave_sum(ss);
        const float rstd = rsqrtf(ss * (1.f / D) + 1e-6f);
        if (first) {
#pragma unroll
            for (int q = 0; q < 4; ++q) *(f32x4*)(p.X + (size_t)m * D + q * 256 + lane * 4) = v[q];
        }
        int seq, t, L; tokdec(m, seq, t, L);
#pragma unroll
        for (int q = 0; q < 4; ++q) v[q] = v[q] * rstd * gv[q];
        if (mode == 2) {
            float* o = nullptr;
            if (m < TP) { if (t >= 16) o = p.y_prompt + ((size_t)seq * 2048 + (t - 16)) * D; }
            else o = p.y_sample + (size_t)(m - TP) * D;
            if (o) {
#pragma unroll
                for (int q = 0; q < 4; ++q) *(f32x4*)(o + q * 256 + lane * 4) = v[q];
            }
            continue;
        }
#pragma unroll
        for (int q = 0; q < 4; ++q) { u32x2 w; w.x = pack2(v[q].x, v[q].y); w.y = pack2(v[q].z, v[q].w); *(u32x2*)(p.HN + (size_t)m * D + q * 256 + lane * 4) = w; }
        if (rw && t == L - 1) {
            float* o = (seq < 8) ? p.rSh_p + ((size_t)j * 8 + seq) * D : p.rSh_s + ((size_t)j * 128 + (seq - 8)) * D;
#pragma unroll
            for (int q = 0; q < 4; ++q) *(f32x4*)(o + q * 256 + lane * 4) = v[q];
        }
    }
}

constexpr int A_STAGE = 32768, B_STAGE = 16384;
__device__ __forceinline__ int lds_off(int r, int c) {
    const int st = (r >> 4) * 2 + (c >> 5), rr = r & 15, cc = c & 31, ob = rr * 64 + cc * 2;
    return st * 1024 + (ob ^ (((ob >> 9) & 1) << 5));
}
struct ALoadPlain {
    const bf16_t* p[4]; u32x4 r[4]; int lo[4];
    __device__ __forceinline__ void init(int tid, const bf16_t* A, int lda, int m0, int mmax) {
        const int row = tid >> 3, kc = tid & 7;
#pragma unroll
        for (int i = 0; i < 4; ++i) { int m = m0 + row + 64 * i; m = m < 0 ? 0 : (m > mmax ? mmax : m); p[i] = A + (size_t)m * lda + kc * 8; lo[i] = lds_off(row + 64 * i, kc * 8); }
    }
    __device__ __forceinline__ void issue(int kt) {
#pragma unroll
        for (int i = 0; i < 4; ++i) r[i] = *(const u32x4*)(p[i] + kt * 64);
    }
    __device__ __forceinline__ void commit(char* As) {
#pragma unroll
        for (int i = 0; i < 4; ++i) *(u32x4*)(As + lo[i]) = r[i];
    }
};
struct ALoadMix {
    const bf16_t* ph[4]; const bf16_t* pp[4]; const float* pm; u32x4 rh[4], rp[4]; f32x4 m0, m1; int lo[4];
    __device__ __forceinline__ void init(int tid, CParams& p, const float* mixv, int mbase) {
        const int row = tid >> 3, kc = tid & 7;
#pragma unroll
        for (int i = 0; i < 4; ++i) {
            int m = mbase + row + 64 * i; if (m > MPAD - 1) m = MPAD - 1;
            ph[i] = p.HN + (size_t)m * D + kc * 8; lo[i] = lds_off(row + 64 * i, kc * 8);
            if (m < T) { int seq, t, L; tokdec(m, seq, t, L); pp[i] = (t == 0) ? p.SHIFT + (size_t)seq * D + kc * 8 : ph[i] - D; }
            else pp[i] = ph[i];
        }
        pm = mixv + kc * 8;
    }
    __device__ __forceinline__ void issue(int kt) {
#pragma unroll
        for (int i = 0; i < 4; ++i) { rh[i] = *(const u32x4*)(ph[i] + kt * 64); rp[i] = *(const u32x4*)(pp[i] + kt * 64); }
        m0 = *(const f32x4*)(pm + kt * 64); m1 = *(const f32x4*)(pm + kt * 64 + 4);
    }
    __device__ __forceinline__ void commit(char* As) {
#pragma unroll
        for (int i = 0; i < 4; ++i) {
            u32x4 o;
#pragma unroll
            for (int q = 0; q < 4; ++q) {
                const unsigned hh = rh[i][q], pv = rp[i][q];
                const float h0 = lo16(hh), h1 = hi16(hh), p0 = lo16(pv), p1 = hi16(pv);
                const float ma = q < 2 ? m0[2 * q] : m1[2 * q - 4], mb = q < 2 ? m0[2 * q + 1] : m1[2 * q - 3];
                o[q] = pack2(h0 + (p0 - h0) * ma, h1 + (p1 - h1) * mb);
            }
            *(u32x4*)(As + lo[i]) = o;
        }
    }
};
struct BLoad {
    const bf16_t* p[2]; u32x4 r[2]; int lo[2];
    __device__ __forceinline__ void init(int tid, const bf16_t* B0, const bf16_t* B1, int ldb) {
        const int row = tid >> 3, kc = tid & 7;
        p[0] = B0 + (size_t)row * ldb + kc * 8;
        p[1] = B1 + (size_t)row * ldb + kc * 8;
        lo[0] = lds_off(row, kc * 8); lo[1] = lds_off(row + 64, kc * 8);
    }
    __device__ __forceinline__ void issue(int kt) { r[0] = *(const u32x4*)(p[0] + kt * 64); r[1] = *(const u32x4*)(p[1] + kt * 64); }
    __device__ __forceinline__ void commit(char* Bs) {
        *(u32x4*)(Bs + lo[0]) = r[0];
        *(u32x4*)(Bs + lo[1]) = r[1];
    }
};
template <bool PAIRED, class AL>
__device__ __forceinline__ void gemm_mainloop(int tid, char* smem, AL& al, BLoad& bl, int nkt, f32x4 (&acc)[4][4]) {
    const int lane = tid & 63, wid = tid >> 6, wr = wid >> 1, wc = wid & 1, fr = lane & 15, fq = lane >> 4;
#pragma unroll
    for (int a = 0; a < 4; ++a)
#pragma unroll
        for (int b = 0; b < 4; ++b) acc[a][b] = (f32x4){0.f, 0.f, 0.f, 0.f};
    char* As = smem; char* Bs = smem + 2 * A_STAGE;
    al.issue(0); bl.issue(0);
    al.commit(As); bl.commit(Bs);
    lds_barrier();
    for (int kt = 0; kt < nkt; ++kt) {
        const int cur = kt & 1;
        if (kt + 1 < nkt) { al.issue(kt + 1); bl.issue(kt + 1); }
        const char* Ac = As + cur * A_STAGE; const char* Bc = Bs + cur * B_STAGE;
#pragma unroll
        for (int ks = 0; ks < 2; ++ks) {
            bf16x8 af[4], bfr[4];
#pragma unroll
            for (int mf = 0; mf < 4; ++mf) af[mf] = *(const bf16x8*)(Ac + lds_off(wr * 64 + mf * 16 + fr, ks * 32 + fq * 8));
#pragma unroll
            for (int nf = 0; nf < 4; ++nf) {
                const int br = PAIRED ? ((nf >> 1) * 64 + wc * 32 + (nf & 1) * 16) : (wc * 64 + nf * 16);
                bfr[nf] = *(const bf16x8*)(Bc + lds_off(br + fr, ks * 32 + fq * 8));
            }
#pragma unroll
            for (int mf = 0; mf < 4; ++mf)
#pragma unroll
                for (int nf = 0; nf < 4; ++nf) acc[mf][nf] = __builtin_amdgcn_mfma_f32_16x16x32_bf16(bfr[nf], af[mf], acc[mf][nf], 0, 0, 0);
        }
        if (kt + 1 < nkt) { al.commit(As + (cur ^ 1) * A_STAGE); bl.commit(Bs + (cur ^ 1) * B_STAGE); }
        lds_barrier();
    }
}

namespace pg8 {
constexpr int BM = 256, BK = 64, HALF = 128, HTB = HALF * BK * 2, NXCD = 8, WGM = 8;
__device__ __forceinline__ void stage_rc(int b, int& R, int& C) { const int st = b / 1024, sb = b % 1024, swz = sb ^ (((sb >> 9) & 1) << 5); R = (st >> 1) * 16 + swz / 64; C = (st & 1) * 32 + (swz % 64) / 2; }
struct Unit { int pm, pn; };
struct Gemm { const bf16_t* A; const bf16_t* Bt; int lda, K, nM, nN; const bf16_t* A2; int ksplit; size_t agstride; int npg; int brows_tile, brows_half; int arows_tile, arow0; int perm; };
struct StaticOrder {
    int nM, nN, nwg, G, c;
    __device__ __forceinline__ void init(int nM_, int nN_, int G_, int c_) { nM = nM_; nN = nN_; nwg = nM * nN; G = G_; c = c_; }
    __device__ __forceinline__ bool next(int i, Unit& u) const {
        const int L = i * G + c; if (L >= nwg) return false;
        int wgid = L; { const int q = nwg / NXCD, r = nwg % NXCD, xcd = wgid % NXCD, off = wgid / NXCD; wgid = (xcd < r ? xcd * (q + 1) : r * (q + 1) + (xcd - r) * q) + off; }
        const int nig = WGM * nN, gid = wgid / nig, fm = gid * WGM, gsz = (nM - fm) < WGM ? (nM - fm) : WGM;
        u.pm = fm + ((wgid % nig) % gsz); u.pn = (wgid % nig) / gsz; return true;
    }
};
template <class Epi>
__device__ __forceinline__ void gemm_phase(int tid, char* smem, const Gemm g, int G, int c, const Epi& E) {
    LAS unsigned char* lds = (LAS unsigned char*)smem;
    const int wid = __builtin_amdgcn_readfirstlane(tid >> 6), lane = tid & 63, wr = wid >> 2, wc = wid & 3, fr = lane & 15, fq = lane >> 4;
    const int K = g.K, nt = K / BK;
    StaticOrder S; S.init(g.nM, g.nN, G, c);
    unsigned voffA[2], voffB[2];
#pragma unroll
    for (int i = 0; i < 2; ++i) { int R, C; stage_rc(tid * 16 + i * 8192, R, C); voffA[i] = (unsigned)(R * g.lda + C) * 2u;
        const int rho = R & 31, Rb = g.perm ? ((R & ~31) + 8 * ((rho & 15) >> 2) + 4 * (rho >> 4) + (rho & 3)) : R;
        voffB[i] = (unsigned)(Rb * K + C) * 2u; }
    const size_t kstep = (size_t)(BK * 2);
    const size_t hstepA = (size_t)HALF * g.lda * 2, hstepB = (size_t)g.brows_half * K * 2;
    const size_t tstepA = (size_t)g.arows_tile * g.lda * 2, tstepB = (size_t)g.brows_tile * K * 2;
    const ptrdiff_t a0off = (ptrdiff_t)g.arow0 * g.lda * 2;
    const unsigned ldsw = (unsigned)wid * 1024u;
    const int aoff = lds_off(wr * 64 + fr, fq * 8), boff = lds_off(wc * 32 + fr, fq * 8);
#define PG8_SA(b, h) (((b) * 2 + (h)) * HTB)
#define PG8_SB(b, h) ((4 + (b) * 2 + (h)) * HTB)
#define PG8_STAGE(bufoff, gbase, voff) do { _Pragma("unroll") for (int _i = 0; _i < 2; ++_i) \
        __builtin_amdgcn_global_load_lds((const unsigned*)((const char*)(gbase) + (voff)[_i]), (LAS unsigned*)(lds + (bufoff) + ldsw + _i * 8192), 16, 0, 0); } while (0)
#define PG8_LDA(dst, b, h) do { _Pragma("unroll") for (int m = 0; m < 4; ++m) _Pragma("unroll") for (int k = 0; k < 2; ++k) dst[m][k] = *(const LAS bf16x8*)(lds + PG8_SA(b, h) + aoff + m * 2048 + k * 1024); } while (0)
#define PG8_LDB(dst, b, h) do { _Pragma("unroll") for (int n = 0; n < 2; ++n) _Pragma("unroll") for (int k = 0; k < 2; ++k) dst[n][k] = *(const LAS bf16x8*)(lds + PG8_SB(b, h) + boff + n * 2048 + k * 1024); } while (0)
#define PG8_MMA(ai, bj, At, Bt) do { __builtin_amdgcn_s_setprio(1); _Pragma("unroll") for (int m = 0; m < 4; ++m) _Pragma("unroll") for (int n = 0; n < 2; ++n) _Pragma("unroll") for (int k = 0; k < 2; ++k) \
        acc[ai][bj][m][n] = __builtin_amdgcn_mfma_f32_16x16x32_bf16(Bt[n][k], At[m][k], acc[ai][bj][m][n], 0, 0, 0); __builtin_amdgcn_s_setprio(0); } while (0)
#define PG8_WAIT_V(n) asm volatile("s_waitcnt vmcnt(" #n ")" ::: "memory")
#define PG8_WAIT_L(n) asm volatile("s_waitcnt lgkmcnt(" #n ")" ::: "memory")
#define PG8_BAR __builtin_amdgcn_s_barrier()
#define PG8_SCHED __builtin_amdgcn_sched_barrier(0)
    Unit cur, nxt; int ui = 0;
    if (!S.next(0, cur)) return;
    f32x4 acc[2][2][4][2];
#pragma unroll
    for (int a = 0; a < 2; ++a)
#pragma unroll
        for (int b = 0; b < 2; ++b)
#pragma unroll
            for (int m = 0; m < 4; ++m)
#pragma unroll
                for (int n = 0; n < 2; ++n) acc[a][b][m][n] = (f32x4){0.f, 0.f, 0.f, 0.f};
    bf16x8 At[4][2], B0[2][2], B1[2][2];
    const int ksplit = g.ksplit;
    const char* cA = (const char*)g.A + (size_t)(cur.pn / g.npg) * g.agstride * 2 + (size_t)cur.pm * tstepA + a0off; const char* cA2 = (const char*)g.A2 + (size_t)cur.pm * tstepA - (size_t)ksplit * kstep;
    const char* cB = (const char*)g.Bt + (size_t)cur.pn * tstepB;
    PG8_STAGE(PG8_SB(0, 0), cB, voffB); PG8_STAGE(PG8_SB(0, 1), cB + hstepB, voffB); PG8_STAGE(PG8_SA(0, 0), cA, voffA); PG8_STAGE(PG8_SA(0, 1), cA + hstepA, voffA);
    if (wr == 1) PG8_BAR;
    PG8_WAIT_V(2); PG8_BAR;
    PG8_STAGE(PG8_SB(1, 0), cB + kstep, voffB); PG8_STAGE(PG8_SA(1, 0), cA + kstep, voffA); PG8_STAGE(PG8_SB(1, 1), cB + hstepB + kstep, voffB);
    PG8_WAIT_V(6); PG8_BAR;
    for (;;) {
        const bool has_next = S.next(ui + 1, nxt);
        const char* nA = has_next ? (const char*)g.A + (size_t)(nxt.pn / g.npg) * g.agstride * 2 + (size_t)nxt.pm * tstepA + a0off : cA; const char* nA2 = has_next ? (const char*)g.A2 + (size_t)nxt.pm * tstepA - (size_t)ksplit * kstep : cA2;
        const char* nB = has_next ? (const char*)g.Bt + (size_t)nxt.pn * tstepB : cB;
        for (int t = 0; t < nt; t += 2) {
            const bool last = (t == nt - 2);
            const char* a1 = ((t + 1 < ksplit) ? cA : cA2) + (size_t)(t + 1) * kstep;
            const char* a2 = last ? nA : ((t + 2 < ksplit) ? cA : cA2) + (size_t)(t + 2) * kstep; const char* b2 = last ? nB : cB + (size_t)(t + 2) * kstep;
            const char* a3 = last ? nA + kstep : ((t + 3 < ksplit) ? cA : cA2) + (size_t)(t + 3) * kstep; const char* b3 = b2 + kstep;
            PG8_LDB(B0, 0, 0); PG8_LDB(B1, 0, 1); PG8_SCHED; PG8_LDA(At, 0, 0); PG8_STAGE(PG8_SA(1, 1), a1 + hstepA, voffA);
            PG8_WAIT_V(8); PG8_WAIT_L(0); PG8_BAR; PG8_MMA(0, 0, At, B0); PG8_MMA(0, 1, At, B1); PG8_BAR; PG8_SCHED;
            PG8_LDA(At, 0, 1); PG8_STAGE(PG8_SB(0, 0), b2, voffB); PG8_STAGE(PG8_SB(0, 1), b2 + hstepB, voffB); PG8_STAGE(PG8_SA(0, 0), a2, voffA);
            PG8_WAIT_V(8); PG8_WAIT_L(0); PG8_BAR; PG8_MMA(1, 0, At, B0); PG8_MMA(1, 1, At, B1); PG8_BAR; PG8_SCHED;
            PG8_LDB(B0, 1, 0); PG8_LDB(B1, 1, 1); PG8_SCHED; PG8_LDA(At, 1, 0); PG8_STAGE(PG8_SA(0, 1), a2 + hstepA, voffA);
            PG8_WAIT_V(8); PG8_WAIT_L(0); PG8_BAR; PG8_MMA(0, 0, At, B0); PG8_MMA(0, 1, At, B1); PG8_BAR; PG8_SCHED;
            PG8_LDA(At, 1, 1); PG8_STAGE(PG8_SB(1, 0), b3, voffB); PG8_STAGE(PG8_SB(1, 1), b3 + hstepB, voffB); PG8_STAGE(PG8_SA(1, 0), a3, voffA);
            PG8_WAIT_V(8); PG8_WAIT_L(0); PG8_BAR; PG8_MMA(1, 0, At, B0); PG8_MMA(1, 1, At, B1); PG8_BAR; PG8_SCHED;
        }
        if (wr == 0) PG8_BAR;
        E(acc, cur, wr, wc, fr, fq);
        if (!has_next) break;
#pragma unroll
        for (int a = 0; a < 2; ++a)
#pragma unroll
            for (int b = 0; b < 2; ++b)
#pragma unroll
                for (int m = 0; m < 4; ++m)
#pragma unroll
                    for (int n = 0; n < 2; ++n) acc[a][b][m][n] = (f32x4){0.f, 0.f, 0.f, 0.f};
        cur = nxt; cA = nA; cA2 = nA2; cB = nB; ++ui;
        if (wr == 1) PG8_BAR;
    }
    PG8_WAIT_V(0);
    PG8_BAR;
#undef PG8_SA
#undef PG8_SB
#undef PG8_STAGE
#undef PG8_LDA
#undef PG8_LDB
#undef PG8_MMA
#undef PG8_WAIT_V
#undef PG8_WAIT_L
#undef PG8_BAR
#undef PG8_SCHED
}
struct EpiRes {
    float* X;
    __device__ __forceinline__ void operator()(const f32x4 (&acc)[2][2][4][2], const Unit& u, int wr, int wc, int fr, int fq) const {
        const int row0 = u.pm * BM + wr * 64 + fr, col0 = u.pn * BM + wc * 32 + 4 * fq;
#pragma unroll
        for (int ai = 0; ai < 2; ++ai) {
            f32x4 xv[4][2][2];
#pragma unroll
            for (int m = 0; m < 4; ++m) { const float* rowp = X + (size_t)(row0 + ai * HALF + m * 16) * D + col0;
#pragma unroll
                for (int bj = 0; bj < 2; ++bj)
#pragma unroll
                    for (int n = 0; n < 2; ++n) xv[m][bj][n] = *(const f32x4*)(rowp + bj * HALF + n * 16); }
#pragma unroll
            for (int m = 0; m < 4; ++m) { float* rowp = X + (size_t)(row0 + ai * HALF + m * 16) * D + col0;
#pragma unroll
                for (int bj = 0; bj < 2; ++bj)
#pragma unroll
                    for (int n = 0; n < 2; ++n) *(f32x4*)(rowp + bj * HALF + n * 16) = xv[m][bj][n] + acc[ai][bj][m][n]; }
        }
    }
};
struct EpiBf16 {
    bf16_t* O; int ldc; int ncol; float* AB;
    __device__ __forceinline__ void operator()(const f32x4 (&acc)[2][2][4][2], const Unit& u, int wr, int wc, int fr, int fq) const {
        const int row0 = u.pm * BM + wr * 64 + fr, col0 = u.pn * BM + wc * 32 + 8 * fq;
#pragma unroll
        for (int ai = 0; ai < 2; ++ai)
#pragma unroll
            for (int m = 0; m < 4; ++m) { const size_t row = (size_t)(row0 + ai * HALF + m * 16);
#pragma unroll
                for (int bj = 0; bj < 2; ++bj) {
                    const int col = col0 + bj * HALF; const f32x4 v0 = acc[ai][bj][m][0], v1 = acc[ai][bj][m][1];
                    if (col < ncol) { u32x4 w; w.x = pack2(v0[0], v0[1]); w.y = pack2(v0[2], v0[3]); w.z = pack2(v1[0], v1[1]); w.w = pack2(v1[2], v1[3]); *(u32x4*)(O + row * ldc + col) = w; }
                    else if (AB && col < ncol + 16) { *(f32x4*)(AB + row * 16 + (col - ncol)) = v0; *(f32x4*)(AB + row * 16 + (col - ncol) + 4) = v1; }
                } }
    }
};
struct EpiRwkv1 {
    bf16_t* C1; bf16_t* VF; int colbase; int lora; int rowbase;
    __device__ __forceinline__ void operator()(const f32x4 (&acc)[2][2][4][2], const Unit& u, int wr, int wc, int fr, int fq) const {
        const int row0 = rowbase + u.pm * BM + wr * 64 + fr, col0 = u.pn * BM + wc * 32 + 8 * fq;
#pragma unroll
        for (int ai = 0; ai < 2; ++ai)
#pragma unroll
            for (int m = 0; m < 4; ++m) { const size_t row = (size_t)(row0 + ai * HALF + m * 16);
#pragma unroll
                for (int bj = 0; bj < 2; ++bj) {
                    const int col = col0 + bj * HALF; f32x4 v0 = acc[ai][bj][m][0], v1 = acc[ai][bj][m][1];
                    if (lora) {
                        if (col < 128) {
#pragma unroll
                            for (int e = 0; e < 4; ++e) { v0[e] = tanhf_(v0[e]); v1[e] = tanhf_(v1[e]); } }
                        else if (col >= 256 && col < 512) {
#pragma unroll
                            for (int e = 0; e < 4; ++e) { v0[e] = sigmoidf_(v0[e]); v1[e] = sigmoidf_(v1[e]); } }
                    }
                    u32x4 w; w.x = pack2(v0[0], v0[1]); w.y = pack2(v0[2], v0[3]); w.z = pack2(v1[0], v1[1]); w.w = pack2(v1[2], v1[3]);
                    *(u32x4*)(C1 + row * R1_N + colbase + col) = w;
                    if (VF && col >= 2048) *(u32x4*)(VF + row * D + (col - 2048)) = w;
                } }
    }
};
template <int CTRL> __device__ __forceinline__ float dpp_shift(float oldv, float src) {
    return __int_as_float(__builtin_amdgcn_update_dpp(__float_as_int(oldv), __float_as_int(src), CTRL, 0xf, 0xf, false));
}
template <int CTRL> __device__ __forceinline__ float dpp_rot(float src) {
    return __int_as_float(__builtin_amdgcn_update_dpp(0, __float_as_int(src), CTRL, 0xf, 0xf, true));
}
struct EpiFfn {
    bf16_t* H; const float* cw; const float* stfc; float* fc_p; float* fc_s; int layer; float* xg;
    __device__ __forceinline__ void operator()(const f32x4 (&acc)[2][2][4][2], const Unit& u, int wr, int wc, int fr, int fq) const {
        if (fr >= 14) {
#pragma unroll
            for (int ai = 0; ai < 2; ++ai)
#pragma unroll
                for (int n = 0; n < 2; ++n) *(f32x4*)(xg + (((((ai * 2 + wr) * 4 + wc) * 2 + n) * 4 + fq) * 2 + (fr - 14)) * 4) = acc[ai][0][3][n];
        }
        asm volatile("s_waitcnt lgkmcnt(0)" ::: "memory");
        __builtin_amdgcn_s_barrier();
        asm volatile("" ::: "memory");
        const int mfirst = 254 * u.pm - 2, ff0 = 128 * u.pn + 32 * wc + 8 * fq;
        f32x4 cw0[2], cw1[2], cw2[2];
#pragma unroll
        for (int n = 0; n < 2; ++n) { cw0[n] = *(const f32x4*)(cw + ff0 + 4 * n); cw1[n] = *(const f32x4*)(cw + DFF + ff0 + 4 * n); cw2[n] = *(const f32x4*)(cw + 2 * DFF + ff0 + 4 * n); }
#pragma unroll
        for (int ai = 0; ai < 2; ++ai) {
#pragma unroll
            for (int m = 0; m < 4; ++m) {
                const int r = 128 * ai + 64 * wr + 16 * m + fr, mg = mfirst + r;
                int seq, t, L; tokdec(mg < 0 ? 0 : mg, seq, t, L);
                const bool live = (r >= 2) && (mg < T);
                u32x2 hw[2];
#pragma unroll
                for (int n = 0; n < 2; ++n) {
                    const int ff = ff0 + 4 * n;
                    const f32x4 g0 = acc[ai][0][m][n], up = acc[ai][1][m][n];
                    f32x4 pf;
                    if (m > 0) pf = acc[ai][0][m - 1][n];
                    else {
                        const int sai = (wr == 1) ? ai : 0, swr = (wr == 1) ? 0 : 1;
                        pf = (f32x4){0.f, 0.f, 0.f, 0.f};
                        if (fr >= 14 && (wr == 1 || ai == 1)) pf = *(const f32x4*)(xg + (((((sai * 2 + swr) * 4 + wc) * 2 + n) * 4 + fq) * 2 + (fr - 14)) * 4);
                    }
                    f32x4 g1, g2;
#pragma unroll
                    for (int e = 0; e < 4; ++e) {
                        g1[e] = dpp_shift<0x111>(dpp_rot<0x121>(pf[e]), g0[e]);
                        g2[e] = dpp_shift<0x112>(dpp_rot<0x122>(pf[e]), g0[e]);
                    }
                    if (live) {
                        if (t < 2) {
                            f32x4 b0 = {0.f, 0.f, 0.f, 0.f}, b1 = b0;
                            if (seq >= 8) { const float* sb = stfc + (((size_t)layer * 128 + (seq - 8)) * 2) * DFF + ff; b0 = *(const f32x4*)sb; b1 = *(const f32x4*)(sb + DFF); }
                            if (t == 0) { g1 = b1; g2 = b0; } else g2 = b1;
                        }
                        const f32x4 cv = cw0[n] * g2 + cw1[n] * g1 + cw2[n] * g0;
                        hw[n].x = pack2(siluf_(cv[0]) * up[0], siluf_(cv[1]) * up[1]); hw[n].y = pack2(siluf_(cv[2]) * up[2], siluf_(cv[3]) * up[3]);
                        if (t >= L - 2) {
                            float* od = (seq < 8) ? fc_p + (((size_t)layer * 8 + seq) * 2 + (t - (L - 2))) * DFF + ff : fc_s + (((size_t)layer * 128 + (seq - 8)) * 2 + (t - (L - 2))) * DFF + ff;
                            *(f32x4*)od = g0;
                        }
                    }
                }
                if (live) { u32x4 w; w.x = hw[0].x; w.y = hw[0].y; w.z = hw[1].x; w.w = hw[1].y; *(u32x4*)(H + (size_t)mg * DFF + ff0) = w; }
            }
        }
    }
};
}

__device__ __forceinline__ void gdn_in_phase(CParams& p, int j, char* smem) {
    const int tid = otid();
    pg8::Gemm g; g.A = p.HN; g.Bt = p.w_in_t + (size_t)j * GIN_NP * D; g.lda = D; g.K = D; g.nM = MPAD / 256; g.nN = GIN_NP / 256; g.A2 = g.A; g.ksplit = 1 << 20; g.agstride = 0; g.npg = 1 << 20; g.brows_tile = 256; g.brows_half = 128; g.arows_tile = 256; g.arow0 = 0; g.perm = 0;
    g.perm = 1;
    pg8::EpiBf16 E; E.O = p.RA; E.ldc = GIN_LD; E.ncol = GIN_LD; E.AB = p.AB;
    pg8::gemm_phase(tid, smem, g, ogrid(), obid(), E);
}
constexpr int RES_MAIN_TILES = 64, RES_ROW0 = RES_MAIN_TILES * 256;
__device__ __forceinline__ void res_gemm_phase(CParams& p, const bf16_t* A, int K, const bf16_t* Bt, char* smem, int rep = 0) {
    const int tid = otid(), lane = tid & 63, wid = tid >> 6, fr = lane & 15, fq = lane >> 4;
    float* X = rep ? (float*)p.RA : p.X;
    pg8::Gemm g; g.A = A; g.Bt = Bt; g.lda = K; g.K = K; g.nM = RES_MAIN_TILES; g.nN = D / 256; g.A2 = g.A; g.ksplit = 1 << 20; g.agstride = 0; g.npg = 1 << 20; g.brows_tile = 256; g.brows_half = 128; g.arows_tile = 256; g.arow0 = 0; g.perm = 0;
    pg8::EpiRes E; E.X = X;
    pg8::gemm_phase(tid, smem, g, ogrid(), obid(), E);
    float* red = (float*)smem;
    const int ksteps = K / 256;
    for (int st = obid(); st < 256; st += ogrid()) {
        const int rb = st >> 5, cb = st & 31;
        const bf16_t* ap = A + (size_t)(RES_ROW0 + rb * 80 + fr) * K + wid * (K / 8) + fq * 8;
        const bf16_t* bp = Bt + (size_t)(cb * 32 + fr) * K + wid * (K / 8) + fq * 8;
        f32x4 acc[5][2];
#pragma unroll
        for (int mf = 0; mf < 5; ++mf) { acc[mf][0] = (f32x4){0.f, 0.f, 0.f, 0.f}; acc[mf][1] = acc[mf][0]; }
        bf16x8 af[4][5], bf[4][2];
#pragma unroll
        for (int sl = 0; sl < 4; ++sl) {
            if (sl < ksteps) {
#pragma unroll
                for (int mf = 0; mf < 5; ++mf) af[sl][mf] = *(const bf16x8*)(ap + (size_t)(mf * 16) * K + sl * 32);
#pragma unroll
                for (int nf = 0; nf < 2; ++nf) bf[sl][nf] = *(const bf16x8*)(bp + (size_t)(nf * 16) * K + sl * 32);
            }
        }
        for (int ks0 = 0; ks0 < ksteps; ks0 += 4) {
#pragma unroll
            for (int sl = 0; sl < 4; ++sl) {
                const int ks = ks0 + sl;
                if (ks < ksteps) {
#pragma unroll
                    for (int mf = 0; mf < 5; ++mf)
#pragma unroll
                        for (int nf = 0; nf < 2; ++nf) acc[mf][nf] = __builtin_amdgcn_mfma_f32_16x16x32_bf16(bf[sl][nf], af[sl][mf], acc[mf][nf], 0, 0, 0);
                    if (ks + 4 < ksteps) {
#pragma unroll
                        for (int mf = 0; mf < 5; ++mf) af[sl][mf] = *(const bf16x8*)(ap + (size_t)(mf * 16) * K + (ks + 4) * 32);
#pragma unroll
                        for (int nf = 0; nf < 2; ++nf) bf[sl][nf] = *(const bf16x8*)(bp + (size_t)(nf * 16) * K + (ks + 4) * 32);
                    }
                }
            }
        }
        float xv[5];
#pragma unroll
        for (int q = 0; q < 5; ++q) { const int o = tid + q * NTH; xv[q] = X[(size_t)(RES_ROW0 + rb * 80 + (o >> 5)) * D + cb * 32 + (o & 31)]; }
#pragma unroll
        for (int mf = 0; mf < 5; ++mf)
#pragma unroll
            for (int nf = 0; nf < 2; ++nf) *(f32x4*)(red + (wid * 80 + mf * 16 + fr) * 32 + nf * 16 + 4 * fq) = acc[mf][nf];
        lds_barrier();
#pragma unroll
        for (int q = 0; q < 5; ++q) {
            const int o = tid + q * NTH, row = o >> 5, col = o & 31;
            float sum = xv[q];
#pragma unroll
            for (int w = 0; w < 8; ++w) sum += red[(w * 80 + row) * 32 + col];
            X[(size_t)(RES_ROW0 + rb * 80 + row) * D + cb * 32 + col] = sum;
        }
        lds_barrier();
    }
}
__device__ __forceinline__ void ffn_up_phase(CParams& p, int layer, char* smem) {
    const int tid = otid();
    pg8::Gemm g; g.A = p.HN; g.Bt = p.up_t + (size_t)layer * (2 * DFF) * D; g.lda = D; g.K = D; g.nM = 68; g.nN = DFF / 128;
    g.A2 = g.A; g.ksplit = 1 << 20; g.agstride = 0; g.npg = 1 << 20; g.brows_tile = 128; g.brows_half = DFF; g.arows_tile = 254; g.arow0 = -2; g.perm = 1;
    pg8::EpiFfn E; E.H = p.RA; E.cw = p.ffn_conv_w + (size_t)layer * 3 * DFF; E.stfc = p.st_fC; E.fc_p = p.fC_p; E.fc_s = p.fC_s; E.layer = layer;
    E.xg = (float*)(smem + 131072 + 1024);
    pg8::gemm_phase(tid, smem, g, ogrid(), obid(), E);
}
constexpr size_t H_OFF = 0;
__device__ __forceinline__ void ffn_act_phase(CParams& p, int layer) {
    const int tid = otid();
    const bf16_t* GU = p.RA; bf16_t* H = p.RA + H_OFF;
    const float* cw = p.ffn_conv_w + (size_t)layer * 3 * DFF;
    constexpr int NCK = DFF / 8, RB = 16, NRB = T / RB;
    for (int idx = obid() * NTH + tid; idx < NRB * NCK; idx += ogrid() * NTH) {
        const int rb = idx / NCK, ck = idx - rb * NCK, ff = ck * 8, mstart = rb * RB;
        float w0[8], w1[8], w2[8], g1[8], g2[8];
#pragma unroll
        for (int q = 0; q < 2; ++q) {
            const f32x4 a0 = *(const f32x4*)(cw + ff + 4 * q), a1 = *(const f32x4*)(cw + DFF + ff + 4 * q), a2 = *(const f32x4*)(cw + 2 * DFF + ff + 4 * q);
#pragma unroll
            for (int e = 0; e < 4; ++e) { w0[4 * q + e] = a0[e]; w1[4 * q + e] = a1[e]; w2[4 * q + e] = a2[e]; }
        }
        {
            const int ma = mstart >= 1 ? mstart - 1 : 0, mb = mstart >= 2 ? mstart - 2 : 0;
            const u32x4 r1 = *(const u32x4*)(GU + (size_t)ma * 2 * DFF + ff), r2 = *(const u32x4*)(GU + (size_t)mb * 2 * DFF + ff);
#pragma unroll
            for (int q = 0; q < 4; ++q) { g1[2 * q] = lo16(r1[q]); g1[2 * q + 1] = hi16(r1[q]); g2[2 * q] = lo16(r2[q]); g2[2 * q + 1] = hi16(r2[q]); }
        }
#pragma unroll 1
        for (int i0 = 0; i0 < RB; i0 += 4) {
            u32x4 g0rr[4], uprr[4];
#pragma unroll
            for (int ii = 0; ii < 4; ++ii) {
                const int m = mstart + i0 + ii;
                g0rr[ii] = *(const u32x4*)(GU + (size_t)m * 2 * DFF + ff); uprr[ii] = *(const u32x4*)(GU + (size_t)m * 2 * DFF + DFF + ff);
            }
#pragma unroll
        for (int ii = 0; ii < 4; ++ii) {
            const int m = mstart + i0 + ii;
            int seq, t, L; tokdec(m, seq, t, L);
            const u32x4 g0r = g0rr[ii], upr = uprr[ii];
            float g0[8], up[8];
#pragma unroll
            for (int q = 0; q < 4; ++q) { g0[2 * q] = lo16(g0r[q]); g0[2 * q + 1] = hi16(g0r[q]); up[2 * q] = lo16(upr[q]); up[2 * q + 1] = hi16(upr[q]); }
            if (t < 2) {
                f32x4 b0a = {0.f, 0.f, 0.f, 0.f}, b0b = b0a, b1a = b0a, b1b = b0a;
                if (seq >= 8) {
                    const float* sb = p.st_fC + (((size_t)layer * 128 + (seq - 8)) * 2) * DFF + ff;
                    b0a = *(const f32x4*)sb; b0b = *(const f32x4*)(sb + 4); b1a = *(const f32x4*)(sb + DFF); b1b = *(const f32x4*)(sb + DFF + 4);
                }
#pragma unroll
                for (int e = 0; e < 8; ++e) {
                    const float s0 = e < 4 ? b0a[e] : b0b[e - 4], s1 = e < 4 ? b1a[e] : b1b[e - 4];
                    if (t == 0) { g1[e] = s1; g2[e] = s0; } else { g2[e] = s1; }
                }
            }
            u32x4 o;
#pragma unroll
            for (int q = 0; q < 4; ++q) {
                const int e0 = 2 * q, e1 = 2 * q + 1;
                const float c0 = w0[e0] * g2[e0] + w1[e0] * g1[e0] + w2[e0] * g0[e0], c1 = w0[e1] * g2[e1] + w1[e1] * g1[e1] + w2[e1] * g0[e1];
                o[q] = pack2(siluf_(c0) * up[e0], siluf_(c1) * up[e1]);
            }
            *(u32x4*)(H + (size_t)m * DFF + ff) = o;
            if (t >= L - 2) {
                float* od = (seq < 8) ? p.fC_p + (((size_t)layer * 8 + seq) * 2 + (t - (L - 2))) * DFF + ff
                                      : p.fC_s + (((size_t)layer * 128 + (seq - 8)) * 2 + (t - (L - 2))) * DFF + ff;
                *(f32x4*)od = (f32x4){g0[0], g0[1], g0[2], g0[3]}; *(f32x4*)(od + 4) = (f32x4){g0[4], g0[5], g0[6], g0[7]};
            }
#pragma unroll
            for (int e = 0; e < 8; ++e) { g2[e] = g1[e]; g1[e] = g0[e]; }
        }
        }
    }
}

__device__ __forceinline__ void rwkv_norm_phase(CParams& p, int layer) {
    const int tid = otid(), lane = tid & 63, wave = tid >> 6;
    const int gw = obid() * 8 + wave, NGW = ogrid() * 8;
    const int j = layer >> 1;
    const float* g = p.norm_mix + layer * D;
    const float* mx = p.rwkv_mix + (size_t)j * 6 * D;
    bf16_t* XR = (bf16_t*)p.RB; bf16_t* XK = XR + (size_t)MPAD * D; bf16_t* XV = XK + (size_t)MPAD * D; bf16_t* PV = XV + (size_t)MPAD * D;
    f32x4 gv[4], mr[4], mk[4], mv[4];
#pragma unroll
    for (int q = 0; q < 4; ++q) {
        gv[q] = *(const f32x4*)(g + q * 256 + lane * 4);
        mr[q] = *(const f32x4*)(mx + 0 * D + q * 256 + lane * 4); mk[q] = *(const f32x4*)(mx + 2 * D + q * 256 + lane * 4); mv[q] = *(const f32x4*)(mx + 3 * D + q * 256 + lane * 4);
    }
    f32x4 nv[4], np_[4];
    auto load_rows = [&](int m) {
        int seq, t, L; tokdec(m, seq, t, L);
        const float* s0 = p.X + (size_t)m * D;
        const float* s1 = (t > 0) ? s0 - D : (seq >= 8 ? p.st_rSh + ((size_t)j * 128 + (seq - 8)) * D : nullptr);
#pragma unroll
        for (int q = 0; q < 4; ++q) { nv[q] = *(const f32x4*)(s0 + q * 256 + lane * 4); np_[q] = s1 ? *(const f32x4*)(s1 + q * 256 + lane * 4) : (f32x4){0.f, 0.f, 0.f, 0.f}; }
    };
    if (gw < T) load_rows(gw);
    for (int m = gw; m < MPAD; m += NGW) {
        if (m >= T) {
            u32x2 z; z.x = 0; z.y = 0;
#pragma unroll
            for (int q = 0; q < 4; ++q) { const size_t o = (size_t)m * D + q * 256 + lane * 4; *(u32x2*)(p.HN + o) = z; *(u32x2*)(XR + o) = z; *(u32x2*)(XK + o) = z; *(u32x2*)(XV + o) = z; *(u32x2*)(PV + o) = z; }
            continue;
        }
        int seq, t, L; tokdec(m, seq, t, L);
        f32x4 v[4], pv[4]; float ss = 0.f, sp = 0.f;
#pragma unroll
        for (int q = 0; q < 4; ++q) { v[q] = nv[q]; pv[q] = np_[q]; ss += v[q].x * v[q].x + v[q].y * v[q].y + v[q].z * v[q].z + v[q].w * v[q].w; sp += pv[q].x * pv[q].x + pv[q].y * pv[q].y + pv[q].z * pv[q].z + pv[q].w * pv[q].w; }
        if (m + NGW < T) load_rows(m + NGW);
        ss = wave_sum(ss); sp = wave_sum(sp);
        const float rstd = rsqrtf(ss * (1.f / D) + 1e-6f);
        const float rstp = (t > 0) ? rsqrtf(sp * (1.f / D) + 1e-6f) : 0.f;
#pragma unroll
        for (int q = 0; q < 4; ++q) {
            const f32x4 h = v[q] * rstd * gv[q];
            const f32x4 pr = (t > 0) ? pv[q] * rstp * gv[q] : pv[q];
            const f32x4 dd = pr - h;
            const f32x4 xr = h + dd * mr[q], xk = h + dd * mk[q], xv = h + dd * mv[q];
            const size_t o = (size_t)m * D + q * 256 + lane * 4;
            u32x2 w;
            w.x = pack2(h.x, h.y); w.y = pack2(h.z, h.w); *(u32x2*)(p.HN + o) = w;
            w.x = pack2(pr.x, pr.y); w.y = pack2(pr.z, pr.w); *(u32x2*)(PV + o) = w;
            w.x = pack2(xr.x, xr.y); w.y = pack2(xr.z, xr.w); *(u32x2*)(XR + o) = w;
            w.x = pack2(xk.x, xk.y); w.y = pack2(xk.z, xk.w); *(u32x2*)(XK + o) = w;
            w.x = pack2(xv.x, xv.y); w.y = pack2(xv.z, xv.w); *(u32x2*)(XV + o) = w;
            if (t == L - 1) {
                float* od = (seq < 8) ? p.rSh_p + ((size_t)j * 8 + seq) * D : p.rSh_s + ((size_t)j * 128 + (seq - 8)) * D;
                *(f32x4*)(od + q * 256 + lane * 4) = h;
            }
        }
    }
}
__device__ __forceinline__ void rwkv_in_phase(CParams& p, int j, char* smem) {
    const int tid = otid(), G = ogrid(), bid = obid();
    constexpr int NLORA = (MPAD / 256) * 3;
    const bool split = G > NLORA + 36;
    {
        pg8::Gemm g; g.A = (const bf16_t*)p.RB; g.Bt = p.rwkv1_t + (size_t)j * 3072 * D; g.lda = D; g.K = D; g.nM = split ? 64 : MPAD / 256; g.nN = 12;
        g.A2 = g.A; g.ksplit = 1 << 20; g.agstride = (size_t)MPAD * D; g.npg = 4; g.brows_tile = 256; g.brows_half = 128; g.arows_tile = 256; g.arow0 = 0; g.perm = 0;
        g.perm = 1;
        pg8::EpiRwkv1 E; E.C1 = p.RA; E.VF = (j == 0) ? p.VFIRST : nullptr; E.colbase = 0; E.lora = 0; E.rowbase = 0;
        pg8::gemm_phase(tid, smem, g, G, bid, E);
    }
    if (!split || bid < NLORA) {
        pg8::Gemm g; g.A = p.HN; g.Bt = p.l1t + (size_t)j * 768 * 2048; g.lda = D; g.K = 2048; g.nM = MPAD / 256; g.nN = 3;
        g.A2 = (const bf16_t*)(p.RB + 3 * (size_t)MPAD * D * 2); g.ksplit = 16; g.agstride = 0; g.npg = 1 << 20; g.brows_tile = 256; g.brows_half = 128; g.arows_tile = 256; g.arow0 = 0; g.perm = 0;
        g.perm = 1;
        pg8::EpiRwkv1 E; E.C1 = p.RA; E.VF = nullptr; E.colbase = 3072; E.lora = 1; E.rowbase = 0;
        pg8::gemm_phase(tid, smem, g, G, bid, E);
    } else {
        pg8::Gemm g; g.A = (const bf16_t*)p.RB; g.Bt = p.rwkv1_t + (size_t)j * 3072 * D; g.lda = D; g.K = D; g.nM = 3; g.nN = 12;
        g.A2 = g.A; g.ksplit = 1 << 20; g.agstride = (size_t)MPAD * D; g.npg = 4; g.brows_tile = 256; g.brows_half = 128; g.arows_tile = 256; g.arow0 = 64 * 256; g.perm = 0;
        g.perm = 1;
        pg8::EpiRwkv1 E; E.C1 = p.RA; E.VF = (j == 0) ? p.VFIRST : nullptr; E.colbase = 0; E.lora = 0; E.rowbase = 64 * 256;
        pg8::gemm_phase(tid, smem, g, G - NLORA, bid - NLORA, E);
    }
}
__device__ __forceinline__ void rwkv_lora_phase(CParams& p, int j, char* smem) {
    const int tid = otid(), lane = tid & 63, wid = tid >> 6, wr = wid >> 1, wc = wid & 1, fr = lane & 15, fq = lane >> 4;
    const int nMt = MPAD / 256, nNt = 8, ngrp = (j == 0) ? 3 : 4, total = nMt * nNt * ngrp, G = ogrid();
    const bf16_t* C1 = p.RA;
    char* As = smem; char* Bs = smem + 2 * A_STAGE;
    ALoadPlain al; BLoad bl;
    auto setup = [&](int u, int& grp, int& m0, int& n0, int& nkt) {
        grp = u / (nMt * nNt); const int r = u - grp * nMt * nNt, nt = r / nMt, mt = r - nt * nMt; m0 = mt * 256; n0 = nt * 128;
        const int acol = grp == 0 ? 3072 : grp == 1 ? 3200 : grp == 2 ? 3328 : 3584;
        const int K = grp == 2 ? 192 : 64; nkt = K / 64;
        const bf16_t* Bt = grp == 0 ? p.w2t + (size_t)j * D * 64 : grp == 1 ? p.a2t + (size_t)j * D * 64 : grp == 2 ? p.g2t + (size_t)j * D * 192 : p.v2t;
        al.init(tid, C1 + acol, R1_N, m0, MPAD - 1);
        bl.init(tid, Bt + (size_t)n0 * K, Bt + (size_t)(n0 + 64) * K, K);
    };
    int u = obid(), st = 0;
    int grp = 0, m0 = 0, n0 = 0, nkt = 1;
    if (u < total) { setup(u, grp, m0, n0, nkt); al.issue(0); bl.issue(0); }
    for (; u < total; u += G) {
        const int cgrp = grp, cm0 = m0, cn0 = n0, cnkt = nkt;
        f32x4 acc[4][4];
#pragma unroll
        for (int a = 0; a < 4; ++a)
#pragma unroll
            for (int b = 0; b < 4; ++b) acc[a][b] = (f32x4){0.f, 0.f, 0.f, 0.f};
        for (int kt = 0; kt < cnkt; ++kt) {
            al.commit(As + st * A_STAGE); bl.commit(Bs + st * B_STAGE);
            lds_barrier();
            if (kt + 1 < cnkt) { al.issue(kt + 1); bl.issue(kt + 1); }
            else if (u + G < total) { setup(u + G, grp, m0, n0, nkt); al.issue(0); bl.issue(0); }
            const char* Ac = As + st * A_STAGE; const char* Bc = Bs + st * B_STAGE;
#pragma unroll
            for (int ks = 0; ks < 2; ++ks) {
                bf16x8 af[4], bfr[4];
#pragma unroll
                for (int mf = 0; mf < 4; ++mf) af[mf] = *(const bf16x8*)(Ac + lds_off(wr * 64 + mf * 16 + fr, ks * 32 + fq * 8));
#pragma unroll
                for (int nf = 0; nf < 4; ++nf) bfr[nf] = *(const bf16x8*)(Bc + lds_off(wc * 64 + nf * 16 + fr, ks * 32 + fq * 8));
#pragma unroll
                for (int mf = 0; mf < 4; ++mf)
#pragma unroll
                    for (int nf = 0; nf < 4; ++nf) acc[mf][nf] = __builtin_amdgcn_mfma_f32_16x16x32_bf16(bfr[nf], af[mf], acc[mf][nf], 0, 0, 0);
            }
            st ^= 1;
        }
        bf16_t* O = (bf16_t*)(p.RB + (size_t)cgrp * MPAD * D * 2);
        const float* bias = cgrp == 0 ? p.rwkv_w0 + (size_t)j * D : cgrp == 1 ? p.rwkv_a0 + (size_t)j * D : cgrp == 3 ? p.rwkv_v0 : nullptr;
#pragma unroll
        for (int mf = 0; mf < 4; ++mf) {
            const int m = cm0 + wr * 64 + mf * 16 + fr;
#pragma unroll
            for (int nf = 0; nf < 4; ++nf) {
                const int n = cn0 + wc * 64 + nf * 16 + 4 * fq;
                f32x4 v = acc[mf][nf];
                if (bias) v = v + *(const f32x4*)(bias + n);
                if (cgrp != 2) { v[0] = sigmoidf_(v[0]); v[1] = sigmoidf_(v[1]); v[2] = sigmoidf_(v[2]); v[3] = sigmoidf_(v[3]); }
                if (cgrp == 0) v = v * 0.60653066f;
                u32x2 w; w.x = pack2(v[0], v[1]); w.y = pack2(v[2], v[3]);
                *(u32x2*)(O + (size_t)m * D + n) = w;
            }
        }
    }
    lds_barrier();
}

__device__ __forceinline__ int perm32k(int kl) { return 8 * ((kl >> 2) & 3) + 4 * (kl >> 4) + (kl & 3); }
__device__ __forceinline__ void gdn_prep_phase(CParams& p, int j, char* smem) {
    int tid = otid(), lane = tid & 63, wid = tid >> 6, fr = lane & 15, fq = lane >> 4;
    bf16_t* qs = (bf16_t*)smem;
    bf16_t* ks = (bf16_t*)(smem + 17408);
    float* rhs = (float*)(smem + 34816);
    float* Am = (float*)(smem + 100352);
    float* Gs = (float*)(smem + 117760);
    float* betas = (float*)(smem + 118016);
    float* gs = (float*)(smem + 118272);
    float* cwl = (float*)(smem + 118528);
    float* Tinv = (float*)(smem + 124672);
    bf16_t* AmB = qs;
    bf16_t* XT = ks;
    const bf16_t* PROJ = p.RA;
    int c8 = tid & 15, rg = tid >> 4, r0 = 2 * rg;
    const int G = ogrid(), bid = obid();
    const bool sticky = (G & 7) == 0;
    const int nitems = sticky ? 8 * NCHUNK : 64 * NCHUNK, istep = sticky ? (G >> 3) : G;
    int q0 = sticky ? (bid >> 3) : bid;
    auto item_of = [&](int q, int& b, int& h, int& n) { if (sticky) { h = bid & 7; b = q / NCHUNK; n = q - b * NCHUNK; } else { n = q % NCHUNK; const int bh = q / NCHUNK; h = bh & 7; b = bh >> 3; } };
    u32x4 rawp[3][5]; float abp[4];
    auto load_raw = [&](int q) {
        int b, h, n; item_of(q, b, h, n);
        const int c = (n == 0) ? 16 : 64, tstart = (n == 0) ? 0 : 16 + 64 * (n - 1);
#pragma unroll
        for (int part = 0; part < 3; ++part) {
            const int col = part * 1024 + h * 128 + c8 * 8;
#pragma unroll
            for (int i = 0; i < 5; ++i) {
                const int r = r0 - 3 + i, t = tstart + r;
                u32x4 v = {0u, 0u, 0u, 0u};
                if (t >= 0 && r < c) v = *(const u32x4*)(PROJ + (size_t)(b * LP + t) * GIN_LD + col);
                rawp[part][i] = v;
            }
        }
#pragma unroll
        for (int rr = 0; rr < 2; ++rr) {
            const int r = r0 + rr;
            abp[2 * rr] = 0.f; abp[2 * rr + 1] = 0.f;
            if (r < c) { abp[2 * rr] = p.AB[(size_t)(b * LP + tstart + r) * 16 + h]; abp[2 * rr + 1] = p.AB[(size_t)(b * LP + tstart + r) * 16 + 8 + h]; }
        }
    };
    int cur_h = -1; float Aexp = 0.f, dtb = 0.f;
    if (q0 < nitems) load_raw(q0);
    for (int q = q0; q < nitems; q += istep) {
        asm volatile("" : "+v"(tid));
        lane = tid & 63; wid = tid >> 6; fr = lane & 15; fq = lane >> 4; c8 = tid & 15; rg = tid >> 4; r0 = 2 * rg;
        int b, h, n; item_of(q, b, h, n);
        const int item = (b * 8 + h) * NCHUNK + n;
        const int c = (n == 0) ? 16 : 64;
        char* rec = p.RB + (size_t)item * CH_BYTES;
        if (h != cur_h) {
            lds_barrier();
            for (int idx = tid; idx < 3 * 4 * 128; idx += NTH) { const int cc = idx & 127, jj = (idx >> 7) & 3, part = idx >> 9; cwl[idx] = p.gdn_conv_w[((size_t)j * 4 + jj) * 3072 + part * 1024 + h * 128 + cc]; }
            Aexp = __expf(p.gdn_A_log[j * 8 + h]); dtb = p.gdn_dt_bias[j * 8 + h];
            cur_h = h;
            lds_barrier();
        }
        float bet[2], gg[2];
#pragma unroll
        for (int rr = 0; rr < 2; ++rr) {
            const int r = r0 + rr;
            if (r < c) { gg[rr] = -Aexp * softplusf_(abp[2 * rr] + dtb); bet[rr] = sigmoidf_(abp[2 * rr + 1]); }
            else { gg[rr] = 0.f; bet[rr] = 0.f; }
            if (c8 == 0) { gs[r] = gg[rr]; betas[r] = bet[rr]; }
        }
#pragma unroll
        for (int pi = 0; pi < 3; ++pi) {
            const int part = (pi == 0) ? 2 : (pi == 1 ? 0 : 1);
            float o[2][8];
#pragma unroll
            for (int e = 0; e < 8; ++e) { o[0][e] = 0.f; o[1][e] = 0.f; }
#pragma unroll
            for (int jj = 0; jj < 4; ++jj) {
                const f32x4 w0 = *(const f32x4*)(cwl + (part * 4 + jj) * 128 + c8 * 8), w1 = *(const f32x4*)(cwl + (part * 4 + jj) * 128 + c8 * 8 + 4);
                const u32x4 ra = rawp[part][jj], rb = rawp[part][jj + 1];
#pragma unroll
                for (int qq = 0; qq < 4; ++qq) {
                    const float wa = qq < 2 ? w0[2 * qq] : w1[2 * qq - 4], wb = qq < 2 ? w0[2 * qq + 1] : w1[2 * qq - 3];
                    o[0][2 * qq] += wa * lo16(ra[qq]); o[0][2 * qq + 1] += wb * hi16(ra[qq]);
                    o[1][2 * qq] += wa * lo16(rb[qq]); o[1][2 * qq + 1] += wb * hi16(rb[qq]);
                }
            }
#pragma unroll
            for (int rr = 0; rr < 2; ++rr) {
                const int r = r0 + rr;
#pragma unroll
                for (int e = 0; e < 8; ++e) o[rr][e] = (r < c) ? siluf_(o[rr][e]) : 0.f;
                if (part == 2) {
                    f32x4 v0, v1;
#pragma unroll
                    for (int e = 0; e < 4; ++e) { v0[e] = o[rr][e] * bet[rr]; v1[e] = o[rr][e + 4] * bet[rr]; }
                    *(f32x4*)(rhs + r * 256 + c8 * 8) = v0; *(f32x4*)(rhs + r * 256 + c8 * 8 + 4) = v1;
                } else {
                    float ss = 0.f;
#pragma unroll
                    for (int e = 0; e < 8; ++e) ss += o[rr][e] * o[rr][e];
                    ss = row16_sum(ss);
                    const float rn = rsqrtf(ss + 1e-6f) * (part == 0 ? 0.08838834764831845f : 1.f);
                    u32x4 w;
#pragma unroll
                    for (int qq = 0; qq < 4; ++qq) w[qq] = pack2(o[rr][2 * qq] * rn, o[rr][2 * qq + 1] * rn);
                    *(u32x4*)((part == 0 ? qs : ks) + r * 136 + c8 * 8) = w;
                }
            }
            __builtin_amdgcn_sched_barrier(0);
        }
        if (q + istep < nitems) load_raw(q + istep);
        lds_barrier();
        if (wid == 0) {
            float x = gs[lane];
#pragma unroll
            for (int o = 1; o < 64; o <<= 1) { const float y = __shfl_up(x, o); if (lane >= o) x += y; }
            Gs[lane] = x;
        }
        lds_barrier();
        const float glast = Gs[63];
#pragma unroll
        for (int rr = 0; rr < 2; ++rr) {
            const int r = r0 + rr; const float eg = __expf(Gs[r]), be = betas[r] * eg;
            const u32x4 kq = *(const u32x4*)(ks + r * 136 + c8 * 8), qq_ = *(const u32x4*)(qs + r * 136 + c8 * 8);
            f32x4 v0, v1;
            v0[0] = lo16(kq[0]) * be; v0[1] = hi16(kq[0]) * be; v0[2] = lo16(kq[1]) * be; v0[3] = hi16(kq[1]) * be;
            v1[0] = lo16(kq[2]) * be; v1[1] = hi16(kq[2]) * be; v1[2] = lo16(kq[3]) * be; v1[3] = hi16(kq[3]) * be;
            *(f32x4*)(rhs + r * 256 + 128 + c8 * 8) = v0; *(f32x4*)(rhs + r * 256 + 128 + c8 * 8 + 4) = v1;
            u32x4 wq;
#pragma unroll
            for (int e = 0; e < 4; ++e) wq[e] = pack2(lo16(qq_[e]) * eg, hi16(qq_[e]) * eg);
            { const int kb32 = (c8 * 8) & ~31, kl = (c8 * 8) & 31;
              u32x2 lo; lo.x = wq[0]; lo.y = wq[1]; u32x2 hi; hi.x = wq[2]; hi.y = wq[3];
              *(u32x2*)(rec + 32768 + ((size_t)r * 128 + kb32 + perm32k(kl)) * 2) = lo;
              *(u32x2*)(rec + 32768 + ((size_t)r * 128 + kb32 + perm32k(kl + 4)) * 2) = hi; }
        }
        {
            const int mat = wid >> 2, ifr = wid & 3;
            const bf16_t* Xs = mat ? qs : ks;
            f32x4 acc[4];
#pragma unroll
            for (int jf = 0; jf < 4; ++jf) acc[jf] = (f32x4){0.f, 0.f, 0.f, 0.f};
#pragma unroll
            for (int kk = 0; kk < 4; ++kk) {
                const bf16x8 xf = *(const bf16x8*)(Xs + (ifr * 16 + fr) * 136 + kk * 32 + fq * 8);
#pragma unroll
                for (int jf = 0; jf < 4; ++jf) {
                    if (jf <= ifr) {
                        const bf16x8 yf = *(const bf16x8*)(ks + (jf * 16 + fr) * 136 + kk * 32 + fq * 8);
                        acc[jf] = __builtin_amdgcn_mfma_f32_16x16x32_bf16(xf, yf, acc[jf], 0, 0, 0);
                    }
                }
            }
#pragma unroll
            for (int jf = 0; jf < 4; ++jf) {
                const int jc = jf * 16 + fr; const float Gj = Gs[jc];
#pragma unroll
                for (int reg = 0; reg < 4; ++reg) {
                    const int i = ifr * 16 + 4 * fq + reg;
                    const float dec = __expf(Gs[i] - Gj);
                    if (mat == 0) { Am[i * 68 + jc] = (i > jc) ? betas[i] * acc[jf][reg] * dec : 0.f; }
                    else { const float v = (i >= jc) ? acc[jf][reg] * dec : 0.f; *(bf16_t*)(rec + 65536 + ((size_t)i * 64 + (jc & ~31) + perm32k(jc & 31)) * 2) = (bf16_t)f2bf(v); }
                }
            }
        }
        lds_barrier();
        {
            const int k = tid >> 2, jq = tid & 3;
            u32x4 o0, o1;
#pragma unroll
            for (int e = 0; e < 8; ++e) {
                const int ja = jq * 16 + 2 * e, jb = ja + 1;
                const float va = bf2f(ks[ja * 136 + k]) * __expf(glast - Gs[ja]), vb = bf2f(ks[jb * 136 + k]) * __expf(glast - Gs[jb]);
                if (e < 4) o0[e] = pack2(va, vb); else o1[e - 4] = pack2(va, vb);
            }
            { const int jb32 = (jq >> 1) * 32, hh = jq & 1;
              u32x2 g0; g0.x = o0[0]; g0.y = o0[1]; u32x2 g1; g1.x = o0[2]; g1.y = o0[3]; u32x2 g2; g2.x = o1[0]; g2.y = o1[1]; u32x2 g3; g3.x = o1[2]; g3.y = o1[3];
              char* kb_ = rec + 49152 + ((size_t)k * 64 + jb32 + 4 * hh) * 2;
              *(u32x2*)(kb_) = g0; *(u32x2*)(kb_ + 16) = g1; *(u32x2*)(kb_ + 32) = g2; *(u32x2*)(kb_ + 48) = g3; }
        }
        if (tid == 0) p.GL[item] = __expf(glast);
        lds_barrier();
        if (wid == 0) {
            const int bk = lane >> 4, cidx = lane & 15;
            float tcol[16];
#pragma unroll
            for (int i = 0; i < 16; ++i) {
                float sacc = (i == cidx) ? 1.f : 0.f;
#pragma unroll
                for (int jj = 0; jj < i; ++jj) sacc -= Am[(16 * bk + i) * 68 + 16 * bk + jj] * tcol[jj];
                tcol[i] = sacc;
            }
#pragma unroll
            for (int i = 0; i < 16; ++i) Tinv[(bk * 16 + i) * 16 + cidx] = tcol[i];
        } else {
            for (int idx = tid - 64; idx < 64 * 32; idx += NTH - 64) { const int i = idx >> 5, j2 = (idx & 31) * 2; *(unsigned*)(AmB + i * 72 + j2) = pack2(-Am[i * 68 + j2], -Am[i * 68 + j2 + 1]); }
        }
        lds_barrier();
#pragma unroll 1
        for (int blk = 0; blk < 4; ++blk) {
#pragma unroll
            for (int c2 = 0; c2 < 2; ++c2) {
                const int ct = wid * 2 + c2;
                f32x4 xacc = {0.f, 0.f, 0.f, 0.f};
#pragma unroll
                for (int kq = 0; kq < 4; ++kq) {
                    const float av = Tinv[(blk * 16 + fr) * 16 + 4 * kq + fq];
                    const float bv = rhs[(16 * blk + 4 * kq + fq) * 256 + ct * 16 + fr];
                    xacc = __builtin_amdgcn_mfma_f32_16x16x4f32(av, bv, xacc, 0, 0, 0);
                }
#pragma unroll
                for (int reg = 0; reg < 4; ++reg) rhs[(16 * blk + 4 * fq + reg) * 256 + ct * 16 + fr] = xacc[reg];
                u32x2 xt; xt.x = pack2(xacc[0], xacc[1]); xt.y = pack2(xacc[2], xacc[3]);
                *(u32x2*)(XT + (ct * 16 + fr) * 24 + 4 * fq) = xt;
            }
            lds_barrier();
            if (blk < 3) {
                const int ntile = (3 - blk) * 16;
                for (int tl = wid; tl < ntile; tl += 8) {
                    const int rt = blk + 1 + (tl >> 4), ct = tl & 15;
                    f32x4 cacc;
#pragma unroll
                    for (int reg = 0; reg < 4; ++reg) cacc[reg] = rhs[(rt * 16 + 4 * fq + reg) * 256 + ct * 16 + fr];
                    u32x4 az = {0u, 0u, 0u, 0u}, bz = az;
                    if (fq < 2) { az = *(const u32x4*)(AmB + (rt * 16 + fr) * 72 + 16 * blk + 8 * fq); bz = *(const u32x4*)(XT + (ct * 16 + fr) * 24 + 8 * fq); }
                    cacc = __builtin_amdgcn_mfma_f32_16x16x32_bf16(__builtin_bit_cast(bf16x8, az), __builtin_bit_cast(bf16x8, bz), cacc, 0, 0, 0);
#pragma unroll
                    for (int reg = 0; reg < 4; ++reg) rhs[(rt * 16 + 4 * fq + reg) * 256 + ct * 16 + fr] = cacc[reg];
                }
                lds_barrier();
            }
        }
#pragma unroll
        for (int qq = 0; qq < 2; ++qq) {
            const int ch = tid + qq * NTH;
            { const int v = ch >> 3, i8 = (ch & 7) * 8;
              u32x4 o;
#pragma unroll
              for (int e = 0; e < 4; ++e) o[e] = pack2(rhs[(i8 + 2 * e) * 256 + v], rhs[(i8 + 2 * e + 1) * 256 + v]);
              *(u32x4*)(rec + ((size_t)v * 64 + i8) * 2) = o; }
            { const int i = ch >> 4, k8 = (ch & 15) * 8;
              const f32x4 a0 = *(const f32x4*)(rhs + i * 256 + 128 + k8), a1 = *(const f32x4*)(rhs + i * 256 + 128 + k8 + 4);
              u32x2 lo; lo.x = pack2(-a0[0], -a0[1]); lo.y = pack2(-a0[2], -a0[3]); u32x2 hi; hi.x = pack2(-a1[0], -a1[1]); hi.y = pack2(-a1[2], -a1[3]);
              const int kb32 = k8 & ~31, kl = k8 & 31;
              *(u32x2*)(rec + 16384 + ((size_t)i * 128 + kb32 + perm32k(kl)) * 2) = lo;
              *(u32x2*)(rec + 16384 + ((size_t)i * 128 + kb32 + perm32k(kl + 4)) * 2) = hi; }
        }
        if (n == NCHUNK - 1) {
            for (int idx = tid; idx < 3 * 3 * 128; idx += NTH) {
                const int cc = idx & 127, part = (idx >> 7) % 3, r = idx / 384;
                const int col = part * 1024 + h * 128 + cc;
                p.gC_p[(((size_t)j * 8 + b) * 3 + r) * 3072 + col] = bf2f(PROJ[(size_t)(b * LP + LP - 3 + r) * GIN_LD + col]);
            }
        }
        lds_barrier();
    }
}

__device__ __forceinline__ bf16x8 xfrag(const char* base, int row, int stride, int kbase, int fq) {
    return *(const bf16x8*)(base + row * stride + (kbase + 8 * fq) * 2);
}
__device__ __forceinline__ bf16x8 pack8(const f32x4& a, const f32x4& b) {
    u32x4 r; r.x = pack2(a[0], a[1]); r.y = pack2(a[2], a[3]); r.z = pack2(b[0], b[1]); r.w = pack2(b[2], b[3]);
    return __builtin_bit_cast(bf16x8, r);
}
__device__ __forceinline__ void gdn_scan_prompt_item(CParams& p, int j, int bh, char* smem) {
    int tid = otid(), lane = tid & 63, wid = tid >> 6, fr = lane & 15, fq = lane >> 4;
    const int h = bh & 7, b = bh >> 3; int v0 = 16 * wid;
    char* UT = smem; char* WN = smem + 18432; char* QG = smem + 35840; char* KDT = smem + 53248; char* QKM = smem + 71680;
    float* OT = (float*)(smem + 80896);
    const bf16_t* PROJ = p.RA; bf16_t* OG = p.HN;
    f32x4 S[8];
#pragma unroll
    for (int kf = 0; kf < 8; ++kf) S[kf] = (f32x4){0.f, 0.f, 0.f, 0.f};
    int cv = tid & 15, orow = tid >> 4;
    const f32x4 nw0 = *(const f32x4*)(p.gdn_norm_w + j * 128 + cv * 8), nw1 = *(const f32x4*)(p.gdn_norm_w + j * 128 + cv * 8 + 4);
    u32x4 pre[9], zpre[2];
    const char* rec0 = p.RB + (size_t)(bh * NCHUNK) * CH_BYTES;
#pragma unroll
    for (int i = 0; i < 9; ++i) pre[i] = *(const u32x4*)(rec0 + (size_t)(tid + 512 * i) * 16);
    float gl_pre = p.GL[bh * NCHUNK];
    for (int n = 0; n < NCHUNK; ++n) {
        asm volatile("" : "+v"(tid));
        lane = tid & 63; wid = tid >> 6; fr = lane & 15; fq = lane >> 4; v0 = 16 * wid; cv = tid & 15; orow = tid >> 4;
#pragma unroll
        for (int i = 0; i < 9; ++i) {
            const int idx = tid + 512 * i;
            char* dst;
            if (i < 2) { const int li = idx; dst = UT + (li >> 3) * 144 + (li & 7) * 16; }
            else if (i < 4) { const int li = idx - 1024; dst = WN + (li >> 4) * 272 + (li & 15) * 16; }
            else if (i < 6) { const int li = idx - 2048; dst = QG + (li >> 4) * 272 + (li & 15) * 16; }
            else if (i < 8) { const int li = idx - 3072; dst = KDT + (li >> 3) * 144 + (li & 7) * 16; }
            else { const int li = idx - 4096; dst = QKM + (li >> 3) * 144 + (li & 7) * 16; }
            *(u32x4*)dst = pre[i];
        }
        const float gl = gl_pre;
        lds_barrier();
        const int c = (n == 0) ? 16 : 64, tstart = (n == 0) ? 0 : 16 + 64 * (n - 1);
        if (n + 1 < NCHUNK) {
            const char* recn = rec0 + (size_t)(n + 1) * CH_BYTES;
#pragma unroll
            for (int i = 0; i < 9; ++i) pre[i] = *(const u32x4*)(recn + (size_t)(tid + 512 * i) * 16);
            gl_pre = p.GL[bh * NCHUNK + n + 1];
        }
#pragma unroll
        for (int q = 0; q < 2; ++q) {
            const int i = orow + 32 * q;
            const size_t m = (size_t)b * LP + tstart + (i < c ? i : 0);
            zpre[q] = *(const u32x4*)(PROJ + m * GIN_LD + 3072 + h * 128 + cv * 8);
        }
        bf16x8 Sb[4];
#pragma unroll
        for (int ks = 0; ks < 4; ++ks) Sb[ks] = pack8(S[2 * ks], S[2 * ks + 1]);
        f32x4 vn[4], o[4];
#pragma unroll
        for (int f = 0; f < 4; ++f) {
            const u32x2 raw = *(const u32x2*)(UT + (v0 + fr) * 144 + (16 * f + 4 * fq) * 2);
            vn[f] = (f32x4){lo16(raw.x), hi16(raw.x), lo16(raw.y), hi16(raw.y)};
            o[f] = (f32x4){0.f, 0.f, 0.f, 0.f};
        }
#pragma unroll
        for (int kb = 0; kb < 2; ++kb) {
            bf16x8 xw[2][4], xq[2][4];
#pragma unroll
            for (int k2 = 0; k2 < 2; ++k2)
#pragma unroll
                for (int f = 0; f < 4; ++f) { xw[k2][f] = xfrag(WN, 16 * f + fr, 272, 32 * (2 * kb + k2), fq); xq[k2][f] = xfrag(QG, 16 * f + fr, 272, 32 * (2 * kb + k2), fq); }
            __builtin_amdgcn_sched_barrier(0);
#pragma unroll
            for (int k2 = 0; k2 < 2; ++k2)
#pragma unroll
                for (int f = 0; f < 4; ++f) {
                    vn[f] = __builtin_amdgcn_mfma_f32_16x16x32_bf16(xw[k2][f], Sb[2 * kb + k2], vn[f], 0, 0, 0);
                    o[f] = __builtin_amdgcn_mfma_f32_16x16x32_bf16(xq[k2][f], Sb[2 * kb + k2], o[f], 0, 0, 0);
                }
            __builtin_amdgcn_sched_barrier(0);
        }
        bf16x8 Vb[2];
        Vb[0] = pack8(vn[0], vn[1]); Vb[1] = pack8(vn[2], vn[3]);
        {
            bf16x8 xm[2][4], xk0[2][4];
#pragma unroll
            for (int js = 0; js < 2; ++js)
#pragma unroll
                for (int f = 0; f < 4; ++f) { xm[js][f] = xfrag(QKM, 16 * f + fr, 144, 32 * js, fq); xk0[js][f] = xfrag(KDT, 16 * f + fr, 144, 32 * js, fq); }
            __builtin_amdgcn_sched_barrier(0);
#pragma unroll
            for (int js = 0; js < 2; ++js)
#pragma unroll
                for (int f = 0; f < 4; ++f) o[f] = __builtin_amdgcn_mfma_f32_16x16x32_bf16(xm[js][f], Vb[js], o[f], 0, 0, 0);
#pragma unroll
            for (int kf = 0; kf < 4; ++kf) {
                S[kf] = S[kf] * gl;
#pragma unroll
                for (int js = 0; js < 2; ++js) S[kf] = __builtin_amdgcn_mfma_f32_16x16x32_bf16(xk0[js][kf], Vb[js], S[kf], 0, 0, 0);
            }
            __builtin_amdgcn_sched_barrier(0);
        }
        {
            bf16x8 xk1[2][4];
#pragma unroll
            for (int js = 0; js < 2; ++js)
#pragma unroll
                for (int f = 0; f < 4; ++f) xk1[js][f] = xfrag(KDT, 16 * (4 + f) + fr, 144, 32 * js, fq);
#pragma unroll
            for (int f = 0; f < 4; ++f)
#pragma unroll
                for (int reg = 0; reg < 4; ++reg) OT[(16 * f + 4 * fq + reg) * 132 + v0 + fr] = o[f][reg];
            __builtin_amdgcn_sched_barrier(0);
#pragma unroll
            for (int kf = 4; kf < 8; ++kf) {
                S[kf] = S[kf] * gl;
#pragma unroll
                for (int js = 0; js < 2; ++js) S[kf] = __builtin_amdgcn_mfma_f32_16x16x32_bf16(xk1[js][kf - 4], Vb[js], S[kf], 0, 0, 0);
            }
        }
        lds_barrier();
#pragma unroll
        for (int q = 0; q < 2; ++q) {
            const int i = orow + 32 * q;
            const f32x4 a0 = *(const f32x4*)(OT + i * 132 + cv * 8), a1 = *(const f32x4*)(OT + i * 132 + cv * 8 + 4);
            float ss = a0[0] * a0[0] + a0[1] * a0[1] + a0[2] * a0[2] + a0[3] * a0[3] + a1[0] * a1[0] + a1[1] * a1[1] + a1[2] * a1[2] + a1[3] * a1[3];
            ss = row16_sum(ss);
            const float rstd = rsqrtf(ss * (1.f / 128.f) + 1e-6f);
            if (i < c) {
                const u32x4 z = zpre[q];
                u32x4 w;
                w.x = pack2(a0[0] * rstd * nw0[0] * siluf_(lo16(z.x)), a0[1] * rstd * nw0[1] * siluf_(hi16(z.x)));
                w.y = pack2(a0[2] * rstd * nw0[2] * siluf_(lo16(z.y)), a0[3] * rstd * nw0[3] * siluf_(hi16(z.y)));
                w.z = pack2(a1[0] * rstd * nw1[0] * siluf_(lo16(z.z)), a1[1] * rstd * nw1[1] * siluf_(hi16(z.z)));
                w.w = pack2(a1[2] * rstd * nw1[2] * siluf_(lo16(z.w)), a1[3] * rstd * nw1[3] * siluf_(hi16(z.w)));
                const size_t m = (size_t)b * LP + tstart + i;
                *(u32x4*)(OG + m * D + h * 128 + cv * 8) = w;
            }
        }
    }
    float* So = p.gS_p + (((size_t)j * 8 + b) * 8 + h) * 16384;
#pragma unroll
    for (int kf = 0; kf < 8; ++kf)
#pragma unroll
        for (int reg = 0; reg < 4; ++reg) So[(size_t)(16 * kf + 4 * fq + reg) * 128 + v0 + fr] = S[kf][reg];
    lds_barrier();
}
__device__ __forceinline__ void gdn_sample_item(CParams& p, int j, int item, char* smem) {
    const int tid = otid(), lane = tid & 63, wid = tid >> 6;
    const int h = item & 7, b = item >> 3;
    float* qn = (float*)smem;
    float* kn = qn + 512;
    float* vv = kn + 512;
    float* gb = vv + 512;
    float* wred = gb + 8;
    float* red = wred + 24;
    float* osum = red + 2048;
    const bf16_t* PROJ = p.RA; bf16_t* OG = p.HN;
    const int mbase = TP + b * 4;
    {
        const int t = tid >> 7, c = tid & 127;
        float val[3];
#pragma unroll
        for (int part = 0; part < 3; ++part) {
            const int col = part * 1024 + h * 128 + c;
            float acc = 0.f;
#pragma unroll
            for (int jj = 0; jj < 4; ++jj) {
                const int xi = t + jj;
                const float x = xi < 3 ? p.st_gC[(((size_t)j * 128 + b) * 3 + xi) * 3072 + col] : bf2f(PROJ[(size_t)(mbase + xi - 3) * GIN_LD + col]);
                acc += p.gdn_conv_w[((size_t)j * 4 + jj) * 3072 + col] * x;
            }
            val[part] = siluf_(acc);
        }
        float sq = wave_sum(val[0] * val[0]), sk = wave_sum(val[1] * val[1]);
        if (lane == 0) { wred[wid * 2] = sq; wred[wid * 2 + 1] = sk; }
        lds_barrier();
        sq = wred[(2 * t) * 2] + wred[(2 * t + 1) * 2]; sk = wred[(2 * t) * 2 + 1] + wred[(2 * t + 1) * 2 + 1];
        qn[t * 128 + c] = val[0] * rsqrtf(sq + 1e-6f) * 0.08838834764831845f;
        kn[t * 128 + c] = val[1] * rsqrtf(sk + 1e-6f);
        vv[t * 128 + c] = val[2];
        if (tid < 4) {
            const float av = p.AB[(size_t)(mbase + tid) * 16 + h], bv = p.AB[(size_t)(mbase + tid) * 16 + 8 + h];
            gb[tid] = -__expf(p.gdn_A_log[j * 8 + h]) * softplusf_(av + p.gdn_dt_bias[j * 8 + h]);
            gb[4 + tid] = sigmoidf_(bv);
        }
    }
    for (int idx = tid; idx < 3 * 3 * 128; idx += NTH) {
        const int cc = idx & 127, part = (idx >> 7) % 3, r = idx / 384;
        const int col = part * 1024 + h * 128 + cc;
        p.gC_s[(((size_t)j * 128 + b) * 3 + r) * 3072 + col] = bf2f(PROJ[(size_t)(mbase + 1 + r) * GIN_LD + col]);
    }
    const int v4 = (tid & 31) * 4, ks = tid >> 5;
    const float* Sin = p.st_gS + (((size_t)j * 128 + b) * 8 + h) * 16384;
    f32x4 S[8];
#pragma unroll
    for (int q = 0; q < 8; ++q) S[q] = *(const f32x4*)(Sin + (size_t)(ks * 8 + q) * 128 + v4);
    lds_barrier();
    for (int t = 0; t < 4; ++t) {
        const float a = __expf(gb[t]), beta = gb[4 + t];
        f32x4 part = {0.f, 0.f, 0.f, 0.f};
#pragma unroll
        for (int q = 0; q < 8; ++q) { S[q] = S[q] * a; part = part + S[q] * kn[t * 128 + ks * 8 + q]; }
        *(f32x4*)(red + ks * 128 + v4) = part;
        lds_barrier();
        f32x4 r = *(const f32x4*)(vv + t * 128 + v4);
#pragma unroll
        for (int s = 0; s < 16; ++s) r = r - *(const f32x4*)(red + s * 128 + v4);
        r = r * beta;
        f32x4 op = {0.f, 0.f, 0.f, 0.f};
#pragma unroll
        for (int q = 0; q < 8; ++q) { S[q] = S[q] + r * kn[t * 128 + ks * 8 + q]; op = op + S[q] * qn[t * 128 + ks * 8 + q]; }
        lds_barrier();
        *(f32x4*)(red + ks * 128 + v4) = op;
        lds_barrier();
        if (tid < 128) { float s = 0.f;
#pragma unroll
            for (int q = 0; q < 16; ++q) s += red[q * 128 + tid];
            osum[t * 128 + tid] = s; }
        lds_barrier();
    }
    float* So = p.gS_s + (((size_t)j * 128 + b) * 8 + h) * 16384;
#pragma unroll
    for (int q = 0; q < 8; ++q) *(f32x4*)(So + (size_t)(ks * 8 + q) * 128 + v4) = S[q];
    {
        const int t = tid >> 7, c = tid & 127;
        const float ov = osum[t * 128 + c];
        float ss = wave_sum(ov * ov);
        if (lane == 0) wred[wid * 2] = ss;
        lds_barrier();
        ss = wred[(2 * t) * 2] + wred[(2 * t + 1) * 2];
        const float rstd = rsqrtf(ss * (1.f / 128.f) + 1e-6f);
        const size_t m = (size_t)mbase + t;
        const float z = bf2f(PROJ[m * GIN_LD + 3072 + h * 128 + c]);
        OG[m * D + h * 128 + c] = (bf16_t)f2bf(ov * rstd * p.gdn_norm_w[j * 128 + c] * siluf_(z));
    }
    lds_barrier();
}
__device__ __forceinline__ void gdn_scan_phase(CParams& p, int j, char* smem) {
    const int G = ogrid(), bid = obid();
    if (G > 64) {
        if (bid < 64) gdn_scan_prompt_item(p, j, bid, smem);
        else {
            for (int it = bid - 64; it < 1024; it += G - 64) gdn_sample_item(p, j, it, smem);
            lds_barrier();
            if (j == 0) prep_phase(p, smem, p.pad0, p.pad1, bid - 64, G - 64); else prep_phase(p, smem, p.pad1, p.njobs, bid - 64, G - 64);
        }
    } else {
        if (j == 0) prep_phase(p, smem, p.pad0, p.pad1, bid, G); else prep_phase(p, smem, p.pad1, p.njobs, bid, G);
        lds_barrier();
        for (int it = bid; it < 64; it += G) gdn_scan_prompt_item(p, j, it, smem);
        for (int it = bid; it < 1024; it += G) gdn_sample_item(p, j, it, smem);
    }
}

constexpr size_t RWB = (size_t)MPAD * D * 2;
constexpr int TOKF = 352;
__device__ __forceinline__ float row8_sum(float x) {
    x = dpp_add<0xB1>(x); x = dpp_add<0x4E>(x); x = dpp_add<0x141>(x);
    return x;
}
struct RVec { f32x4 w0, w1, a0, a1, f0, f1, k0, k1, r0, r1; float vv; };
__device__ __forceinline__ void rvec_load(RVec& V, const float* tb, int k8, int rw) {
    V.w0 = *(const f32x4*)(tb + k8); V.w1 = *(const f32x4*)(tb + k8 + 4);
    V.a0 = *(const f32x4*)(tb + 64 + k8); V.a1 = *(const f32x4*)(tb + 64 + k8 + 4);
    V.f0 = *(const f32x4*)(tb + 128 + k8); V.f1 = *(const f32x4*)(tb + 128 + k8 + 4);
    V.k0 = *(const f32x4*)(tb + 192 + k8); V.k1 = *(const f32x4*)(tb + 192 + k8 + 4);
    V.r0 = *(const f32x4*)(tb + 256 + k8); V.r1 = *(const f32x4*)(tb + 256 + k8 + 4);
    V.vv = tb[320 + rw];
}
__device__ __forceinline__ float rvec_step(f32x4& S0, f32x4& S1, const RVec& V) {
    const f32x4 d = S0 * V.k0 + S1 * V.k1;
    const float sa = row8_sum((d[0] + d[1]) + (d[2] + d[3]));
    const f32x4 P0 = S0 * V.w0 + V.f0 * V.vv, P1 = S1 * V.w1 + V.f1 * V.vv;
    S0 = P0 - V.a0 * sa; S1 = P1 - V.a1 * sa;
    const f32x4 e = S0 * V.r0 + S1 * V.r1;
    return row8_sum((e[0] + e[1]) + (e[2] + e[3]));
}
__device__ __forceinline__ void rwkv_scan_stream(CParams& p, int j, int h, int half, int m0, int ntok, int seglen, int seq0, char* smem) {
    const int tid = otid(), lane = tid & 63, wid = tid >> 6;
    float* bufs = (float*)smem;
    float* ybuf = (float*)(smem + 2 * 32 * TOKF * 4);
    const bf16_t* C1 = p.RA;
    const bf16_t* E = (const bf16_t*)p.RB; const bf16_t* AA = (const bf16_t*)(p.RB + RWB); const bf16_t* VM = (const bf16_t*)(p.RB + 3 * RWB);
    bf16_t* YRAW = (bf16_t*)(p.RB + 4 * RWB);
    const int nch = (ntok + 31) >> 5;
    if (wid >= 4) {
        const int pt = tid - 256, ptok = pt >> 3, c8 = (pt & 7) * 8, col = h * 64 + c8;
        const f32x4 kk0 = *(const f32x4*)(p.rwkv_k_k + (size_t)j * D + col), kk1 = *(const f32x4*)(p.rwkv_k_k + (size_t)j * D + col + 4);
        const f32x4 ka0 = *(const f32x4*)(p.rwkv_k_a + (size_t)j * D + col), ka1 = *(const f32x4*)(p.rwkv_k_a + (size_t)j * D + col + 4);
        u32x4 rr_, rk_, rv_, re_, ra_, rm_, rf_;
        auto load_raw = [&](int ch) {
            int tk = ch * 32 + ptok; if (tk > ntok - 1) tk = ntok - 1;
            const size_t m = (size_t)m0 + tk;
            rr_ = *(const u32x4*)(C1 + m * R1_N + col); rk_ = *(const u32x4*)(C1 + m * R1_N + 1024 + col); rv_ = *(const u32x4*)(C1 + m * R1_N + 2048 + col);
            re_ = *(const u32x4*)(E + m * D + col); ra_ = *(const u32x4*)(AA + m * D + col);
            if (j == 1) { rm_ = *(const u32x4*)(VM + m * D + col); rf_ = *(const u32x4*)(p.VFIRST + m * D + col); }
        };
        auto prep_write = [&](float* buf) {
            float r[8], k[8], v[8], e[8], a[8];
#pragma unroll
            for (int q = 0; q < 4; ++q) {
                r[2 * q] = lo16(rr_[q]); r[2 * q + 1] = hi16(rr_[q]); k[2 * q] = lo16(rk_[q]); k[2 * q + 1] = hi16(rk_[q]);
                v[2 * q] = lo16(rv_[q]); v[2 * q + 1] = hi16(rv_[q]); e[2 * q] = lo16(re_[q]); e[2 * q + 1] = hi16(re_[q]);
                a[2 * q] = lo16(ra_[q]); a[2 * q + 1] = hi16(ra_[q]);
            }
            if (j == 1) {
#pragma unroll
                for (int q = 0; q < 4; ++q) {
                    const float m0_ = lo16(rm_[q]), m1_ = hi16(rm_[q]), f0_ = lo16(rf_[q]), f1_ = hi16(rf_[q]);
                    v[2 * q] += (f0_ - v[2 * q]) * m0_; v[2 * q + 1] += (f1_ - v[2 * q + 1]) * m1_;
                }
            }
            float kkr[8], ss = 0.f;
#pragma unroll
            for (int q = 0; q < 8; ++q) { kkr[q] = k[q] * (q < 4 ? kk0[q] : kk1[q - 4]); ss += kkr[q] * kkr[q]; }
            ss = row8_sum(ss);
            const float rn = rsqrtf(ss + 1e-6f);
            f32x4 o[10];
#pragma unroll
            for (int q = 0; q < 8; ++q) {
                const float kkq = kkr[q] * rn, ka = (q < 4 ? ka0[q] : ka1[q - 4]);
                o[0 + (q >> 2)][q & 3] = __expf(-e[q]);
                o[2 + (q >> 2)][q & 3] = kkq * a[q];
                o[4 + (q >> 2)][q & 3] = k[q] * (1.f + (a[q] - 1.f) * ka);
                o[6 + (q >> 2)][q & 3] = kkq;
                o[8 + (q >> 2)][q & 3] = r[q];
            }
            float* tb = buf + ptok * TOKF;
#pragma unroll
            for (int q = 0; q < 5; ++q) { *(f32x4*)(tb + q * 64 + c8) = o[2 * q]; *(f32x4*)(tb + q * 64 + c8 + 4) = o[2 * q + 1]; }
            if ((c8 >> 5) == half) { *(f32x4*)(tb + 320 + (c8 & 31)) = (f32x4){v[0], v[1], v[2], v[3]}; *(f32x4*)(tb + 320 + (c8 & 31) + 4) = (f32x4){v[4], v[5], v[6], v[7]}; }
        };
        load_raw(0);
        prep_write(bufs);
        lds_barrier();
        for (int ch = 0; ch < nch; ++ch) {
            if (ch + 1 < nch) { load_raw(ch + 1); prep_write(bufs + ((ch + 1) & 1) * 32 * TOKF); }
            lds_barrier();
            const float* yb = ybuf + (ch & 1) * 1024;
            const int nt = (ntok - ch * 32) < 32 ? (ntok - ch * 32) : 32;
            const int tk = pt >> 3, r4 = (pt & 7) * 4;
            if (tk < nt) {
                const size_t m = (size_t)m0 + ch * 32 + tk;
                const f32x4 yv = *(const f32x4*)(yb + tk * 32 + r4);
                u32x2 w; w.x = pack2(yv[0], yv[1]); w.y = pack2(yv[2], yv[3]);
                *(u32x2*)(YRAW + m * D + h * 64 + half * 32 + r4) = w;
            }
        }
    } else {
        const int rw = wid * 8 + (lane >> 3), k8 = (lane & 7) * 8, vrow = half * 32 + rw;
        auto state_ptr = [&](int seq, bool out) -> float* {
            if (seq < 8) return (float*)(out ? p.rS_p : nullptr) + ((((size_t)j * 8 + seq) * 16 + h) * 64 + vrow) * 64 + k8;
            return (float*)(out ? p.rS_s : const_cast<float*>(p.st_rS)) + ((((size_t)j * 128 + (seq - 8)) * 16 + h) * 64 + vrow) * 64 + k8;
        };
        __builtin_amdgcn_s_setprio(3);
        f32x4 S0 = {0.f, 0.f, 0.f, 0.f}, S1 = {0.f, 0.f, 0.f, 0.f}, N0 = S0, N1 = S0;
        const bool carried = (seq0 >= 8);
        if (carried) { const float* sp = state_ptr(seq0, false); N0 = *(const f32x4*)sp; N1 = *(const f32x4*)(sp + 4); }
        lds_barrier();
        int seg = 0, tin = 0;
        for (int ch = 0; ch < nch; ++ch) {
            const float* buf = bufs + (ch & 1) * 32 * TOKF;
            float* yb = ybuf + (ch & 1) * 1024;
            const int nt = (ntok - ch * 32) < 32 ? (ntok - ch * 32) : 32;
            RVec VA, VB, VC, VD;
            rvec_load(VA, buf, k8, rw); rvec_load(VB, buf + TOKF, k8, rw); rvec_load(VC, buf + 2 * TOKF, k8, rw);
            for (int t = 0; t < nt; t += 4) {
                if (tin == 0) {
                    S0 = N0; S1 = N1;
                    if (carried && (seg + 1) * seglen < ntok) { const float* sp = state_ptr(seq0 + seg + 1, false); N0 = *(const f32x4*)sp; N1 = *(const f32x4*)(sp + 4); }
                }
                rvec_load(VD, buf + (t + 3) * TOKF, k8, rw);
                yb[t * 32 + rw] = rvec_step(S0, S1, VA);
                rvec_load(VA, buf + (t + 4) * TOKF, k8, rw);
                yb[(t + 1) * 32 + rw] = rvec_step(S0, S1, VB);
                rvec_load(VB, buf + (t + 5) * TOKF, k8, rw);
                yb[(t + 2) * 32 + rw] = rvec_step(S0, S1, VC);
                rvec_load(VC, buf + (t + 6) * TOKF, k8, rw);
                yb[(t + 3) * 32 + rw] = rvec_step(S0, S1, VD);
                tin += 4;
                if (tin == seglen) {
                    float* so = state_ptr(seq0 + seg, true);
                    *(f32x4*)so = S0; *(f32x4*)(so + 4) = S1;
                    tin = 0; ++seg;
                }
            }
            lds_barrier();
        }
        __builtin_amdgcn_s_setprio(0);
    }
    lds_barrier();
}
__device__ __forceinline__ void rwkv_scan_phase(CParams& p, int j, char* smem) {
    const int G = ogrid(), bid = obid();
    for (int it = bid; it < 256; it += G) rwkv_scan_stream(p, j, (it >> 1) & 15, it & 1, (it >> 5) * LP, LP, LP, it >> 5, smem);
    for (int it = bid; it < 256; it += G) rwkv_scan_stream(p, j, (it >> 1) & 15, it & 1, TP + (it >> 5) * 64, 64, 4, 8 + (it >> 5) * 16, smem);
}
__device__ __forceinline__ void rwkv_post_phase(CParams& p, int j) {
    const int tid = otid();
    const bf16_t* C1 = p.RA;
    const bf16_t* AA = (const bf16_t*)(p.RB + RWB); const bf16_t* GATE = (const bf16_t*)(p.RB + 2 * RWB); const bf16_t* VM = (const bf16_t*)(p.RB + 3 * RWB);
    const bf16_t* YRAW = (const bf16_t*)(p.RB + 4 * RWB);
    bf16_t* YG = p.HN;
    const int c4 = (tid & 15) * 4;
    struct Raw { u32x2 ry, rr, rk, rv, ra, rg, rm, rf; };
    auto load = [&](Raw& R, int base) {
        const int it = base + (tid >> 4), m = it >> 4, h = it & 15, col = h * 64 + c4;
        const size_t mm = (size_t)m;
        R.ry = *(const u32x2*)(YRAW + mm * D + col); R.rr = *(const u32x2*)(C1 + mm * R1_N + col); R.rk = *(const u32x2*)(C1 + mm * R1_N + 1024 + col);
        R.rv = *(const u32x2*)(C1 + mm * R1_N + 2048 + col); R.ra = *(const u32x2*)(AA + mm * D + col); R.rg = *(const u32x2*)(GATE + mm * D + col);
        if (j == 1) { R.rm = *(const u32x2*)(VM + mm * D + col); R.rf = *(const u32x2*)(p.VFIRST + mm * D + col); }
    };
    const int stride = ogrid() * 32;
    int base = obid() * 32;
    Raw cur, nxt;
    if (base < T * 16) load(cur, base);
    for (; base < T * 16; base += stride) {
        if (base + stride < T * 16) load(nxt, base + stride);
        const int it = base + (tid >> 4), m = it >> 4, h = it & 15, col = h * 64 + c4;
        const size_t mm = (size_t)m;
        const u32x2 ry = cur.ry, rr = cur.rr, rk = cur.rk, rv = cur.rv, ra = cur.ra, rg = cur.rg;
        f32x4 y = {lo16(ry.x), hi16(ry.x), lo16(ry.y), hi16(ry.y)};
        f32x4 r = {lo16(rr.x), hi16(rr.x), lo16(rr.y), hi16(rr.y)};
        f32x4 k = {lo16(rk.x), hi16(rk.x), lo16(rk.y), hi16(rk.y)};
        f32x4 v = {lo16(rv.x), hi16(rv.x), lo16(rv.y), hi16(rv.y)};
        f32x4 a = {lo16(ra.x), hi16(ra.x), lo16(ra.y), hi16(ra.y)};
        f32x4 g = {lo16(rg.x), hi16(rg.x), lo16(rg.y), hi16(rg.y)};
        if (j == 1) {
            const u32x2 rm = cur.rm, rf = cur.rf;
            f32x4 vm = {lo16(rm.x), hi16(rm.x), lo16(rm.y), hi16(rm.y)};
            f32x4 vf = {lo16(rf.x), hi16(rf.x), lo16(rf.y), hi16(rf.y)};
            v = v + (vf - v) * vm;
        }
        const f32x4 kav = *(const f32x4*)(p.rwkv_k_a + (size_t)j * D + col), rkv = *(const f32x4*)(p.rwkv_r_k + (size_t)j * D + col);
        const f32x4 lw = *(const f32x4*)(p.rwkv_ln_w + (size_t)j * D + col), lb = *(const f32x4*)(p.rwkv_ln_b + (size_t)j * D + col);
        const f32x4 kf = k * (1.f + (a - 1.f) * kav);
        const float mu = row16_sum(y[0] + y[1] + y[2] + y[3]) * (1.f / 64.f);
        const f32x4 yc = y - mu;
        const float var = row16_sum(yc[0] * yc[0] + yc[1] * yc[1] + yc[2] * yc[2] + yc[3] * yc[3]) * (1.f / 64.f);
        const f32x4 t3 = r * kf * rkv;
        const float bon = row16_sum(t3[0] + t3[1] + t3[2] + t3[3]);
        const f32x4 o = (yc * rsqrtf(var + 64e-5f) * lw + lb + v * bon) * g;
        u32x2 w; w.x = pack2(o[0], o[1]); w.y = pack2(o[2], o[3]);
        *(u32x2*)(YG + mm * D + col) = w;
        cur = nxt;
    }
}

__global__ void __launch_bounds__(NTH) mega_kernel(Params p_arg, int ph_begin, int ph_end) {
    extern __shared__ __attribute__((aligned(16))) char smem[];
#if !MULTI_LAUNCH
    cg::grid_group grid = cg::this_grid();
    volatile LAS unsigned* xst = (volatile LAS unsigned*)(smem + 131072);
    if (threadIdx.x == 0) { xst[0] = 0u; xst[1] = 0u; }
    __syncthreads();
    XcdBarrier xb = xcd_barrier_post(p_arg.bar, xst);
#endif
    for (int ph = ph_begin; ph < ph_end; ++ph) {
        CParams* pp = (CParams*)__builtin_amdgcn_kernarg_segment_ptr();
        asm volatile("" : "+s"(pp));
        CParams& p = *pp;
        int type, layer; phase_info(ph, type, layer);
        const int j = layer >> 1;
#ifndef DUP
#define DUP -1
#endif
        for (int rep = 0; rep < ((type == DUP) ? 2 : 1); ++rep) {
#if !MULTI_LAUNCH
        if (rep) xcd_barrier(xb);
#endif
        switch (type) {
#ifndef ONLY
#define ONLY -1
#endif
#define EN(t) (ONLY < 0 || ONLY == (t))
            case PH_PREP: if (EN(PH_PREP)) { prep_phase(p, smem, 0, p.pad0, obid(), ogrid()); norm_phase(p, 0, 0); } break;
            case PH_NORM_MIX: if (EN(PH_NORM_MIX)) { if (layer & 1) rwkv_norm_phase(p, layer); else norm_phase(p, layer, 0); } break;
            case PH_NORM_FFN: if (EN(PH_NORM_FFN)) { norm_phase(p, layer, 1); } break;
            case PH_FINAL: if (EN(PH_FINAL)) { norm_phase(p, 0, 2); } break;
            case PH_GDN_IN: if (EN(PH_GDN_IN)) { gdn_in_phase(p, j, smem); } break;
            case PH_GDN_PREP: if (EN(PH_GDN_PREP)) { gdn_prep_phase(p, j, smem); } break;
            case PH_GDN_SCAN: if (EN(PH_GDN_SCAN)) { gdn_scan_phase(p, j, smem); } break;
            case PH_GDN_OUT: if (EN(PH_GDN_OUT)) { res_gemm_phase(p, p.HN, D, p.w_out_t + (size_t)j * D * D, smem, rep); } break;
            case PH_FFN_UP: if (EN(PH_FFN_UP)) { ffn_up_phase(p, layer, smem); } break;
            case PH_FFN_DOWN: if (EN(PH_FFN_DOWN)) { res_gemm_phase(p, p.RA + H_OFF, DFF, p.down_t + (size_t)layer * D * DFF, smem, rep); } break;
            case PH_FFN_ACT: if (EN(PH_FFN_ACT)) { ffn_act_phase(p, layer); } break;
            case PH_RWKV_IN: if (EN(PH_RWKV_IN)) { rwkv_in_phase(p, j, smem); } break;
            case PH_RWKV_LORA: if (EN(PH_RWKV_LORA)) { rwkv_lora_phase(p, j, smem); } break;
            case PH_RWKV_SCAN: if (EN(PH_RWKV_SCAN)) { rwkv_scan_phase(p, j, smem); } break;
            case PH_RWKV_POST: if (EN(PH_RWKV_POST)) { rwkv_post_phase(p, j); } break;
            case PH_RWKV_OUT: if (EN(PH_RWKV_OUT)) { res_gemm_phase(p, p.HN, D, p.wo_t + (size_t)j * D * D, smem, rep); } break;
            default: break;
        }
        }
#if !MULTI_LAUNCH
        if (ph + 1 < ph_end) { if (ph == ph_begin) grid.sync(); else xcd_barrier(xb); }
#endif
    }
}

extern "C" void kernel_launch(void* const* d_in, const int* in_sizes, int n_in, void* d_out, int out_size, void* d_ws, size_t ws_size, hipStream_t stream) {
    static int grid = 0;
    if (grid == 0) {
        int dev = 0, cus = 0, per_cu = 0;
        hipGetDevice(&dev);
        hipDeviceGetAttribute(&cus, hipDeviceAttributeMultiprocessorCount, dev);
        hipFuncSetAttribute((const void*)mega_kernel, hipFuncAttributeMaxDynamicSharedMemorySize, SMEM_BYTES);
        hipOccupancyMaxActiveBlocksPerMultiprocessor(&per_cu, (const void*)mega_kernel, NTH, SMEM_BYTES);
        (void)hipGetLastError();
        if (per_cu < 1) { fprintf(stderr, "kernel_launch: occupancy query reports %d blocks per CU\n", per_cu); per_cu = 1; }
        grid = cus;
    }
    Params p; memset(&p, 0, sizeof(p));
    auto in = [&](int i) { return (const float*)d_in[i]; };
    p.x_prompt = in(0); p.x_sample = in(1); p.st_gS = in(2); p.st_gC = in(3); p.st_rS = in(4); p.st_rSh = in(5); p.st_fC = in(6); p.meta = in(7);
    p.norm_mix = in(8); p.norm_ffn = in(9); p.norm_final = in(10);
    p.gdn_conv_w = in(12); p.gdn_A_log = in(13); p.gdn_dt_bias = in(14); p.gdn_norm_w = in(15);
    p.rwkv_mix = in(17); p.rwkv_w0 = in(22); p.rwkv_a0 = in(25); p.rwkv_k_k = in(30); p.rwkv_k_a = in(31); p.rwkv_r_k = in(32); p.rwkv_ln_w = in(33); p.rwkv_ln_b = in(34); p.rwkv_v0 = in(35);
    p.ffn_conv_w = in(39);
    float* o = (float*)d_out; size_t off = 0;
    p.y_prompt = o + off; off += (size_t)8 * 2048 * 1024;
    p.y_sample = o + off; off += (size_t)128 * 4 * 1024;
    p.gS_p = o + off; off += (size_t)2 * 8 * 8 * 128 * 128;
    p.gC_p = o + off; off += (size_t)2 * 8 * 3 * 3072;
    p.rS_p = o + off; off += (size_t)2 * 8 * 16 * 64 * 64;
    p.rSh_p = o + off; off += (size_t)2 * 8 * 1024;
    p.fC_p = o + off; off += (size_t)4 * 8 * 2 * DFF;
    p.gS_s = o + off; off += (size_t)2 * 128 * 8 * 128 * 128;
    p.gC_s = o + off; off += (size_t)2 * 128 * 3 * 3072;
    p.rS_s = o + off; off += (size_t)2 * 128 * 16 * 64 * 64;
    p.rSh_s = o + off; off += (size_t)2 * 128 * 1024;
    p.fC_s = o + off; off += (size_t)4 * 128 * 2 * DFF;
    char* ws = (char*)d_ws; size_t w = 0;
    auto carve = [&](size_t bytes) { char* r = ws + w; w += (bytes + 255) & ~(size_t)255; return r; };
    p.bar = (unsigned*)carve(XCD_BAR_WORDS * 4);
    p.w_in_t = (bf16_t*)carve((size_t)2 * GIN_NP * D * 2);
    p.w_out_t = (bf16_t*)carve((size_t)2 * D * D * 2);
    p.rwkv1_t = (bf16_t*)carve((size_t)2 * 3072 * D * 2);
    p.w2t = (bf16_t*)carve((size_t)2 * D * 64 * 2);
    p.a2t = (bf16_t*)carve((size_t)2 * D * 64 * 2);
    p.g2t = (bf16_t*)carve((size_t)2 * D * 192 * 2);
    p.v2t = (bf16_t*)carve((size_t)D * 64 * 2);
    p.wo_t = (bf16_t*)carve((size_t)2 * D * D * 2);
    p.up_t = (bf16_t*)carve((size_t)4 * 2 * DFF * D * 2);
    p.down_t = (bf16_t*)carve((size_t)4 * D * DFF * 2);
    p.X = (float*)carve((size_t)MPAD * D * 4);
    p.HN = (bf16_t*)carve((size_t)MPAD * D * 2);
    p.RA = (bf16_t*)carve((size_t)MPAD * GIN_LD * 2);
    p.RB = carve((size_t)5 * MPAD * D * 2);
    if (w > ws_size) { fprintf(stderr, "kernel_launch: workspace too small: need %zu, have %zu\n", w, ws_size); return; }
    char* sc = (char*)p.y_prompt; size_t so = 0;
    auto scarve = [&](size_t bytes) { char* r = sc + so; so += (bytes + 255) & ~(size_t)255; return r; };
    p.VFIRST = (bf16_t*)scarve((size_t)MPAD * D * 2);
    p.AB = (float*)scarve((size_t)MPAD * 16 * 4);
    p.SHIFT = (bf16_t*)scarve((size_t)NSEQ * D * 2);
    p.GL = (float*)scarve((size_t)64 * NCHUNK * 4);
    p.l1t = (bf16_t*)scarve((size_t)2 * 768 * 2048 * 2);
    int nj = 0;
    auto jobx = [&](const float* src, bf16_t* dst, int K, int N, int Kd, int Nd, int ld, const float* scale, int smode) {
        TJob& t = p.jobs[nj++]; t.src = src; t.dst = dst; t.scale = scale; t.K = K; t.N = N; t.Kd = Kd; t.Nd = Nd; t.ld = ld; t.smode = smode; };
    auto job = [&](const float* src, bf16_t* dst, int K, int N, int Kd, int Nd) { jobx(src, dst, K, N, Kd, Nd, Kd, nullptr, 0); };
    auto gdn_jobs = [&](int j) {
        job(in(11) + (size_t)j * D * 4112, p.w_in_t + (size_t)j * GIN_NP * D, D, 4112, D, GIN_NP);
        job(in(16) + (size_t)j * D * D, p.w_out_t + (size_t)j * D * D, D, D, D, D);
    };
    auto ffn_jobs = [&](int i) {
        job(in(38) + (size_t)i * D * 2 * DFF, p.up_t + (size_t)i * 2 * DFF * D, D, 2 * DFF, D, 2 * DFF);
        job(in(40) + (size_t)i * DFF * D, p.down_t + (size_t)i * D * DFF, DFF, D, DFF, D);
    };
    auto rwkv_jobs = [&](int j) {
        bf16_t* r1 = p.rwkv1_t + (size_t)j * 3072 * D;
        job(in(18) + (size_t)j * D * D, r1, D, D, D, D);
        job(in(19) + (size_t)j * D * D, r1 + (size_t)1024 * D, D, D, D, D);
        job(in(20) + (size_t)j * D * D, r1 + (size_t)2048 * D, D, D, D, D);
        bf16_t* l1 = p.l1t + (size_t)j * 768 * 2048;
        const float* mixb = in(17) + (size_t)j * 6 * D;
        auto lora = [&](const float* src, int N, int Nd, int row0, int ms) {
            jobx(src, l1 + (size_t)row0 * 2048, D, N, D, Nd, 2048, mixb + (size_t)ms * D, 1);
            jobx(src, l1 + (size_t)row0 * 2048 + 1024, D, N, D, Nd, 2048, mixb + (size_t)ms * D, 2);
        };
        lora(in(23) + (size_t)j * D * 64, 64, 128, 0, 1);
        lora(in(26) + (size_t)j * D * 64, 64, 128, 128, 4);
        lora(in(28) + (size_t)j * D * 160, 160, 256, 256, 5);
        lora(in(36), j == 1 ? 32 : 0, 128, 512, 3);
        lora(in(36), 0, 128, 640, 3);
        job(in(24) + (size_t)j * 64 * D, p.w2t + (size_t)j * D * 64, 64, D, 64, D);
        job(in(27) + (size_t)j * 64 * D, p.a2t + (size_t)j * D * 64, 64, D, 64, D);
        job(in(29) + (size_t)j * 160 * D, p.g2t + (size_t)j * D * 192, 160, D, 192, D);
        job(in(21) + (size_t)j * D * D, p.wo_t + (size_t)j * D * D, D, D, D, D);
    };
    gdn_jobs(0); ffn_jobs(0);
    p.pad0 = nj;
    rwkv_jobs(0); ffn_jobs(1); gdn_jobs(1);
    p.pad1 = nj;
    ffn_jobs(2); rwkv_jobs(1); job(in(37), p.v2t, 32, D, 64, D); ffn_jobs(3);
    p.njobs = nj;
#if MULTI_LAUNCH
    for (int ph = 0; ph < NPHASES; ++ph) hipLaunchKernelGGL(mega_kernel, dim3(grid), dim3(NTH), SMEM_BYTES, stream, p, ph, ph + 1);
#else
    hipMemsetAsync(p.bar, 0, XCD_BAR_WORDS * 4, stream);
    int b0 = 0, b1 = NPHASES;
    void* args[] = { &p, &b0, &b1 };
    hipError_t e = hipLaunchCooperativeKernel((const void*)mega_kernel, dim3(grid), dim3(NTH), args, SMEM_BYTES, stream);
    if (e != hipSuccess) fprintf(stderr, "cooperative launch failed: %s (grid %d)\n", hipGetErrorString(e), grid);
#endif
}
```

```cpp
#include <hip/hip_runtime.h>
#include <hip/hip_cooperative_groups.h>
#include <cstdio>
#include <cstring>
#include <cstdint>
namespace cg = cooperative_groups;

#ifndef MULTI_LAUNCH
#define MULTI_LAUNCH 0
#endif

typedef unsigned short bf16_t;
typedef short bf16x8 __attribute__((ext_vector_type(8)));
typedef float f32x4 __attribute__((ext_vector_type(4)));
typedef float f32x2 __attribute__((ext_vector_type(2)));
typedef unsigned u32x4 __attribute__((ext_vector_type(4)));
typedef unsigned u32x2 __attribute__((ext_vector_type(2)));

constexpr int D = 1024;
constexpr int LP = 2064;
constexpr int TP = 8 * LP;
constexpr int TS = 512;
constexpr int T = TP + TS;
constexpr int MPAD = 17152;
constexpr int NSEQ = 136;
constexpr int DFF = 2816;
constexpr int NTH = 512;
constexpr int GIN_LD = 4096;
constexpr int GIN_NP = 4352;
constexpr int R1_N = 3840;
constexpr int NCHUNK = 33;
constexpr int CH_BYTES = 73728;
constexpr int SMEM_BYTES = 131072 + 1024 + 4096;

enum { PH_PREP = 0, PH_NORM_MIX, PH_GDN_IN, PH_GDN_PREP, PH_GDN_SCAN, PH_GDN_OUT, PH_NORM_FFN, PH_FFN_UP, PH_FFN_DOWN,
       PH_RWKV_IN, PH_RWKV_LORA, PH_RWKV_SCAN, PH_RWKV_POST, PH_RWKV_OUT, PH_FINAL, PH_FFN_ACT };
constexpr int NPHASES = 35;

struct TJob { const float* src; bf16_t* dst; const float* scale; int K, N, Kd, Nd, ld, smode; };
constexpr int MAXJOBS = 56;

struct Params {
    const float *x_prompt, *x_sample, *st_gS, *st_gC, *st_rS, *st_rSh, *st_fC, *meta;
    const float *norm_mix, *norm_ffn, *norm_final;
    const float *gdn_conv_w, *gdn_A_log, *gdn_dt_bias, *gdn_norm_w;
    const float *rwkv_mix, *rwkv_w0, *rwkv_a0, *rwkv_k_k, *rwkv_k_a, *rwkv_r_k, *rwkv_ln_w, *rwkv_ln_b, *rwkv_v0;
    const float *ffn_conv_w;
    float *y_prompt, *y_sample, *gS_p, *gC_p, *rS_p, *rSh_p, *fC_p, *gS_s, *gC_s, *rS_s, *rSh_s, *fC_s;
    bf16_t *w_in_t, *w_out_t, *rwkv1_t, *l1t, *w2t, *a2t, *g2t, *v2t, *wo_t, *up_t, *down_t;
    bf16_t* X; bf16_t* HN; bf16_t* SHIFT; bf16_t* RA; char* RB; float* AB; bf16_t* VFIRST; float* GL; float* BON;
    unsigned* bar;
    int njobs; int pad0; int pad1; int pad2;
    TJob jobs[MAXJOBS];
};

typedef const __attribute__((address_space(4))) Params CParams;

__device__ __forceinline__ void lds_barrier() { asm volatile("s_waitcnt lgkmcnt(0)" ::: "memory"); __builtin_amdgcn_s_barrier(); asm volatile("" ::: "memory"); }
__device__ __forceinline__ int otid() { int t = threadIdx.x; asm volatile("" : "+v"(t)); return t; }
__device__ __forceinline__ int obid() { int t = blockIdx.x; asm volatile("" : "+s"(t)); return t; }
__device__ __forceinline__ int ogrid() { int t = gridDim.x; asm volatile("" : "+s"(t)); return t; }
__device__ __forceinline__ float bf2f(unsigned h) { return __uint_as_float(h << 16); }
typedef __bf16 bf16x2_t __attribute__((ext_vector_type(2)));
__device__ __forceinline__ unsigned pack2(float lo, float hi) { const f32x2 v = {lo, hi}; return __builtin_bit_cast(unsigned, __builtin_convertvector(v, bf16x2_t)); }
__device__ __forceinline__ unsigned f2bf(float f) { return pack2(f, 0.f) & 0xffffu; }
__device__ __forceinline__ float lo16(unsigned u) { return __uint_as_float(u << 16); }
__device__ __forceinline__ float hi16(unsigned u) { return __uint_as_float(u & 0xffff0000u); }
__device__ __forceinline__ float sigmoidf_(float x) { return __builtin_amdgcn_rcpf(1.f + __expf(-x)); }
__device__ __forceinline__ float siluf_(float x) { return x * __builtin_amdgcn_rcpf(1.f + __expf(-x)); }
__device__ __forceinline__ float tanhf_(float x) { return 2.f * __builtin_amdgcn_rcpf(1.f + __expf(-2.f * x)) - 1.f; }
__device__ __forceinline__ float softplusf_(float x) { return fmaxf(x, 0.f) + __logf(1.f + __expf(-fabsf(x))); }
__device__ __forceinline__ float wave_sum(float v) {
#pragma unroll
    for (int o = 1; o < 64; o <<= 1) v += __shfl_xor(v, o);
    return v;
}
template <int CTRL> __device__ __forceinline__ float dpp_add(float x) {
    int v = __builtin_amdgcn_update_dpp(0, __float_as_int(x), CTRL, 0xf, 0xf, true);
    return x + __int_as_float(v);
}
__device__ __forceinline__ float row16_sum(float x) {
    x = dpp_add<0xB1>(x);
    x = dpp_add<0x4E>(x);
    x = dpp_add<0x141>(x);
    x = dpp_add<0x140>(x);
    return x;
}
__device__ __forceinline__ void tokdec(int m, int& seq, int& t, int& L) {
    if (m < TP) { seq = m / LP; t = m - seq * LP; L = LP; }
    else { int s = m - TP; seq = 8 + (s >> 2); t = s & 3; L = 4; }
}
__device__ __forceinline__ int gdn_ph(int q) { return q == 0 ? PH_NORM_MIX : q == 1 ? PH_GDN_IN : q == 2 ? PH_GDN_PREP : q == 3 ? PH_GDN_SCAN : q == 4 ? PH_GDN_OUT : q == 5 ? PH_NORM_FFN : q == 6 ? PH_FFN_UP : PH_FFN_DOWN; }
__device__ __forceinline__ int rwkv_ph(int q) { return q == 0 ? PH_NORM_MIX : q == 1 ? PH_RWKV_IN : q == 2 ? PH_RWKV_LORA : q == 3 ? PH_RWKV_SCAN : q == 4 ? PH_RWKV_POST : q == 5 ? PH_RWKV_OUT : q == 6 ? PH_NORM_FFN : q == 7 ? PH_FFN_UP : PH_FFN_DOWN; }
__device__ __forceinline__ void phase_info(int ph, int& type, int& layer) {
    if (ph == 0) { type = PH_PREP; layer = 0; return; }
    if (ph == NPHASES - 1) { type = PH_FINAL; layer = 0; return; }
    int q = ph - 1;
    if (q < 7) { layer = 0; type = gdn_ph(q + 1); return; } q -= 7;
    if (q < 9) { layer = 1; type = rwkv_ph(q); return; } q -= 9;
    if (q < 8) { layer = 2; type = gdn_ph(q); return; } q -= 8;
    layer = 3; type = rwkv_ph(q);
}

#define XB_TMO      128
#define XB_XCNT(j)  (256  + 64 * (j))
#define XB_XSUB(j)  (1280 + 64 * (j))
#define XB_XGEN(j)  (2304 + 64 * (j))
#define XB_TOP      3328
#define XB_TOPGEN   3392
#define XCD_BAR_WORDS 3456
#define XB_SPIN_CAP (1u << 22)
#define LAS __attribute__((address_space(3)))
__device__ __forceinline__ unsigned xb_ld(unsigned* p)              { return __hip_atomic_load(p, __ATOMIC_RELAXED, __HIP_MEMORY_SCOPE_AGENT); }
__device__ __forceinline__ unsigned xb_add(unsigned* p, unsigned v) { return __hip_atomic_fetch_add(p, v, __ATOMIC_RELAXED, __HIP_MEMORY_SCOPE_AGENT); }
__device__ __forceinline__ unsigned xb_xcc_id() { return (unsigned)__builtin_amdgcn_s_getreg((3 << 11) | 20) & 0xFu; }
#define XB_SPIN(cond, bar) do { unsigned _sp = 0; while (cond) { __builtin_amdgcn_s_sleep(1); \
    if ((++_sp & 255u) == 0u) { if (xb_ld(&(bar)[XB_TMO])) break; if (_sp > XB_SPIN_CAP) { atomicAdd(&(bar)[XB_TMO], 1u); break; } } } } while (0)
struct XcdBarrier { unsigned* bar; unsigned x; volatile LAS unsigned* st; };
__device__ __forceinline__ XcdBarrier xcd_barrier_post(unsigned* bar, volatile LAS unsigned* st) {
    XcdBarrier b; b.bar = bar; b.x = xb_xcc_id(); b.st = st;
    if (threadIdx.x == 0) (void)xb_add(&bar[XB_XCNT(b.x)], 1u);
    return b;
}
__device__ __forceinline__ void xcd_barrier_complete(unsigned* bar, unsigned x, unsigned& nloc, unsigned& nx) {
    const unsigned G = gridDim.x * gridDim.y * gridDim.z;
    unsigned sum, cnt, mine, sp = 0u;
    for (;;) {
        sum = 0u; cnt = 0u; mine = 0u;
#pragma unroll
        for (unsigned j = 0; j < 16; ++j) { const unsigned c = xb_ld(&bar[XB_XCNT(j)]); sum += c; cnt += (c > 0u) ? 1u : 0u; mine = (j == x) ? c : mine; }
        if (sum == G) break;
        __builtin_amdgcn_s_sleep(1);
        if ((++sp & 255u) == 0u) { if (xb_ld(&bar[XB_TMO])) break; if (sp > XB_SPIN_CAP) { atomicAdd(&bar[XB_TMO], 1u); break; } }
    }
    nloc = mine > 0u ? mine : 1u; nx = cnt > 0u ? cnt : 1u;
}
__device__ __forceinline__ void xcd_barrier(const XcdBarrier& b) {
    asm volatile("s_waitcnt vmcnt(0)" ::: "memory");
    __syncthreads();
    if (threadIdx.x == 0) {
        unsigned* bar = b.bar;
        __builtin_amdgcn_s_waitcnt(0);
        unsigned nloc = b.st[0], nx = b.st[1];
        if (nloc == 0u) { xcd_barrier_complete(bar, b.x, nloc, nx); b.st[0] = nloc; b.st[1] = nx; }
        const unsigned old = xb_add(&bar[XB_XSUB(b.x)], 1u);
        const unsigned gen = old / nloc;
        if (old + 1u == (gen + 1u) * nloc) {
            __builtin_amdgcn_fence(__ATOMIC_RELEASE, "agent");
            asm volatile("s_waitcnt vmcnt(0)" ::: "memory");
            const unsigned og = xb_add(&bar[XB_TOP], 1u);
            const unsigned tg = og / nx;
            if (og + 1u == (tg + 1u) * nx) xb_add(&bar[XB_TOPGEN], 1u);
            else XB_SPIN(xb_ld(&bar[XB_TOPGEN]) == tg, bar);
            __builtin_amdgcn_fence(__ATOMIC_ACQUIRE, "agent");
            asm volatile("s_waitcnt vmcnt(0)" ::: "memory");
        } else {
            XB_SPIN(xb_ld(&bar[XB_TOPGEN]) == gen, bar);
            __builtin_amdgcn_fence(__ATOMIC_ACQUIRE, "agent");
            asm volatile("s_waitcnt vmcnt(0)" ::: "memory");
        }
    }
    __syncthreads();
}

__device__ __forceinline__ void prep_phase(CParams& p, char* smem, int j0, int j1, int widx, int nworkers) {
    const int tid = otid(), lane = tid & 63, wave = tid >> 6;
    float* scr = (float*)(smem + wave * 8704);
    const int gw = widx * 8 + wave, NGW = nworkers * 8;
    int total = 0;
    for (int j = j0; j < j1; ++j) total += (p.jobs[j].Kd >> 6) * (p.jobs[j].Nd >> 5);
    for (int it = gw; it < total; it += NGW) {
        int r = it, j = j0;
        for (;; ++j) { const int c = (p.jobs[j].Kd >> 6) * (p.jobs[j].Nd >> 5); if (r < c) break; r -= c; }
        TJob jb; jb.src = p.jobs[j].src; jb.dst = p.jobs[j].dst; jb.scale = p.jobs[j].scale; jb.K = p.jobs[j].K; jb.N = p.jobs[j].N; jb.Kd = p.jobs[j].Kd; jb.Nd = p.jobs[j].Nd; jb.ld = p.jobs[j].ld; jb.smode = p.jobs[j].smode;
        const int nblk = jb.Nd >> 5, kb = r / nblk, nb = r - kb * nblk, k0 = kb * 64, n0 = nb * 32;
        {
            const int n4 = (lane & 7) * 4, kr = lane >> 3;
            f32x4 v[8];
            const bool vec_ok = ((jb.N & 3) == 0) && (n0 + n4 + 3 < jb.N);
#pragma unroll
            for (int i = 0; i < 8; ++i) {
                const int kk = i * 8 + kr;
                v[i] = (f32x4){0.f, 0.f, 0.f, 0.f};
                if (k0 + kk < jb.K) {
                    const float* sp = jb.src + (size_t)(k0 + kk) * jb.N + n0 + n4;
                    if (vec_ok) v[i] = *(const f32x4*)sp;
                    else {
#pragma unroll
                        for (int e = 0; e < 4; ++e) if (n0 + n4 + e < jb.N) v[i][e] = sp[e];
                    }
                    if (jb.smode & 3) { const float sc = jb.scale[k0 + kk]; v[i] = v[i] * ((jb.smode & 3) == 1 ? 1.f - sc : sc); }
                }
            }
#pragma unroll
            for (int i = 0; i < 8; ++i) {
                const int kk = i * 8 + kr;
#pragma unroll
                for (int e = 0; e < 4; ++e) scr[kk * 33 + n4 + e] = v[i][e];
            }
        }
        __builtin_amdgcn_s_waitcnt(0xc07f);
        asm volatile("" ::: "memory");
        const int c = lane & 7;
#pragma unroll
        for (int jj = 0; jj < 4; ++jj) {
            const int nn = (lane >> 3) + 8 * jj;
            const float* s = scr + (8 * c) * 33 + nn;
            u32x4 o;
            o.x = pack2(s[0], s[33]); o.y = pack2(s[66], s[99]); o.z = pack2(s[132], s[165]); o.w = pack2(s[198], s[231]);
            const int nd = (jb.smode & 16) ? 16 * ((nn >> 2) & 1) + 4 * (nn >> 3) + (nn & 3) : nn;
            *(u32x4*)(jb.dst + (size_t)(n0 + nd) * jb.ld + k0 + 8 * c) = o;
        }
        __builtin_amdgcn_s_waitcnt(0xc07f);
        asm volatile("" ::: "memory");
    }
}

__device__ __forceinline__ const float* xsrc_row(CParams& p, int m) {
    int seq, t, L; tokdec(m, seq, t, L);
    if (m < TP) return t < 16 ? p.meta + (size_t)t * D : p.x_prompt + ((size_t)seq * 2048 + (t - 16)) * D;
    return p.x_sample + (size_t)(m - TP) * D;
}
__device__ __forceinline__ void norm_phase(CParams& p, int layer, int mode) {
    const int tid = otid(), lane = tid & 63, wave = tid >> 6;
    const int gw = obid() * 8 + wave, NGW = ogrid() * 8;
    const float* g = mode == 0 ? p.norm_mix + layer * D : (mode == 1 ? p.norm_ffn + layer * D : p.norm_final);
    const bool first = (mode == 0 && layer == 0);
    const bool rw = (mode == 0 && (layer & 1));
    const int j = layer >> 1;
    f32x4 gv[4];
#pragma unroll
    for (int q = 0; q < 4; ++q) gv[q] = *(const f32x4*)(g + q * 256 + lane * 4);
    const int nrows = (mode == 2) ? T : MPAD + (rw ? NSEQ : 0);
    f32x4 nv[4];
    auto ldrow = [&](int mm) {
        if (first) { const float* s0 = xsrc_row(p, mm);
#pragma unroll
            for (int q = 0; q < 4; ++q) nv[q] = *(const f32x4*)(s0 + q * 256 + lane * 4); }
        else { const bf16_t* s0 = p.X + (size_t)mm * D;
#pragma unroll
            for (int q = 0; q < 4; ++q) { const u32x2 r = *(const u32x2*)(s0 + q * 256 + lane * 4); nv[q] = (f32x4){lo16(r.x), hi16(r.x), lo16(r.y), hi16(r.y)}; } }
    };
    if (gw < T) ldrow(gw);
    for (int m = gw; m < nrows; m += NGW) {
        if (m >= MPAD) {
            const int seq = m - MPAD;
            bf16_t* o = p.SHIFT + (size_t)seq * D;
#pragma unroll
            for (int q = 0; q < 4; ++q) {
                f32x4 v = {0.f, 0.f, 0.f, 0.f};
                if (seq >= 8) v = *(const f32x4*)(p.st_rSh + ((size_t)j * 128 + (seq - 8)) * D + q * 256 + lane * 4);
                u32x2 w; w.x = pack2(v.x, v.y); w.y = pack2(v.z, v.w);
                *(u32x2*)(o + q * 256 + lane * 4) = w;
            }
            continue;
        }
        if (m >= T) {
            u32x2 z; z.x = 0; z.y = 0;
#pragma unroll
            for (int q = 0; q < 4; ++q) *(u32x2*)(p.HN + (size_t)m * D + q * 256 + lane * 4) = z;
            if (first) {
#pragma unroll
                for (int q = 0; q < 4; ++q) *(u32x2*)(p.X + (size_t)m * D + q * 256 + lane * 4) = z; }
            continue;
        }
        f32x4 v[4]; float ss = 0.f;
#pragma unroll
        for (int q = 0; q < 4; ++q) { v[q] = nv[q]; ss += v[q].x * v[q].x + v[q].y * v[q].y + v[q].z * v[q].z + v[q].w * v[q].w; }
        if (m + NGW < T) ldrow(m + NGW);
        ss = wave_sum(ss);
        const float rstd = rsqrtf(ss * (1.f / D) + 1e-6f);
        if (first) {
#pragma unroll
            for (int q = 0; q < 4; ++q) { u32x2 w; w.x = pack2(v[q].x, v[q].y); w.y = pack2(v[q].z, v[q].w); *(u32x2*)(p.X + (size_t)m * D + q * 256 + lane * 4) = w; }
        }
        int seq, t, L; tokdec(m, seq, t, L);
#pragma unroll
        for (int q = 0; q < 4; ++q) v[q] = v[q] * rstd * gv[q];
        if (mode == 2) {
            float* o = nullptr;
            if (m < TP) { if (t >= 16) o = p.y_prompt + ((size_t)seq * 2048 + (t - 16)) * D; }
            else o = p.y_sample + (size_t)(m - TP) * D;
            if (o) {
#pragma unroll
                for (int q = 0; q < 4; ++q) *(f32x4*)(o + q * 256 + lane * 4) = v[q];
            }
            continue;
        }
#pragma unroll
        for (int q = 0; q < 4; ++q) { u32x2 w; w.x = pack2(v[q].x, v[q].y); w.y = pack2(v[q].z, v[q].w); *(u32x2*)(p.HN + (size_t)m * D + q * 256 + lane * 4) = w; }
        if (rw && t == L - 1) {
            float* o = (seq < 8) ? p.rSh_p + ((size_t)j * 8 + seq) * D : p.rSh_s + ((size_t)j * 128 + (seq - 8)) * D;
#pragma unroll
            for (int q = 0; q < 4; ++q) *(f32x4*)(o + q * 256 + lane * 4) = v[q];
        }
    }
}

constexpr int A_STAGE = 32768, B_STAGE = 16384;
__device__ __forceinline__ int lds_off(int r, int c) {
    const int st = (r >> 4) * 2 + (c >> 5), rr = r & 15, cc = c & 31, ob = rr * 64 + cc * 2;
    return st * 1024 + (ob ^ (((ob >> 9) & 1) << 5));
}
struct ALoadPlain {
    const bf16_t* p[4]; u32x4 r[4]; int lo[4];
    __device__ __forceinline__ void init(int tid, const bf16_t* A, int lda, int m0, int mmax) {
        const int row = tid >> 3, kc = tid & 7;
#pragma unroll
        for (int i = 0; i < 4; ++i) { int m = m0 + row + 64 * i; m = m < 0 ? 0 : (m > mmax ? mmax : m); p[i] = A + (size_t)m * lda + kc * 8; lo[i] = lds_off(row + 64 * i, kc * 8); }
    }
    __device__ __forceinline__ void issue(int kt) {
#pragma unroll
        for (int i = 0; i < 4; ++i) r[i] = *(const u32x4*)(p[i] + kt * 64);
    }
    __device__ __forceinline__ void commit(char* As) {
#pragma unroll
        for (int i = 0; i < 4; ++i) *(u32x4*)(As + lo[i]) = r[i];
    }
};
struct ALoadMix {
    const bf16_t* ph[4]; const bf16_t* pp[4]; const float* pm; u32x4 rh[4], rp[4]; f32x4 m0, m1; int lo[4];
    __device__ __forceinline__ void init(int tid, CParams& p, const float* mixv, int mbase) {
        const int row = tid >> 3, kc = tid & 7;
#pragma unroll
        for (int i = 0; i < 4; ++i) {
            int m = mbase + row + 64 * i; if (m > MPAD - 1) m = MPAD - 1;
            ph[i] = p.HN + (size_t)m * D + kc * 8; lo[i] = lds_off(row + 64 * i, kc * 8);
            if (m < T) { int seq, t, L; tokdec(m, seq, t, L); pp[i] = (t == 0) ? p.SHIFT + (size_t)seq * D + kc * 8 : ph[i] - D; }
            else pp[i] = ph[i];
        }
        pm = mixv + kc * 8;
    }
    __device__ __forceinline__ void issue(int kt) {
#pragma unroll
        for (int i = 0; i < 4; ++i) { rh[i] = *(const u32x4*)(ph[i] + kt * 64); rp[i] = *(const u32x4*)(pp[i] + kt * 64); }
        m0 = *(const f32x4*)(pm + kt * 64); m1 = *(const f32x4*)(pm + kt * 64 + 4);
    }
    __device__ __forceinline__ void commit(char* As) {
#pragma unroll
        for (int i = 0; i < 4; ++i) {
            u32x4 o;
#pragma unroll
            for (int q = 0; q < 4; ++q) {
                const unsigned hh = rh[i][q], pv = rp[i][q];
                const float h0 = lo16(hh), h1 = hi16(hh), p0 = lo16(pv), p1 = hi16(pv);
                const float ma = q < 2 ? m0[2 * q] : m1[2 * q - 4], mb = q < 2 ? m0[2 * q + 1] : m1[2 * q - 3];
                o[q] = pack2(h0 + (p0 - h0) * ma, h1 + (p1 - h1) * mb);
            }
            *(u32x4*)(As + lo[i]) = o;
        }
    }
};
struct BLoad {
    const bf16_t* p[2]; u32x4 r[2]; int lo[2];
    __device__ __forceinline__ void init(int tid, const bf16_t* B0, const bf16_t* B1, int ldb) {
        const int row = tid >> 3, kc = tid & 7;
        p[0] = B0 + (size_t)row * ldb + kc * 8;
        p[1] = B1 + (size_t)row * ldb + kc * 8;
        lo[0] = lds_off(row, kc * 8); lo[1] = lds_off(row + 64, kc * 8);
    }
    __device__ __forceinline__ void issue(int kt) { r[0] = *(const u32x4*)(p[0] + kt * 64); r[1] = *(const u32x4*)(p[1] + kt * 64); }
    __device__ __forceinline__ void commit(char* Bs) {
        *(u32x4*)(Bs + lo[0]) = r[0];
        *(u32x4*)(Bs + lo[1]) = r[1];
    }
};
template <bool PAIRED, class AL>
__device__ __forceinline__ void gemm_mainloop(int tid, char* smem, AL& al, BLoad& bl, int nkt, f32x4 (&acc)[4][4]) {
    const int lane = tid & 63, wid = tid >> 6, wr = wid >> 1, wc = wid & 1, fr = lane & 15, fq = lane >> 4;
#pragma unroll
    for (int a = 0; a < 4; ++a)
#pragma unroll
        for (int b = 0; b < 4; ++b) acc[a][b] = (f32x4){0.f, 0.f, 0.f, 0.f};
    char* As = smem; char* Bs = smem + 2 * A_STAGE;
    al.issue(0); bl.issue(0);
    al.commit(As); bl.commit(Bs);
    lds_barrier();
    for (int kt = 0; kt < nkt; ++kt) {
        const int cur = kt & 1;
        if (kt + 1 < nkt) { al.issue(kt + 1); bl.issue(kt + 1); }
        const char* Ac = As + cur * A_STAGE; const char* Bc = Bs + cur * B_STAGE;
#pragma unroll
        for (int ks = 0; ks < 2; ++ks) {
            bf16x8 af[4], bfr[4];
#pragma unroll
            for (int mf = 0; mf < 4; ++mf) af[mf] = *(const bf16x8*)(Ac + lds_off(wr * 64 + mf * 16 + fr, ks * 32 + fq * 8));
#pragma unroll
            for (int nf = 0; nf < 4; ++nf) {
                const int br = PAIRED ? ((nf >> 1) * 64 + wc * 32 + (nf & 1) * 16) : (wc * 64 + nf * 16);
                bfr[nf] = *(const bf16x8*)(Bc + lds_off(br + fr, ks * 32 + fq * 8));
            }
#pragma unroll
            for (int mf = 0; mf < 4; ++mf)
#pragma unroll
                for (int nf = 0; nf < 4; ++nf) acc[mf][nf] = __builtin_amdgcn_mfma_f32_16x16x32_bf16(bfr[nf], af[mf], acc[mf][nf], 0, 0, 0);
        }
        if (kt + 1 < nkt) { al.commit(As + (cur ^ 1) * A_STAGE); bl.commit(Bs + (cur ^ 1) * B_STAGE); }
        lds_barrier();
    }
}

namespace pg8 {
constexpr int BM = 256, BK = 64, HALF = 128, HTB = HALF * BK * 2, NXCD = 8, WGM = 8;
__device__ __forceinline__ void stage_rc(int b, int& R, int& C) { const int st = b / 1024, sb = b % 1024, swz = sb ^ (((sb >> 9) & 1) << 5); R = (st >> 1) * 16 + swz / 64; C = (st & 1) * 32 + (swz % 64) / 2; }
struct Unit { int pm, pn; };
struct Gemm { const bf16_t* A; const bf16_t* Bt; int lda, K, nM, nN; const bf16_t* A2; int ksplit; size_t agstride; int npg; int brows_tile, brows_half; int arows_tile, arow0; int perm; };
struct StaticOrder {
    int nM, nN, nwg, G, c;
    __device__ __forceinline__ void init(int nM_, int nN_, int G_, int c_) { nM = nM_; nN = nN_; nwg = nM * nN; G = G_; c = c_; }
    __device__ __forceinline__ bool next(int i, Unit& u) const {
        const int L = i * G + c; if (L >= nwg) return false;
        int wgid = L; { const int q = nwg / NXCD, r = nwg % NXCD, xcd = wgid % NXCD, off = wgid / NXCD; wgid = (xcd < r ? xcd * (q + 1) : r * (q + 1) + (xcd - r) * q) + off; }
        const int nig = WGM * nN, gid = wgid / nig, fm = gid * WGM, gsz = (nM - fm) < WGM ? (nM - fm) : WGM;
        u.pm = fm + ((wgid % nig) % gsz); u.pn = (wgid % nig) / gsz; return true;
    }
};
template <class Epi>
__device__ __forceinline__ void gemm_phase(int tid, char* smem, const Gemm g, int G, int c, const Epi& E) {
    LAS unsigned char* lds = (LAS unsigned char*)smem;
    const int wid = __builtin_amdgcn_readfirstlane(tid >> 6), lane = tid & 63, wr = wid >> 2, wc = wid & 3, fr = lane & 15, fq = lane >> 4;
    const int K = g.K, nt = K / BK;
    StaticOrder S; S.init(g.nM, g.nN, G, c);
    unsigned voffA[2], voffB[2];
#pragma unroll
    for (int i = 0; i < 2; ++i) { int R, C; stage_rc(tid * 16 + i * 8192, R, C); voffA[i] = (unsigned)(R * g.lda + C) * 2u;
        const int rho = R & 31, Rb = g.perm ? ((R & ~31) + 8 * ((rho & 15) >> 2) + 4 * (rho >> 4) + (rho & 3)) : R;
        voffB[i] = (unsigned)(Rb * K + C) * 2u; }
    const size_t kstep = (size_t)(BK * 2);
    const size_t hstepA = (size_t)HALF * g.lda * 2, hstepB = (size_t)g.brows_half * K * 2;
    const size_t tstepA = (size_t)g.arows_tile * g.lda * 2, tstepB = (size_t)g.brows_tile * K * 2;
    const ptrdiff_t a0off = (ptrdiff_t)g.arow0 * g.lda * 2;
    const unsigned ldsw = (unsigned)wid * 1024u;
    const int aoff = lds_off(wr * 64 + fr, fq * 8), boff = lds_off(wc * 32 + fr, fq * 8);
#define PG8_SA(b, h) (((b) * 2 + (h)) * HTB)
#define PG8_SB(b, h) ((4 + (b) * 2 + (h)) * HTB)
#define PG8_STAGE(bufoff, gbase, voff) do { _Pragma("unroll") for (int _i = 0; _i < 2; ++_i) \
        __builtin_amdgcn_global_load_lds((const unsigned*)((const char*)(gbase) + (voff)[_i]), (LAS unsigned*)(lds + (bufoff) + ldsw + _i * 8192), 16, 0, 0); } while (0)
#define PG8_LDA(dst, b, h) do { _Pragma("unroll") for (int m = 0; m < 4; ++m) _Pragma("unroll") for (int k = 0; k < 2; ++k) dst[m][k] = *(const LAS bf16x8*)(lds + PG8_SA(b, h) + aoff + m * 2048 + k * 1024); } while (0)
#define PG8_LDB(dst, b, h) do { _Pragma("unroll") for (int n = 0; n < 2; ++n) _Pragma("unroll") for (int k = 0; k < 2; ++k) dst[n][k] = *(const LAS bf16x8*)(lds + PG8_SB(b, h) + boff + n * 2048 + k * 1024); } while (0)
#define PG8_MMA(ai, bj, At, Bt) do { __builtin_amdgcn_s_setprio(1); _Pragma("unroll") for (int m = 0; m < 4; ++m) _Pragma("unroll") for (int n = 0; n < 2; ++n) _Pragma("unroll") for (int k = 0; k < 2; ++k) \
        acc[ai][bj][m][n] = __builtin_amdgcn_mfma_f32_16x16x32_bf16(Bt[n][k], At[m][k], acc[ai][bj][m][n], 0, 0, 0); __builtin_amdgcn_s_setprio(0); } while (0)
#define PG8_WAIT_V(n) asm volatile("s_waitcnt vmcnt(" #n ")" ::: "memory")
#define PG8_WAIT_L(n) asm volatile("s_waitcnt lgkmcnt(" #n ")" ::: "memory")
#define PG8_BAR __builtin_amdgcn_s_barrier()
#define PG8_SCHED __builtin_amdgcn_sched_barrier(0)
    Unit cur, nxt; int ui = 0;
    if (!S.next(0, cur)) return;
    f32x4 acc[2][2][4][2];
#pragma unroll
    for (int a = 0; a < 2; ++a)
#pragma unroll
        for (int b = 0; b < 2; ++b)
#pragma unroll
            for (int m = 0; m < 4; ++m)
#pragma unroll
                for (int n = 0; n < 2; ++n) acc[a][b][m][n] = (f32x4){0.f, 0.f, 0.f, 0.f};
    bf16x8 At[4][2], B0[2][2], B1[2][2];
    const int ksplit = g.ksplit;
    const char* cA = (const char*)g.A + (size_t)(cur.pn / g.npg) * g.agstride * 2 + (size_t)cur.pm * tstepA + a0off; const char* cA2 = (const char*)g.A2 + (size_t)cur.pm * tstepA - (size_t)ksplit * kstep;
    const char* cB = (const char*)g.Bt + (size_t)cur.pn * tstepB;
    PG8_STAGE(PG8_SB(0, 0), cB, voffB); PG8_STAGE(PG8_SB(0, 1), cB + hstepB, voffB); PG8_STAGE(PG8_SA(0, 0), cA, voffA); PG8_STAGE(PG8_SA(0, 1), cA + hstepA, voffA);
    if (wr == 1) PG8_BAR;
    PG8_WAIT_V(2); PG8_BAR;
    PG8_STAGE(PG8_SB(1, 0), cB + kstep, voffB); PG8_STAGE(PG8_SA(1, 0), cA + kstep, voffA); PG8_STAGE(PG8_SB(1, 1), cB + hstepB + kstep, voffB);
    PG8_WAIT_V(6); PG8_BAR;
    for (;;) {
        const bool has_next = S.next(ui + 1, nxt);
        const char* nA = has_next ? (const char*)g.A + (size_t)(nxt.pn / g.npg) * g.agstride * 2 + (size_t)nxt.pm * tstepA + a0off : cA; const char* nA2 = has_next ? (const char*)g.A2 + (size_t)nxt.pm * tstepA - (size_t)ksplit * kstep : cA2;
        const char* nB = has_next ? (const char*)g.Bt + (size_t)nxt.pn * tstepB : cB;
        for (int t = 0; t < nt; t += 2) {
            const bool last = (t == nt - 2);
            const char* a1 = ((t + 1 < ksplit) ? cA : cA2) + (size_t)(t + 1) * kstep;
            const char* a2 = last ? nA : ((t + 2 < ksplit) ? cA : cA2) + (size_t)(t + 2) * kstep; const char* b2 = last ? nB : cB + (size_t)(t + 2) * kstep;
            const char* a3 = last ? nA + kstep : ((t + 3 < ksplit) ? cA : cA2) + (size_t)(t + 3) * kstep; const char* b3 = b2 + kstep;
            PG8_LDB(B0, 0, 0); PG8_LDB(B1, 0, 1); PG8_SCHED; PG8_LDA(At, 0, 0); PG8_STAGE(PG8_SA(1, 1), a1 + hstepA, voffA);
            PG8_WAIT_V(8); PG8_WAIT_L(0); PG8_BAR; PG8_MMA(0, 0, At, B0); PG8_MMA(0, 1, At, B1); PG8_BAR; PG8_SCHED;
            PG8_LDA(At, 0, 1); PG8_STAGE(PG8_SB(0, 0), b2, voffB); PG8_STAGE(PG8_SB(0, 1), b2 + hstepB, voffB); PG8_STAGE(PG8_SA(0, 0), a2, voffA);
            PG8_WAIT_V(8); PG8_WAIT_L(0); PG8_BAR; PG8_MMA(1, 0, At, B0); PG8_MMA(1, 1, At, B1); PG8_BAR; PG8_SCHED;
            PG8_LDB(B0, 1, 0); PG8_LDB(B1, 1, 1); PG8_SCHED; PG8_LDA(At, 1, 0); PG8_STAGE(PG8_SA(0, 1), a2 + hstepA, voffA);
            PG8_WAIT_V(8); PG8_WAIT_L(0); PG8_BAR; PG8_MMA(0, 0, At, B0); PG8_MMA(0, 1, At, B1); PG8_BAR; PG8_SCHED;
            PG8_LDA(At, 1, 1); PG8_STAGE(PG8_SB(1, 0), b3, voffB); PG8_STAGE(PG8_SB(1, 1), b3 + hstepB, voffB); PG8_STAGE(PG8_SA(1, 0), a3, voffA);
            PG8_WAIT_V(8); PG8_WAIT_L(0); PG8_BAR; PG8_MMA(1, 0, At, B0); PG8_MMA(1, 1, At, B1); PG8_BAR; PG8_SCHED;
        }
        if (wr == 0) PG8_BAR;
        E(acc, cur, wr, wc, fr, fq);
        if (!has_next) break;
#pragma unroll
        for (int a = 0; a < 2; ++a)
#pragma unroll
            for (int b = 0; b < 2; ++b)
#pragma unroll
                for (int m = 0; m < 4; ++m)
#pragma unroll
                    for (int n = 0; n < 2; ++n) acc[a][b][m][n] = (f32x4){0.f, 0.f, 0.f, 0.f};
        cur = nxt; cA = nA; cA2 = nA2; cB = nB; ++ui;
        if (wr == 1) PG8_BAR;
    }
    PG8_WAIT_V(0);
    PG8_BAR;
#undef PG8_SA
#undef PG8_SB
#undef PG8_STAGE
#undef PG8_LDA
#undef PG8_LDB
#undef PG8_MMA
#undef PG8_WAIT_V
#undef PG8_WAIT_L
#undef PG8_BAR
#undef PG8_SCHED
}
struct EpiRes {
    bf16_t* X;
    __device__ __forceinline__ void operator()(const f32x4 (&acc)[2][2][4][2], const Unit& u, int wr, int wc, int fr, int fq) const {
        const int row0 = u.pm * BM + wr * 64 + fr, col0 = u.pn * BM + wc * 32 + 8 * fq;
#pragma unroll
        for (int ai = 0; ai < 2; ++ai) {
            u32x4 xv[4][2];
#pragma unroll
            for (int m = 0; m < 4; ++m) { const bf16_t* rowp = X + (size_t)(row0 + ai * HALF + m * 16) * D + col0;
#pragma unroll
                for (int bj = 0; bj < 2; ++bj) xv[m][bj] = *(const u32x4*)(rowp + bj * HALF); }
#pragma unroll
            for (int m = 0; m < 4; ++m) { bf16_t* rowp = X + (size_t)(row0 + ai * HALF + m * 16) * D + col0;
#pragma unroll
                for (int bj = 0; bj < 2; ++bj) {
                    const u32x4 x = xv[m][bj]; const f32x4 v0 = acc[ai][bj][m][0], v1 = acc[ai][bj][m][1];
                    u32x4 w;
                    w.x = pack2(lo16(x.x) + v0[0], hi16(x.x) + v0[1]); w.y = pack2(lo16(x.y) + v0[2], hi16(x.y) + v0[3]);
                    w.z = pack2(lo16(x.z) + v1[0], hi16(x.z) + v1[1]); w.w = pack2(lo16(x.w) + v1[2], hi16(x.w) + v1[3]);
                    *(u32x4*)(rowp + bj * HALF) = w;
                } }
        }
    }
};
struct EpiBf16 {
    bf16_t* O; int ldc; int ncol; float* AB;
    __device__ __forceinline__ void operator()(const f32x4 (&acc)[2][2][4][2], const Unit& u, int wr, int wc, int fr, int fq) const {
        const int row0 = u.pm * BM + wr * 64 + fr, col0 = u.pn * BM + wc * 32 + 8 * fq;
#pragma unroll
        for (int ai = 0; ai < 2; ++ai)
#pragma unroll
            for (int m = 0; m < 4; ++m) { const size_t row = (size_t)(row0 + ai * HALF + m * 16);
#pragma unroll
                for (int bj = 0; bj < 2; ++bj) {
                    const int col = col0 + bj * HALF; const f32x4 v0 = acc[ai][bj][m][0], v1 = acc[ai][bj][m][1];
                    if (col < ncol) { u32x4 w; w.x = pack2(v0[0], v0[1]); w.y = pack2(v0[2], v0[3]); w.z = pack2(v1[0], v1[1]); w.w = pack2(v1[2], v1[3]); *(u32x4*)(O + row * ldc + col) = w; }
                    else if (AB && col < ncol + 16) { *(f32x4*)(AB + row * 16 + (col - ncol)) = v0; *(f32x4*)(AB + row * 16 + (col - ncol) + 4) = v1; }
                } }
    }
};
struct EpiRwkv1 {
    bf16_t* C1; bf16_t* VF; int colbase; int lora; int rowbase;
    __device__ __forceinline__ void operator()(const f32x4 (&acc)[2][2][4][2], const Unit& u, int wr, int wc, int fr, int fq) const {
        const int row0 = rowbase + u.pm * BM + wr * 64 + fr, col0 = u.pn * BM + wc * 32 + 8 * fq;
#pragma unroll
        for (int ai = 0; ai < 2; ++ai)
#pragma unroll
            for (int m = 0; m < 4; ++m) { const size_t row = (size_t)(row0 + ai * HALF + m * 16);
#pragma unroll
                for (int bj = 0; bj < 2; ++bj) {
                    const int col = col0 + bj * HALF; f32x4 v0 = acc[ai][bj][m][0], v1 = acc[ai][bj][m][1];
                    if (lora) {
                        if (col < 128) {
#pragma unroll
                            for (int e = 0; e < 4; ++e) { v0[e] = tanhf_(v0[e]); v1[e] = tanhf_(v1[e]); } }
                        else if (col >= 256 && col < 512) {
#pragma unroll
                            for (int e = 0; e < 4; ++e) { v0[e] = sigmoidf_(v0[e]); v1[e] = sigmoidf_(v1[e]); } }
                    }
                    u32x4 w; w.x = pack2(v0[0], v0[1]); w.y = pack2(v0[2], v0[3]); w.z = pack2(v1[0], v1[1]); w.w = pack2(v1[2], v1[3]);
                    *(u32x4*)(C1 + row * R1_N + colbase + col) = w;
                    if (VF && col >= 2048) *(u32x4*)(VF + row * D + (col - 2048)) = w;
                } }
    }
};
template <int CTRL> __device__ __forceinline__ float dpp_shift(float oldv, float src) {
    return __int_as_float(__builtin_amdgcn_update_dpp(__float_as_int(oldv), __float_as_int(src), CTRL, 0xf, 0xf, false));
}
template <int CTRL> __device__ __forceinline__ float dpp_rot(float src) {
    return __int_as_float(__builtin_amdgcn_update_dpp(0, __float_as_int(src), CTRL, 0xf, 0xf, true));
}
struct EpiFfn {
    bf16_t* H; const float* cw; const float* stfc; float* fc_p; float* fc_s; int layer; float* xg;
    __device__ __forceinline__ void operator()(const f32x4 (&acc)[2][2][4][2], const Unit& u, int wr, int wc, int fr, int fq) const {
        if (fr >= 14) {
#pragma unroll
            for (int ai = 0; ai < 2; ++ai)
#pragma unroll
                for (int n = 0; n < 2; ++n) *(f32x4*)(xg + (((((ai * 2 + wr) * 4 + wc) * 2 + n) * 4 + fq) * 2 + (fr - 14)) * 4) = acc[ai][0][3][n];
        }
        asm volatile("s_waitcnt lgkmcnt(0)" ::: "memory");
        __builtin_amdgcn_s_barrier();
        asm volatile("" ::: "memory");
        const int mfirst = 254 * u.pm - 2, ff0 = 128 * u.pn + 32 * wc + 8 * fq;
        f32x4 cw0[2], cw1[2], cw2[2];
#pragma unroll
        for (int n = 0; n < 2; ++n) { cw0[n] = *(const f32x4*)(cw + ff0 + 4 * n); cw1[n] = *(const f32x4*)(cw + DFF + ff0 + 4 * n); cw2[n] = *(const f32x4*)(cw + 2 * DFF + ff0 + 4 * n); }
        asm volatile("" :: "v"(cw0[0]), "v"(cw0[1]), "v"(cw1[0]), "v"(cw1[1]), "v"(cw2[0]), "v"(cw2[1]));
#pragma unroll
        for (int ai = 0; ai < 2; ++ai) {
#pragma unroll
            for (int m = 0; m < 4; ++m) {
                const int r = 128 * ai + 64 * wr + 16 * m + fr, mg = mfirst + r;
                int seq, t, L; tokdec(mg < 0 ? 0 : mg, seq, t, L);
                const bool live = (r >= 2) && (mg < T);
                u32x2 hw[2];
#pragma unroll
                for (int n = 0; n < 2; ++n) {
                    const int ff = ff0 + 4 * n;
                    const f32x4 g0 = acc[ai][0][m][n], up = acc[ai][1][m][n];
                    f32x4 pf;
                    if (m > 0) pf = acc[ai][0][m - 1][n];
                    else {
                        const int sai = (wr == 1) ? ai : 0, swr = (wr == 1) ? 0 : 1;
                        pf = (f32x4){0.f, 0.f, 0.f, 0.f};
                        if (fr >= 14 && (wr == 1 || ai == 1)) pf = *(const f32x4*)(xg + (((((sai * 2 + swr) * 4 + wc) * 2 + n) * 4 + fq) * 2 + (fr - 14)) * 4);
                    }
                    f32x4 g1, g2;
#pragma unroll
                    for (int e = 0; e < 4; ++e) {
                        g1[e] = dpp_shift<0x111>(dpp_rot<0x121>(pf[e]), g0[e]);
                        g2[e] = dpp_shift<0x112>(dpp_rot<0x122>(pf[e]), g0[e]);
                    }
                    if (live) {
                        if (t < 2) {
                            f32x4 b0 = {0.f, 0.f, 0.f, 0.f}, b1 = b0;
                            if (seq >= 8) { const float* sb = stfc + (((size_t)layer * 128 + (seq - 8)) * 2) * DFF + ff; b0 = *(const f32x4*)sb; b1 = *(const f32x4*)(sb + DFF); }
                            if (t == 0) { g1 = b1; g2 = b0; } else g2 = b1;
                        }
                        const f32x4 cv = cw0[n] * g2 + cw1[n] * g1 + cw2[n] * g0;
                        hw[n].x = pack2(siluf_(cv[0]) * up[0], siluf_(cv[1]) * up[1]); hw[n].y = pack2(siluf_(cv[2]) * up[2], siluf_(cv[3]) * up[3]);
                        if (t >= L - 2) {
                            float* od = (seq < 8) ? fc_p + (((size_t)layer * 8 + seq) * 2 + (t - (L - 2))) * DFF + ff : fc_s + (((size_t)layer * 128 + (seq - 8)) * 2 + (t - (L - 2))) * DFF + ff;
                            *(f32x4*)od = g0;
                        }
                    }
                }
                if (live) { u32x4 w; w.x = hw[0].x; w.y = hw[0].y; w.z = hw[1].x; w.w = hw[1].y; *(u32x4*)(H + (size_t)mg * DFF + ff0) = w; }
            }
        }
    }
};
}

__device__ __forceinline__ void gdn_in_phase(CParams& p, int j, char* smem) {
    const int tid = otid();
    pg8::Gemm g; g.A = p.HN; g.Bt = p.w_in_t + (size_t)j * GIN_NP * D; g.lda = D; g.K = D; g.nM = MPAD / 256; g.nN = GIN_NP / 256; g.A2 = g.A; g.ksplit = 1 << 20; g.agstride = 0; g.npg = 1 << 20; g.brows_tile = 256; g.brows_half = 128; g.arows_tile = 256; g.arow0 = 0; g.perm = 0;
    g.perm = 1;
    pg8::EpiBf16 E; E.O = p.RA; E.ldc = GIN_LD; E.ncol = GIN_LD; E.AB = p.AB;
    pg8::gemm_phase(tid, smem, g, ogrid(), obid(), E);
    if (j == 0) {
        const int G = ogrid(), bid = obid(), nwg = g.nM * g.nN, rem = nwg % G;
        if (rem > 0 && G - rem >= 64) { if (bid >= rem) prep_phase(p, smem, p.pad0, p.pad2, bid - rem, G - rem); }
        else prep_phase(p, smem, p.pad0, p.pad2, bid, G);
    }
}
constexpr int RES_MAIN_TILES = 64, RES_ROW0 = RES_MAIN_TILES * 256;
__device__ __forceinline__ void res_gemm_phase(CParams& p, const bf16_t* A, int K, const bf16_t* Bt, char* smem, int rep = 0) {
    const int tid = otid(), lane = tid & 63, wid = tid >> 6, fr = lane & 15, fq = lane >> 4;
    bf16_t* X = rep ? p.RA : p.X;
    pg8::Gemm g; g.A = A; g.Bt = Bt; g.lda = K; g.K = K; g.nM = RES_MAIN_TILES; g.nN = D / 256; g.A2 = g.A; g.ksplit = 1 << 20; g.agstride = 0; g.npg = 1 << 20; g.brows_tile = 256; g.brows_half = 128; g.arows_tile = 256; g.arow0 = 0; g.perm = 1;
    pg8::EpiRes E; E.X = X;
    pg8::gemm_phase(tid, smem, g, ogrid(), obid(), E);
    float* red = (float*)smem;
    const int ksteps = K / 256;
    for (int st = obid(); st < 256; st += ogrid()) {
        const int rb = st >> 5, cb = st & 31;
        const bf16_t* ap = A + (size_t)(RES_ROW0 + rb * 80 + fr) * K + wid * (K / 8) + fq * 8;
        const bf16_t* bp = Bt + (size_t)(cb * 32 + fr) * K + wid * (K / 8) + fq * 8;
        f32x4 acc[5][2];
#pragma unroll
        for (int mf = 0; mf < 5; ++mf) { acc[mf][0] = (f32x4){0.f, 0.f, 0.f, 0.f}; acc[mf][1] = acc[mf][0]; }
        bf16x8 af[4][5], bf[4][2];
#pragma unroll
        for (int sl = 0; sl < 4; ++sl) {
            if (sl < ksteps) {
#pragma unroll
                for (int mf = 0; mf < 5; ++mf) af[sl][mf] = *(const bf16x8*)(ap + (size_t)(mf * 16) * K + sl * 32);
#pragma unroll
                for (int nf = 0; nf < 2; ++nf) bf[sl][nf] = *(const bf16x8*)(bp + (size_t)(nf * 16) * K + sl * 32);
            }
        }
        for (int ks0 = 0; ks0 < ksteps; ks0 += 4) {
#pragma unroll
            for (int sl = 0; sl < 4; ++sl) {
                const int ks = ks0 + sl;
                if (ks < ksteps) {
#pragma unroll
                    for (int mf = 0; mf < 5; ++mf)
#pragma unroll
                        for (int nf = 0; nf < 2; ++nf) acc[mf][nf] = __builtin_amdgcn_mfma_f32_16x16x32_bf16(bf[sl][nf], af[sl][mf], acc[mf][nf], 0, 0, 0);
                    if (ks + 4 < ksteps) {
#pragma unroll
                        for (int mf = 0; mf < 5; ++mf) af[sl][mf] = *(const bf16x8*)(ap + (size_t)(mf * 16) * K + (ks + 4) * 32);
#pragma unroll
                        for (int nf = 0; nf < 2; ++nf) bf[sl][nf] = *(const bf16x8*)(bp + (size_t)(nf * 16) * K + (ks + 4) * 32);
                    }
                }
            }
        }
        float xv[5];
#pragma unroll
        for (int q = 0; q < 5; ++q) { const int o = tid + q * NTH; xv[q] = bf2f(X[(size_t)(RES_ROW0 + rb * 80 + (o >> 5)) * D + cb * 32 + (o & 31)]); }
#pragma unroll
        for (int mf = 0; mf < 5; ++mf)
#pragma unroll
            for (int nf = 0; nf < 2; ++nf) *(f32x4*)(red + (wid * 80 + mf * 16 + fr) * 32 + nf * 16 + 4 * fq) = acc[mf][nf];
        lds_barrier();
#pragma unroll
        for (int q = 0; q < 5; ++q) {
            const int o = tid + q * NTH, row = o >> 5, col = o & 31;
            float sum = xv[q];
#pragma unroll
            for (int w = 0; w < 8; ++w) sum += red[(w * 80 + row) * 32 + col];
            X[(size_t)(RES_ROW0 + rb * 80 + row) * D + cb * 32 + col] = (bf16_t)f2bf(sum);
        }
        lds_barrier();
    }
}
__device__ __forceinline__ void ffn_up_phase(CParams& p, int layer, char* smem) {
    const int tid = otid();
    pg8::Gemm g; g.A = p.HN; g.Bt = p.up_t + (size_t)layer * (2 * DFF) * D; g.lda = D; g.K = D; g.nM = 68; g.nN = DFF / 128;
    g.A2 = g.A; g.ksplit = 1 << 20; g.agstride = 0; g.npg = 1 << 20; g.brows_tile = 128; g.brows_half = DFF; g.arows_tile = 254; g.arow0 = -2; g.perm = 1;
    pg8::EpiFfn E; E.H = p.RA; E.cw = p.ffn_conv_w + (size_t)layer * 3 * DFF; E.stfc = p.st_fC; E.fc_p = p.fC_p; E.fc_s = p.fC_s; E.layer = layer;
    E.xg = (float*)(smem + 131072 + 1024);
    pg8::gemm_phase(tid, smem, g, ogrid(), obid(), E);
}
constexpr size_t H_OFF = 0;
__device__ __forceinline__ void ffn_act_phase(CParams& p, int layer) {
    const int tid = otid();
    const bf16_t* GU = p.RA; bf16_t* H = p.RA + H_OFF;
    const float* cw = p.ffn_conv_w + (size_t)layer * 3 * DFF;
    constexpr int NCK = DFF / 8, RB = 16, NRB = T / RB;
    for (int idx = obid() * NTH + tid; idx < NRB * NCK; idx += ogrid() * NTH) {
        const int rb = idx / NCK, ck = idx - rb * NCK, ff = ck * 8, mstart = rb * RB;
        float w0[8], w1[8], w2[8], g1[8], g2[8];
#pragma unroll
        for (int q = 0; q < 2; ++q) {
            const f32x4 a0 = *(const f32x4*)(cw + ff + 4 * q), a1 = *(const f32x4*)(cw + DFF + ff + 4 * q), a2 = *(const f32x4*)(cw + 2 * DFF + ff + 4 * q);
#pragma unroll
            for (int e = 0; e < 4; ++e) { w0[4 * q + e] = a0[e]; w1[4 * q + e] = a1[e]; w2[4 * q + e] = a2[e]; }
        }
        {
            const int ma = mstart >= 1 ? mstart - 1 : 0, mb = mstart >= 2 ? mstart - 2 : 0;
            const u32x4 r1 = *(const u32x4*)(GU + (size_t)ma * 2 * DFF + ff), r2 = *(const u32x4*)(GU + (size_t)mb * 2 * DFF + ff);
#pragma unroll
            for (int q = 0; q < 4; ++q) { g1[2 * q] = lo16(r1[q]); g1[2 * q + 1] = hi16(r1[q]); g2[2 * q] = lo16(r2[q]); g2[2 * q + 1] = hi16(r2[q]); }
        }
#pragma unroll 1
        for (int i0 = 0; i0 < RB; i0 += 4) {
            u32x4 g0rr[4], uprr[4];
#pragma unroll
            for (int ii = 0; ii < 4; ++ii) {
                const int m = mstart + i0 + ii;
                g0rr[ii] = *(const u32x4*)(GU + (size_t)m * 2 * DFF + ff); uprr[ii] = *(const u32x4*)(GU + (size_t)m * 2 * DFF + DFF + ff);
            }
#pragma unroll
        for (int ii = 0; ii < 4; ++ii) {
            const int m = mstart + i0 + ii;
            int seq, t, L; tokdec(m, seq, t, L);
            const u32x4 g0r = g0rr[ii], upr = uprr[ii];
            float g0[8], up[8];
#pragma unroll
            for (int q = 0; q < 4; ++q) { g0[2 * q] = lo16(g0r[q]); g0[2 * q + 1] = hi16(g0r[q]); up[2 * q] = lo16(upr[q]); up[2 * q + 1] = hi16(upr[q]); }
            if (t < 2) {
                f32x4 b0a = {0.f, 0.f, 0.f, 0.f}, b0b = b0a, b1a = b0a, b1b = b0a;
                if (seq >= 8) {
                    const float* sb = p.st_fC + (((size_t)layer * 128 + (seq - 8)) * 2) * DFF + ff;
                    b0a = *(const f32x4*)sb; b0b = *(const f32x4*)(sb + 4); b1a = *(const f32x4*)(sb + DFF); b1b = *(const f32x4*)(sb + DFF + 4);
                }
#pragma unroll
                for (int e = 0; e < 8; ++e) {
                    const float s0 = e < 4 ? b0a[e] : b0b[e - 4], s1 = e < 4 ? b1a[e] : b1b[e - 4];
                    if (t == 0) { g1[e] = s1; g2[e] = s0; } else { g2[e] = s1; }
                }
            }
            u32x4 o;
#pragma unroll
            for (int q = 0; q < 4; ++q) {
                const int e0 = 2 * q, e1 = 2 * q + 1;
                const float c0 = w0[e0] * g2[e0] + w1[e0] * g1[e0] + w2[e0] * g0[e0], c1 = w0[e1] * g2[e1] + w1[e1] * g1[e1] + w2[e1] * g0[e1];
                o[q] = pack2(siluf_(c0) * up[e0], siluf_(c1) * up[e1]);
            }
            *(u32x4*)(H + (size_t)m * DFF + ff) = o;
            if (t >= L - 2) {
                float* od = (seq < 8) ? p.fC_p + (((size_t)layer * 8 + seq) * 2 + (t - (L - 2))) * DFF + ff
                                      : p.fC_s + (((size_t)layer * 128 + (seq - 8)) * 2 + (t - (L - 2))) * DFF + ff;
                *(f32x4*)od = (f32x4){g0[0], g0[1], g0[2], g0[3]}; *(f32x4*)(od + 4) = (f32x4){g0[4], g0[5], g0[6], g0[7]};
            }
#pragma unroll
            for (int e = 0; e < 8; ++e) { g2[e] = g1[e]; g1[e] = g0[e]; }
        }
        }
    }
}

__device__ __forceinline__ void rwkv_norm_phase(CParams& p, int layer) {
    const int tid = otid(), lane = tid & 63, wave = tid >> 6;
    const int gw = obid() * 8 + wave, NGW = ogrid() * 8;
    const int j = layer >> 1;
    const float* g = p.norm_mix + layer * D;
    const float* mx = p.rwkv_mix + (size_t)j * 6 * D;
    bf16_t* XR = (bf16_t*)p.RB; bf16_t* XK = XR + (size_t)MPAD * D; bf16_t* XV = XK + (size_t)MPAD * D; bf16_t* PV = XV + (size_t)MPAD * D;
    f32x4 gv[4], mr[4], mk[4], mv[4];
#pragma unroll
    for (int q = 0; q < 4; ++q) {
        gv[q] = *(const f32x4*)(g + q * 256 + lane * 4);
        mr[q] = *(const f32x4*)(mx + 0 * D + q * 256 + lane * 4); mk[q] = *(const f32x4*)(mx + 2 * D + q * 256 + lane * 4); mv[q] = *(const f32x4*)(mx + 3 * D + q * 256 + lane * 4);
    }
    f32x4 nv[4], np_[4];
    auto load_rows = [&](int m) {
        int seq, t, L; tokdec(m, seq, t, L);
        const bf16_t* s0 = p.X + (size_t)m * D;
        const float* s1 = (t == 0 && seq >= 8) ? p.st_rSh + ((size_t)j * 128 + (seq - 8)) * D : nullptr;
#pragma unroll
        for (int q = 0; q < 4; ++q) {
            const u32x2 r = *(const u32x2*)(s0 + q * 256 + lane * 4); nv[q] = (f32x4){lo16(r.x), hi16(r.x), lo16(r.y), hi16(r.y)};
            if (t > 0) { const u32x2 rp = *(const u32x2*)(s0 - D + q * 256 + lane * 4); np_[q] = (f32x4){lo16(rp.x), hi16(rp.x), lo16(rp.y), hi16(rp.y)}; }
            else np_[q] = s1 ? *(const f32x4*)(s1 + q * 256 + lane * 4) : (f32x4){0.f, 0.f, 0.f, 0.f};
        }
    };
    if (gw < T) load_rows(gw);
    for (int m = gw; m < MPAD; m += NGW) {
        if (m >= T) {
            u32x2 z; z.x = 0; z.y = 0;
#pragma unroll
            for (int q = 0; q < 4; ++q) { const size_t o = (size_t)m * D + q * 256 + lane * 4; *(u32x2*)(p.HN + o) = z; *(u32x2*)(XR + o) = z; *(u32x2*)(XK + o) = z; *(u32x2*)(XV + o) = z; *(u32x2*)(PV + o) = z; }
            continue;
        }
        int seq, t, L; tokdec(m, seq, t, L);
        f32x4 v[4], pv[4]; float ss = 0.f, sp = 0.f;
#pragma unroll
        for (int q = 0; q < 4; ++q) { v[q] = nv[q]; pv[q] = np_[q]; ss += v[q].x * v[q].x + v[q].y * v[q].y + v[q].z * v[q].z + v[q].w * v[q].w; sp += pv[q].x * pv[q].x + pv[q].y * pv[q].y + pv[q].z * pv[q].z + pv[q].w * pv[q].w; }
        if (m + NGW < T) load_rows(m + NGW);
        ss = wave_sum(ss); sp = wave_sum(sp);
        const float rstd = rsqrtf(ss * (1.f / D) + 1e-6f);
        const float rstp = (t > 0) ? rsqrtf(sp * (1.f / D) + 1e-6f) : 0.f;
#pragma unroll
        for (int q = 0; q < 4; ++q) {
            const f32x4 h = v[q] * rstd * gv[q];
            const f32x4 pr = (t > 0) ? pv[q] * rstp * gv[q] : pv[q];
            const f32x4 dd = pr - h;
            const f32x4 xr = h + dd * mr[q], xk = h + dd * mk[q], xv = h + dd * mv[q];
            const size_t o = (size_t)m * D + q * 256 + lane * 4;
            u32x2 w;
            w.x = pack2(h.x, h.y); w.y = pack2(h.z, h.w); *(u32x2*)(p.HN + o) = w;
            w.x = pack2(pr.x, pr.y); w.y = pack2(pr.z, pr.w); *(u32x2*)(PV + o) = w;
            w.x = pack2(xr.x, xr.y); w.y = pack2(xr.z, xr.w); *(u32x2*)(XR + o) = w;
            w.x = pack2(xk.x, xk.y); w.y = pack2(xk.z, xk.w); *(u32x2*)(XK + o) = w;
            w.x = pack2(xv.x, xv.y); w.y = pack2(xv.z, xv.w); *(u32x2*)(XV + o) = w;
            if (t == L - 1) {
                float* od = (seq < 8) ? p.rSh_p + ((size_t)j * 8 + seq) * D : p.rSh_s + ((size_t)j * 128 + (seq - 8)) * D;
                *(f32x4*)(od + q * 256 + lane * 4) = h;
            }
        }
    }
}
__device__ __forceinline__ void rwkv_in_phase(CParams& p, int j, char* smem) {
    const int tid = otid(), G = ogrid(), bid = obid();
    constexpr int NLORA = (MPAD / 256) * 3;
    const bool split = G > NLORA + 36;
    {
        pg8::Gemm g; g.A = (const bf16_t*)p.RB; g.Bt = p.rwkv1_t + (size_t)j * 3072 * D; g.lda = D; g.K = D; g.nM = split ? 64 : MPAD / 256; g.nN = 12;
        g.A2 = g.A; g.ksplit = 1 << 20; g.agstride = (size_t)MPAD * D; g.npg = 4; g.brows_tile = 256; g.brows_half = 128; g.arows_tile = 256; g.arow0 = 0; g.perm = 0;
        g.perm = 1;
        pg8::EpiRwkv1 E; E.C1 = p.RA; E.VF = (j == 0) ? p.VFIRST : nullptr; E.colbase = 0; E.lora = 0; E.rowbase = 0;
        pg8::gemm_phase(tid, smem, g, G, bid, E);
    }
    if (!split || bid < NLORA) {
        pg8::Gemm g; g.A = p.HN; g.Bt = p.l1t + (size_t)j * 768 * 2048; g.lda = D; g.K = 2048; g.nM = MPAD / 256; g.nN = 3;
        g.A2 = (const bf16_t*)(p.RB + 3 * (size_t)MPAD * D * 2); g.ksplit = 16; g.agstride = 0; g.npg = 1 << 20; g.brows_tile = 256; g.brows_half = 128; g.arows_tile = 256; g.arow0 = 0; g.perm = 0;
        g.perm = 1;
        pg8::EpiRwkv1 E; E.C1 = p.RA; E.VF = nullptr; E.colbase = 3072; E.lora = 1; E.rowbase = 0;
        pg8::gemm_phase(tid, smem, g, G, bid, E);
    } else {
        pg8::Gemm g; g.A = (const bf16_t*)p.RB; g.Bt = p.rwkv1_t + (size_t)j * 3072 * D; g.lda = D; g.K = D; g.nM = 3; g.nN = 12;
        g.A2 = g.A; g.ksplit = 1 << 20; g.agstride = (size_t)MPAD * D; g.npg = 4; g.brows_tile = 256; g.brows_half = 128; g.arows_tile = 256; g.arow0 = 64 * 256; g.perm = 0;
        g.perm = 1;
        pg8::EpiRwkv1 E; E.C1 = p.RA; E.VF = (j == 0) ? p.VFIRST : nullptr; E.colbase = 0; E.lora = 0; E.rowbase = 64 * 256;
        pg8::gemm_phase(tid, smem, g, G - NLORA, bid - NLORA, E);
    }
}
__device__ __forceinline__ void rwkv_lora_phase(CParams& p, int j, char* smem) {
    const int tid = otid(), lane = tid & 63, wid = tid >> 6, wr = wid >> 1, wc = wid & 1, fr = lane & 15, fq = lane >> 4;
    const int nMt = MPAD / 256, nNt = 8, ngrp = (j == 0) ? 3 : 4, total = nMt * nNt * ngrp, G = ogrid();
    const bf16_t* C1 = p.RA;
    char* As = smem; char* Bs = smem + 2 * A_STAGE;
    ALoadPlain al; BLoad bl;
    auto setup = [&](int u, int& grp, int& m0, int& n0, int& nkt) {
        grp = u / (nMt * nNt); const int r = u - grp * nMt * nNt, nt = r / nMt, mt = r - nt * nMt; m0 = mt * 256; n0 = nt * 128;
        const int acol = grp == 0 ? 3072 : grp == 1 ? 3200 : grp == 2 ? 3328 : 3584;
        const int K = grp == 2 ? 192 : 64; nkt = K / 64;
        const bf16_t* Bt = grp == 0 ? p.w2t + (size_t)j * D * 64 : grp == 1 ? p.a2t + (size_t)j * D * 64 : grp == 2 ? p.g2t + (size_t)j * D * 192 : p.v2t;
        al.init(tid, C1 + acol, R1_N, m0, MPAD - 1);
        bl.init(tid, Bt + (size_t)n0 * K, Bt + (size_t)(n0 + 64) * K, K);
    };
    int u = obid(), st = 0;
    int grp = 0, m0 = 0, n0 = 0, nkt = 1;
    if (u < total) { setup(u, grp, m0, n0, nkt); al.issue(0); bl.issue(0); }
    for (; u < total; u += G) {
        const int cgrp = grp, cm0 = m0, cn0 = n0, cnkt = nkt;
        f32x4 acc[4][4];
#pragma unroll
        for (int a = 0; a < 4; ++a)
#pragma unroll
            for (int b = 0; b < 4; ++b) acc[a][b] = (f32x4){0.f, 0.f, 0.f, 0.f};
        for (int kt = 0; kt < cnkt; ++kt) {
            al.commit(As + st * A_STAGE); bl.commit(Bs + st * B_STAGE);
            lds_barrier();
            if (kt + 1 < cnkt) { al.issue(kt + 1); bl.issue(kt + 1); }
            else if (u + G < total) { setup(u + G, grp, m0, n0, nkt); al.issue(0); bl.issue(0); }
            const char* Ac = As + st * A_STAGE; const char* Bc = Bs + st * B_STAGE;
#pragma unroll
            for (int ks = 0; ks < 2; ++ks) {
                bf16x8 af[4], bfr[4];
#pragma unroll
                for (int mf = 0; mf < 4; ++mf) af[mf] = *(const bf16x8*)(Ac + lds_off(wr * 64 + mf * 16 + fr, ks * 32 + fq * 8));
#pragma unroll
                for (int nf = 0; nf < 4; ++nf) bfr[nf] = *(const bf16x8*)(Bc + lds_off(wc * 64 + nf * 16 + fr, ks * 32 + fq * 8));
                __builtin_amdgcn_s_setprio(1);
#pragma unroll
                for (int mf = 0; mf < 4; ++mf)
#pragma unroll
                    for (int nf = 0; nf < 4; ++nf) acc[mf][nf] = __builtin_amdgcn_mfma_f32_16x16x32_bf16(bfr[nf], af[mf], acc[mf][nf], 0, 0, 0);
                __builtin_amdgcn_s_setprio(0);
            }
            st ^= 1;
        }
        bf16_t* O = (bf16_t*)(p.RB + (size_t)cgrp * MPAD * D * 2);
        const float* bias = cgrp == 0 ? p.rwkv_w0 + (size_t)j * D : cgrp == 1 ? p.rwkv_a0 + (size_t)j * D : cgrp == 3 ? p.rwkv_v0 : nullptr;
        f32x4 bv[2][2];
#pragma unroll
        for (int np = 0; np < 2; ++np) { const int n = cn0 + wc * 64 + np * 32 + 8 * fq;
            bv[np][0] = bias ? *(const f32x4*)(bias + n) : (f32x4){0.f, 0.f, 0.f, 0.f}; bv[np][1] = bias ? *(const f32x4*)(bias + n + 4) : (f32x4){0.f, 0.f, 0.f, 0.f}; }
#pragma unroll
        for (int mf = 0; mf < 4; ++mf) {
            const int m = cm0 + wr * 64 + mf * 16 + fr;
#pragma unroll
            for (int np = 0; np < 2; ++np) {
                const int n = cn0 + wc * 64 + np * 32 + 8 * fq;
                f32x4 v0 = acc[mf][2 * np], v1 = acc[mf][2 * np + 1];
                v0 = v0 + bv[np][0]; v1 = v1 + bv[np][1];
                if (cgrp != 2) {
#pragma unroll
                    for (int e = 0; e < 4; ++e) { v0[e] = sigmoidf_(v0[e]); v1[e] = sigmoidf_(v1[e]); } }
                if (cgrp == 0) { v0 = v0 * 0.60653066f; v1 = v1 * 0.60653066f; }
                u32x4 w; w.x = pack2(v0[0], v0[1]); w.y = pack2(v0[2], v0[3]); w.z = pack2(v1[0], v1[1]); w.w = pack2(v1[2], v1[3]);
                *(u32x4*)(O + (size_t)m * D + n) = w;
            }
        }
    }
    lds_barrier();
}

__device__ __forceinline__ int perm32k(int kl) { return 8 * ((kl >> 2) & 3) + 4 * (kl >> 4) + (kl & 3); }
__device__ __forceinline__ void gdn_prep_phase(CParams& p, int j, char* smem) {
    int tid = otid(), lane = tid & 63, wid = tid >> 6, fr = lane & 15, fq = lane >> 4;
    bf16_t* qs = (bf16_t*)smem;
    bf16_t* ks = (bf16_t*)(smem + 17408);
    float* rhs = (float*)(smem + 34816);
    float* Am = (float*)(smem + 100352);
    float* Gs = (float*)(smem + 117760);
    float* betas = (float*)(smem + 118016);
    float* gs = (float*)(smem + 118272);
    float* cwl = (float*)(smem + 118528);
    float* Tinv = (float*)(smem + 124672);
    bf16_t* AmB = qs;
    const bf16_t* PROJ = p.RA;
    int c8 = tid & 15, rg = tid >> 4, r0 = 2 * rg;
    const int G = ogrid(), bid = obid();
    const bool sticky = (G & 7) == 0;
    const int nitems = sticky ? 8 * NCHUNK : 64 * NCHUNK, istep = sticky ? (G >> 3) : G;
    int q0 = sticky ? (bid >> 3) : bid;
    auto item_of = [&](int q, int& b, int& h, int& n) { if (sticky) { h = bid & 7; b = q / NCHUNK; n = q - b * NCHUNK; } else { n = q % NCHUNK; const int bh = q / NCHUNK; h = bh & 7; b = bh >> 3; } };
    u32x4 rawp[3][5]; float abp[4];
    auto load_raw = [&](int q) {
        int b, h, n; item_of(q, b, h, n);
        const int c = (n == 0) ? 16 : 64, tstart = (n == 0) ? 0 : 16 + 64 * (n - 1);
        if (n > 0) {
            const bf16_t* src = PROJ + (size_t)(b * LP + tstart + r0 - 3) * GIN_LD + h * 128 + c8 * 8;
#pragma unroll
            for (int part = 0; part < 3; ++part)
#pragma unroll
                for (int i = 0; i < 5; ++i) rawp[part][i] = *(const u32x4*)(src + (size_t)i * GIN_LD + part * 1024);
            const float* ab = p.AB + (size_t)(b * LP + tstart + r0) * 16 + h;
            abp[0] = ab[0]; abp[1] = ab[8]; abp[2] = ab[16]; abp[3] = ab[24];
        } else {
#pragma unroll
            for (int part = 0; part < 3; ++part) {
                const int col = part * 1024 + h * 128 + c8 * 8;
#pragma unroll
                for (int i = 0; i < 5; ++i) {
                    const int r = r0 - 3 + i, t = tstart + r;
                    u32x4 v = {0u, 0u, 0u, 0u};
                    if (t >= 0 && r < c) v = *(const u32x4*)(PROJ + (size_t)(b * LP + t) * GIN_LD + col);
                    rawp[part][i] = v;
                }
            }
#pragma unroll
            for (int rr = 0; rr < 2; ++rr) {
                const int r = r0 + rr;
                abp[2 * rr] = 0.f; abp[2 * rr + 1] = 0.f;
                if (r < c) { abp[2 * rr] = p.AB[(size_t)(b * LP + tstart + r) * 16 + h]; abp[2 * rr + 1] = p.AB[(size_t)(b * LP + tstart + r) * 16 + 8 + h]; }
            }
        }
    };
    int cur_h = -1; float Aexp = 0.f, dtb = 0.f;
    if (q0 < nitems) load_raw(q0);
    for (int q = q0; q < nitems; q += istep) {
        asm volatile("" : "+v"(tid));
        lane = tid & 63; wid = tid >> 6; fr = lane & 15; fq = lane >> 4; c8 = tid & 15; rg = tid >> 4; r0 = 2 * rg;
        int b, h, n; item_of(q, b, h, n);
        const int item = (b * 8 + h) * NCHUNK + n;
        const int c = (n == 0) ? 16 : 64;
        char* rec = p.RB + (size_t)item * CH_BYTES;
        if (h != cur_h) {
            lds_barrier();
            for (int idx = tid; idx < 3 * 4 * 128; idx += NTH) { const int cc = idx & 127, jj = (idx >> 7) & 3, part = idx >> 9; cwl[idx] = p.gdn_conv_w[((size_t)j * 4 + jj) * 3072 + part * 1024 + h * 128 + cc]; }
            Aexp = __expf(p.gdn_A_log[j * 8 + h]); dtb = p.gdn_dt_bias[j * 8 + h];
            cur_h = h;
            lds_barrier();
        }
        float bet[2], gg[2];
#pragma unroll
        for (int rr = 0; rr < 2; ++rr) {
            const int r = r0 + rr;
            if (r < c) { gg[rr] = -Aexp * softplusf_(abp[2 * rr] + dtb); bet[rr] = sigmoidf_(abp[2 * rr + 1]); }
            else { gg[rr] = 0.f; bet[rr] = 0.f; }
            if (c8 == 0) { gs[r] = gg[rr]; betas[r] = bet[rr]; }
        }
#pragma unroll
        for (int pi = 0; pi < 3; ++pi) {
            const int part = (pi == 0) ? 2 : (pi == 1 ? 0 : 1);
            float o[2][8];
#pragma unroll
            for (int e = 0; e < 8; ++e) { o[0][e] = 0.f; o[1][e] = 0.f; }
#pragma unroll
            for (int jj = 0; jj < 4; ++jj) {
                const f32x4 w0 = *(const f32x4*)(cwl + (part * 4 + jj) * 128 + c8 * 8), w1 = *(const f32x4*)(cwl + (part * 4 + jj) * 128 + c8 * 8 + 4);
                const u32x4 ra = rawp[part][jj], rb = rawp[part][jj + 1];
#pragma unroll
                for (int qq = 0; qq < 4; ++qq) {
                    const float wa = qq < 2 ? w0[2 * qq] : w1[2 * qq - 4], wb = qq < 2 ? w0[2 * qq + 1] : w1[2 * qq - 3];
                    o[0][2 * qq] += wa * lo16(ra[qq]); o[0][2 * qq + 1] += wb * hi16(ra[qq]);
                    o[1][2 * qq] += wa * lo16(rb[qq]); o[1][2 * qq + 1] += wb * hi16(rb[qq]);
                }
            }
#pragma unroll
            for (int rr = 0; rr < 2; ++rr) {
                const int r = r0 + rr;
#pragma unroll
                for (int e = 0; e < 8; ++e) o[rr][e] = (r < c) ? siluf_(o[rr][e]) : 0.f;
                if (part == 2) {
                    f32x4 v0, v1;
#pragma unroll
                    for (int e = 0; e < 4; ++e) { v0[e] = o[rr][e] * bet[rr]; v1[e] = o[rr][e + 4] * bet[rr]; }
                    *(f32x4*)(rhs + r * 256 + c8 * 8) = v0; *(f32x4*)(rhs + r * 256 + c8 * 8 + 4) = v1;
                } else {
                    float ss = 0.f;
#pragma unroll
                    for (int e = 0; e < 8; ++e) ss += o[rr][e] * o[rr][e];
                    ss = row16_sum(ss);
                    const float rn = rsqrtf(ss + 1e-6f) * (part == 0 ? 0.08838834764831845f : 1.f);
                    u32x4 w;
#pragma unroll
                    for (int qq = 0; qq < 4; ++qq) w[qq] = pack2(o[rr][2 * qq] * rn, o[rr][2 * qq + 1] * rn);
                    *(u32x4*)((part == 0 ? qs : ks) + r * 136 + c8 * 8) = w;
                }
            }
            __builtin_amdgcn_sched_barrier(0);
        }
        if (q + istep < nitems) load_raw(q + istep);
        lds_barrier();
        if (wid == 0) {
            float x = gs[lane];
#pragma unroll
            for (int o = 1; o < 64; o <<= 1) { const float y = __shfl_up(x, o); if (lane >= o) x += y; }
            Gs[lane] = x;
        }
        lds_barrier();
        const float glast = Gs[63];
#pragma unroll
        for (int rr = 0; rr < 2; ++rr) {
            const int r = r0 + rr; const float eg = __expf(Gs[r]), be = betas[r] * eg;
            const u32x4 kq = *(const u32x4*)(ks + r * 136 + c8 * 8), qq_ = *(const u32x4*)(qs + r * 136 + c8 * 8);
            f32x4 v0, v1;
            v0[0] = lo16(kq[0]) * be; v0[1] = hi16(kq[0]) * be; v0[2] = lo16(kq[1]) * be; v0[3] = hi16(kq[1]) * be;
            v1[0] = lo16(kq[2]) * be; v1[1] = hi16(kq[2]) * be; v1[2] = lo16(kq[3]) * be; v1[3] = hi16(kq[3]) * be;
            *(f32x4*)(rhs + r * 256 + 128 + c8 * 8) = v0; *(f32x4*)(rhs + r * 256 + 128 + c8 * 8 + 4) = v1;
            u32x4 wq;
#pragma unroll
            for (int e = 0; e < 4; ++e) wq[e] = pack2(lo16(qq_[e]) * eg, hi16(qq_[e]) * eg);
            { const int kb32 = (c8 * 8) & ~31, kl = (c8 * 8) & 31;
              u32x2 lo; lo.x = wq[0]; lo.y = wq[1]; u32x2 hi; hi.x = wq[2]; hi.y = wq[3];
              *(u32x2*)(rec + 32768 + ((size_t)r * 128 + kb32 + perm32k(kl)) * 2) = lo;
              *(u32x2*)(rec + 32768 + ((size_t)r * 128 + kb32 + perm32k(kl + 4)) * 2) = hi; }
        }
        {
            const int mat = wid >> 2, ifr = wid & 3;
            const bf16_t* Xs = mat ? qs : ks;
            f32x4 acc[4];
#pragma unroll
            for (int jf = 0; jf < 4; ++jf) acc[jf] = (f32x4){0.f, 0.f, 0.f, 0.f};
#pragma unroll
            for (int kk = 0; kk < 4; ++kk) {
                const bf16x8 xf = *(const bf16x8*)(Xs + (ifr * 16 + fr) * 136 + kk * 32 + fq * 8);
#pragma unroll
                for (int jf = 0; jf < 4; ++jf) {
                    if (jf <= ifr) {
                        const bf16x8 yf = *(const bf16x8*)(ks + (jf * 16 + fr) * 136 + kk * 32 + fq * 8);
                        acc[jf] = __builtin_amdgcn_mfma_f32_16x16x32_bf16(yf, xf, acc[jf], 0, 0, 0);
                    }
                }
            }
            const int i = ifr * 16 + fr; const float Gi = Gs[i], bi = betas[i];
#pragma unroll
            for (int jf = 0; jf < 4; ++jf) {
                const int jc0 = jf * 16 + 4 * fq; const f32x4 Gj = *(const f32x4*)(Gs + jc0);
                f32x4 o;
#pragma unroll
                for (int reg = 0; reg < 4; ++reg) {
                    const int jc = jc0 + reg;
                    const float dec = __expf(Gi - Gj[reg]);
                    o[reg] = (mat == 0) ? ((i > jc) ? bi * acc[jf][reg] * dec : 0.f) : ((i >= jc) ? acc[jf][reg] * dec : 0.f);
                }
                if (mat == 0) *(f32x4*)(Am + i * 68 + jc0) = o;
                else { u32x2 w; w.x = pack2(o[0], o[1]); w.y = pack2(o[2], o[3]); *(u32x2*)(rec + 65536 + ((size_t)i * 64 + (jc0 & ~31) + perm32k(jc0 & 31)) * 2) = w; }
            }
        }
        lds_barrier();
        if (tid == 0) p.GL[item] = __expf(glast);
        if (wid == 0) {
            const int bk = lane >> 4, cidx = lane & 15;
            float tcol[16];
#pragma unroll
            for (int i = 0; i < 16; ++i) {
                float sacc = (i == cidx) ? 1.f : 0.f;
#pragma unroll
                for (int jj = 0; jj < i; ++jj) sacc -= Am[(16 * bk + i) * 68 + 16 * bk + jj] * tcol[jj];
                tcol[i] = sacc;
            }
#pragma unroll
            for (int i = 0; i < 16; ++i) Tinv[(bk * 16 + i) * 16 + cidx] = tcol[i];
        } else {
            for (int idx = tid - 64; idx < 64 * 32; idx += NTH - 64) { const int i = idx >> 5, j2 = (idx & 31) * 2; *(unsigned*)(AmB + i * 72 + j2) = pack2(-Am[i * 68 + j2], -Am[i * 68 + j2 + 1]); }
            for (int kit = tid - 64; kit < 512; kit += NTH - 64) {
                const int k = kit >> 2, jq = kit & 3;
                u32x4 o0, o1;
#pragma unroll
                for (int e = 0; e < 8; ++e) {
                    const int ja = jq * 16 + 2 * e, jb = ja + 1;
                    const float va = bf2f(ks[ja * 136 + k]) * __expf(glast - Gs[ja]), vb = bf2f(ks[jb * 136 + k]) * __expf(glast - Gs[jb]);
                    if (e < 4) o0[e] = pack2(va, vb); else o1[e - 4] = pack2(va, vb);
                }
                { const int jb32 = (jq >> 1) * 32, hh = jq & 1;
                  u32x2 g0; g0.x = o0[0]; g0.y = o0[1]; u32x2 g1; g1.x = o0[2]; g1.y = o0[3]; u32x2 g2; g2.x = o1[0]; g2.y = o1[1]; u32x2 g3; g3.x = o1[2]; g3.y = o1[3];
                  char* kb_ = rec + 49152 + ((size_t)k * 64 + jb32 + 4 * hh) * 2;
                  *(u32x2*)(kb_) = g0; *(u32x2*)(kb_ + 16) = g1; *(u32x2*)(kb_ + 32) = g2; *(u32x2*)(kb_ + 48) = g3; }
            }
        }
        lds_barrier();
        {
            f32x4 C[4][2];
#pragma unroll
            for (int rt = 0; rt < 4; ++rt)
#pragma unroll
                for (int c2 = 0; c2 < 2; ++c2)
#pragma unroll
                    for (int reg = 0; reg < 4; ++reg) C[rt][c2][reg] = rhs[(rt * 16 + 4 * fq + reg) * 256 + (wid * 2 + c2) * 16 + fr];
#pragma unroll
            for (int blk = 0; blk < 4; ++blk) {
                const f32x4 tv = *(const f32x4*)(Tinv + (blk * 16 + fr) * 16 + 4 * fq);
                u32x4 xb[2];
#pragma unroll
                for (int c2 = 0; c2 < 2; ++c2) {
                    f32x4 xacc = {0.f, 0.f, 0.f, 0.f};
#pragma unroll
                    for (int s2 = 0; s2 < 4; ++s2) xacc = __builtin_amdgcn_mfma_f32_16x16x4f32(tv[s2], C[blk][c2][s2], xacc, 0, 0, 0);
                    C[blk][c2] = xacc;
                    xb[c2] = (u32x4){pack2(xacc[0], xacc[1]), pack2(xacc[2], xacc[3]), 0u, 0u};
                }
#pragma unroll
                for (int rt = blk + 1; rt < 4; ++rt) {
                    const u32x2 a2 = *(const u32x2*)(AmB + (rt * 16 + fr) * 72 + 16 * blk + 4 * fq);
                    const u32x4 az = {a2.x, a2.y, 0u, 0u};
#pragma unroll
                    for (int c2 = 0; c2 < 2; ++c2)
                        C[rt][c2] = __builtin_amdgcn_mfma_f32_16x16x32_bf16(__builtin_bit_cast(bf16x8, az), __builtin_bit_cast(bf16x8, xb[c2]), C[rt][c2], 0, 0, 0);
                }
            }
#pragma unroll
            for (int rt = 0; rt < 4; ++rt)
#pragma unroll
                for (int c2 = 0; c2 < 2; ++c2)
#pragma unroll
                    for (int reg = 0; reg < 4; ++reg) rhs[(rt * 16 + 4 * fq + reg) * 256 + (wid * 2 + c2) * 16 + fr] = C[rt][c2][reg];
        }
        lds_barrier();
#pragma unroll
        for (int qq = 0; qq < 2; ++qq) {
            const int ch = tid + qq * NTH;
            { const int v = ch >> 3, i8 = (ch & 7) * 8;
              u32x4 o;
#pragma unroll
              for (int e = 0; e < 4; ++e) o[e] = pack2(rhs[(i8 + 2 * e) * 256 + v], rhs[(i8 + 2 * e + 1) * 256 + v]);
              *(u32x4*)(rec + ((size_t)v * 64 + i8) * 2) = o; }
            { const int i = ch >> 4, k8 = (ch & 15) * 8;
              const f32x4 a0 = *(const f32x4*)(rhs + i * 256 + 128 + k8), a1 = *(const f32x4*)(rhs + i * 256 + 128 + k8 + 4);
              u32x2 lo; lo.x = pack2(-a0[0], -a0[1]); lo.y = pack2(-a0[2], -a0[3]); u32x2 hi; hi.x = pack2(-a1[0], -a1[1]); hi.y = pack2(-a1[2], -a1[3]);
              const int kb32 = k8 & ~31, kl = k8 & 31;
              *(u32x2*)(rec + 16384 + ((size_t)i * 128 + kb32 + perm32k(kl)) * 2) = lo;
              *(u32x2*)(rec + 16384 + ((size_t)i * 128 + kb32 + perm32k(kl + 4)) * 2) = hi; }
        }
        if (n == NCHUNK - 1) {
            for (int idx = tid; idx < 3 * 3 * 128; idx += NTH) {
                const int cc = idx & 127, part = (idx >> 7) % 3, r = idx / 384;
                const int col = part * 1024 + h * 128 + cc;
                p.gC_p[(((size_t)j * 8 + b) * 3 + r) * 3072 + col] = bf2f(PROJ[(size_t)(b * LP + LP - 3 + r) * GIN_LD + col]);
            }
        }
        lds_barrier();
    }
}

__device__ __forceinline__ bf16x8 xfrag(const char* base, int row, int stride, int kbase, int fq) {
    return *(const bf16x8*)(base + row * stride + (kbase + 8 * fq) * 2);
}
__device__ __forceinline__ bf16x8 pack8(const f32x4& a, const f32x4& b) {
    u32x4 r; r.x = pack2(a[0], a[1]); r.y = pack2(a[2], a[3]); r.z = pack2(b[0], b[1]); r.w = pack2(b[2], b[3]);
    return __builtin_bit_cast(bf16x8, r);
}
__device__ __forceinline__ void gdn_scan_prompt_item(CParams& p, int j, int bh, char* smem) {
    int tid = otid(), lane = tid & 63, wid = tid >> 6, fr = lane & 15, fq = lane >> 4;
    const int h = bh & 7, b = bh >> 3; int v0 = 16 * wid;
    char* UT = smem; char* WN = smem + 18432; char* QG = smem + 35840; char* KDT = smem + 53248; char* QKM = smem + 71680;
    float* OT = (float*)(smem + 80896);
    const bf16_t* PROJ = p.RA; bf16_t* OG = p.HN;
    f32x4 S[8];
#pragma unroll
    for (int kf = 0; kf < 8; ++kf) S[kf] = (f32x4){0.f, 0.f, 0.f, 0.f};
    int cv = tid & 15, orow = tid >> 4;
    const f32x4 nw0 = *(const f32x4*)(p.gdn_norm_w + j * 128 + cv * 8), nw1 = *(const f32x4*)(p.gdn_norm_w + j * 128 + cv * 8 + 4);
    u32x4 pre[9], zpre[2];
    const char* rec0 = p.RB + (size_t)(bh * NCHUNK) * CH_BYTES;
#pragma unroll
    for (int i = 0; i < 9; ++i) pre[i] = *(const u32x4*)(rec0 + (size_t)(tid + 512 * i) * 16);
    float gl_pre = p.GL[bh * NCHUNK];
    for (int n = 0; n < NCHUNK; ++n) {
        asm volatile("" : "+v"(tid));
        lane = tid & 63; wid = tid >> 6; fr = lane & 15; fq = lane >> 4; v0 = 16 * wid; cv = tid & 15; orow = tid >> 4;
#pragma unroll
        for (int i = 0; i < 9; ++i) {
            const int idx = tid + 512 * i;
            char* dst;
            if (i < 2) { const int li = idx; dst = UT + (li >> 3) * 144 + (li & 7) * 16; }
            else if (i < 4) { const int li = idx - 1024; dst = WN + (li >> 4) * 272 + (li & 15) * 16; }
            else if (i < 6) { const int li = idx - 2048; dst = QG + (li >> 4) * 272 + (li & 15) * 16; }
            else if (i < 8) { const int li = idx - 3072; dst = KDT + (li >> 3) * 144 + (li & 7) * 16; }
            else { const int li = idx - 4096; dst = QKM + (li >> 3) * 144 + (li & 7) * 16; }
            *(u32x4*)dst = pre[i];
        }
        const float gl = gl_pre;
        lds_barrier();
        const int c = (n == 0) ? 16 : 64, tstart = (n == 0) ? 0 : 16 + 64 * (n - 1);
        if (n + 1 < NCHUNK) {
            const char* recn = rec0 + (size_t)(n + 1) * CH_BYTES;
#pragma unroll
            for (int i = 0; i < 9; ++i) pre[i] = *(const u32x4*)(recn + (size_t)(tid + 512 * i) * 16);
            gl_pre = p.GL[bh * NCHUNK + n + 1];
        }
#pragma unroll
        for (int q = 0; q < 2; ++q) {
            const int i = orow + 32 * q;
            const size_t m = (size_t)b * LP + tstart + (i < c ? i : 0);
            zpre[q] = *(const u32x4*)(PROJ + m * GIN_LD + 3072 + h * 128 + cv * 8);
        }
        bf16x8 Sb[4];
#pragma unroll
        for (int ks = 0; ks < 4; ++ks) Sb[ks] = pack8(S[2 * ks], S[2 * ks + 1]);
        f32x4 vn[4], o[4];
#pragma unroll
        for (int f = 0; f < 4; ++f) {
            const u32x2 raw = *(const u32x2*)(UT + (v0 + fr) * 144 + (16 * f + 4 * fq) * 2);
            vn[f] = (f32x4){lo16(raw.x), hi16(raw.x), lo16(raw.y), hi16(raw.y)};
            o[f] = (f32x4){0.f, 0.f, 0.f, 0.f};
        }
#pragma unroll
        for (int kb = 0; kb < 2; ++kb) {
            bf16x8 xw[2][4], xq[2][4];
#pragma unroll
            for (int k2 = 0; k2 < 2; ++k2)
#pragma unroll
                for (int f = 0; f < 4; ++f) { xw[k2][f] = xfrag(WN, 16 * f + fr, 272, 32 * (2 * kb + k2), fq); xq[k2][f] = xfrag(QG, 16 * f + fr, 272, 32 * (2 * kb + k2), fq); }
            __builtin_amdgcn_sched_barrier(0);
            __builtin_amdgcn_s_setprio(1);
#pragma unroll
            for (int k2 = 0; k2 < 2; ++k2)
#pragma unroll
                for (int f = 0; f < 4; ++f) {
                    vn[f] = __builtin_amdgcn_mfma_f32_16x16x32_bf16(xw[k2][f], Sb[2 * kb + k2], vn[f], 0, 0, 0);
                    o[f] = __builtin_amdgcn_mfma_f32_16x16x32_bf16(xq[k2][f], Sb[2 * kb + k2], o[f], 0, 0, 0);
                }
            __builtin_amdgcn_s_setprio(0);
            __builtin_amdgcn_sched_barrier(0);
        }
        bf16x8 Vb[2];
        Vb[0] = pack8(vn[0], vn[1]); Vb[1] = pack8(vn[2], vn[3]);
        {
            bf16x8 xm[2][4], xk0[2][4];
#pragma unroll
            for (int js = 0; js < 2; ++js)
#pragma unroll
                for (int f = 0; f < 4; ++f) { xm[js][f] = xfrag(QKM, 16 * f + fr, 144, 32 * js, fq); xk0[js][f] = xfrag(KDT, 16 * f + fr, 144, 32 * js, fq); }
            __builtin_amdgcn_sched_barrier(0);
            __builtin_amdgcn_s_setprio(1);
#pragma unroll
            for (int js = 0; js < 2; ++js)
#pragma unroll
                for (int f = 0; f < 4; ++f) o[f] = __builtin_amdgcn_mfma_f32_16x16x32_bf16(xm[js][f], Vb[js], o[f], 0, 0, 0);
#pragma unroll
            for (int kf = 0; kf < 4; ++kf) {
                S[kf] = S[kf] * gl;
#pragma unroll
                for (int js = 0; js < 2; ++js) S[kf] = __builtin_amdgcn_mfma_f32_16x16x32_bf16(xk0[js][kf], Vb[js], S[kf], 0, 0, 0);
            }
            __builtin_amdgcn_s_setprio(0);
            __builtin_amdgcn_sched_barrier(0);
        }
        {
            bf16x8 xk1[2][4];
#pragma unroll
            for (int js = 0; js < 2; ++js)
#pragma unroll
                for (int f = 0; f < 4; ++f) xk1[js][f] = xfrag(KDT, 16 * (4 + f) + fr, 144, 32 * js, fq);
#pragma unroll
            for (int f = 0; f < 4; ++f)
#pragma unroll
                for (int reg = 0; reg < 4; ++reg) OT[(16 * f + 4 * fq + reg) * 132 + v0 + fr] = o[f][reg];
            __builtin_amdgcn_sched_barrier(0);
#pragma unroll
            for (int kf = 4; kf < 8; ++kf) {
                S[kf] = S[kf] * gl;
#pragma unroll
                for (int js = 0; js < 2; ++js) S[kf] = __builtin_amdgcn_mfma_f32_16x16x32_bf16(xk1[js][kf - 4], Vb[js], S[kf], 0, 0, 0);
            }
        }
        lds_barrier();
#pragma unroll
        for (int q = 0; q < 2; ++q) {
            const int i = orow + 32 * q;
            const f32x4 a0 = *(const f32x4*)(OT + i * 132 + cv * 8), a1 = *(const f32x4*)(OT + i * 132 + cv * 8 + 4);
            float ss = a0[0] * a0[0] + a0[1] * a0[1] + a0[2] * a0[2] + a0[3] * a0[3] + a1[0] * a1[0] + a1[1] * a1[1] + a1[2] * a1[2] + a1[3] * a1[3];
            ss = row16_sum(ss);
            const float rstd = rsqrtf(ss * (1.f / 128.f) + 1e-6f);
            if (i < c) {
                const u32x4 z = zpre[q];
                u32x4 w;
                w.x = pack2(a0[0] * rstd * nw0[0] * siluf_(lo16(z.x)), a0[1] * rstd * nw0[1] * siluf_(hi16(z.x)));
                w.y = pack2(a0[2] * rstd * nw0[2] * siluf_(lo16(z.y)), a0[3] * rstd * nw0[3] * siluf_(hi16(z.y)));
                w.z = pack2(a1[0] * rstd * nw1[0] * siluf_(lo16(z.z)), a1[1] * rstd * nw1[1] * siluf_(hi16(z.z)));
                w.w = pack2(a1[2] * rstd * nw1[2] * siluf_(lo16(z.w)), a1[3] * rstd * nw1[3] * siluf_(hi16(z.w)));
                const size_t m = (size_t)b * LP + tstart + i;
                *(u32x4*)(OG + m * D + h * 128 + cv * 8) = w;
            }
        }
    }
    float* So = p.gS_p + (((size_t)j * 8 + b) * 8 + h) * 16384;
#pragma unroll
    for (int kf = 0; kf < 8; ++kf)
#pragma unroll
        for (int reg = 0; reg < 4; ++reg) So[(size_t)(16 * kf + 4 * fq + reg) * 128 + v0 + fr] = S[kf][reg];
    lds_barrier();
}
__device__ __forceinline__ void gdn_sample_item(CParams& p, int j, int item, char* smem) {
    const int tid = otid(), lane = tid & 63, wid = tid >> 6;
    const int h = item & 7, b = item >> 3;
    float* qn = (float*)smem;
    float* kn = qn + 512;
    float* vv = kn + 512;
    float* gb = vv + 512;
    float* wred = gb + 8;
    float* red = wred + 24;
    float* osum = red + 2048;
    const bf16_t* PROJ = p.RA; bf16_t* OG = p.HN;
    const int mbase = TP + b * 4;
    {
        const int t = tid >> 7, c = tid & 127;
        float val[3];
#pragma unroll
        for (int part = 0; part < 3; ++part) {
            const int col = part * 1024 + h * 128 + c;
            float acc = 0.f;
#pragma unroll
            for (int jj = 0; jj < 4; ++jj) {
                const int xi = t + jj;
                const float x = xi < 3 ? p.st_gC[(((size_t)j * 128 + b) * 3 + xi) * 3072 + col] : bf2f(PROJ[(size_t)(mbase + xi - 3) * GIN_LD + col]);
                acc += p.gdn_conv_w[((size_t)j * 4 + jj) * 3072 + col] * x;
            }
            val[part] = siluf_(acc);
        }
        float sq = wave_sum(val[0] * val[0]), sk = wave_sum(val[1] * val[1]);
        if (lane == 0) { wred[wid * 2] = sq; wred[wid * 2 + 1] = sk; }
        lds_barrier();
        sq = wred[(2 * t) * 2] + wred[(2 * t + 1) * 2]; sk = wred[(2 * t) * 2 + 1] + wred[(2 * t + 1) * 2 + 1];
        qn[t * 128 + c] = val[0] * rsqrtf(sq + 1e-6f) * 0.08838834764831845f;
        kn[t * 128 + c] = val[1] * rsqrtf(sk + 1e-6f);
        vv[t * 128 + c] = val[2];
        if (tid < 4) {
            const float av = p.AB[(size_t)(mbase + tid) * 16 + h], bv = p.AB[(size_t)(mbase + tid) * 16 + 8 + h];
            gb[tid] = -__expf(p.gdn_A_log[j * 8 + h]) * softplusf_(av + p.gdn_dt_bias[j * 8 + h]);
            gb[4 + tid] = sigmoidf_(bv);
        }
    }
    for (int idx = tid; idx < 3 * 3 * 128; idx += NTH) {
        const int cc = idx & 127, part = (idx >> 7) % 3, r = idx / 384;
        const int col = part * 1024 + h * 128 + cc;
        p.gC_s[(((size_t)j * 128 + b) * 3 + r) * 3072 + col] = bf2f(PROJ[(size_t)(mbase + 1 + r) * GIN_LD + col]);
    }
    const int v4 = (tid & 31) * 4, ks = tid >> 5;
    const float* Sin = p.st_gS + (((size_t)j * 128 + b) * 8 + h) * 16384;
    f32x4 S[8];
#pragma unroll
    for (int q = 0; q < 8; ++q) S[q] = *(const f32x4*)(Sin + (size_t)(ks * 8 + q) * 128 + v4);
    lds_barrier();
    for (int t = 0; t < 4; ++t) {
        const float a = __expf(gb[t]), beta = gb[4 + t];
        f32x4 part = {0.f, 0.f, 0.f, 0.f};
#pragma unroll
        for (int q = 0; q < 8; ++q) { S[q] = S[q] * a; part = part + S[q] * kn[t * 128 + ks * 8 + q]; }
        *(f32x4*)(red + ks * 128 + v4) = part;
        lds_barrier();
        f32x4 r = *(const f32x4*)(vv + t * 128 + v4);
#pragma unroll
        for (int s = 0; s < 16; ++s) r = r - *(const f32x4*)(red + s * 128 + v4);
        r = r * beta;
        f32x4 op = {0.f, 0.f, 0.f, 0.f};
#pragma unroll
        for (int q = 0; q < 8; ++q) { S[q] = S[q] + r * kn[t * 128 + ks * 8 + q]; op = op + S[q] * qn[t * 128 + ks * 8 + q]; }
        lds_barrier();
        *(f32x4*)(red + ks * 128 + v4) = op;
        lds_barrier();
        if (tid < 128) { float s = 0.f;
#pragma unroll
            for (int q = 0; q < 16; ++q) s += red[q * 128 + tid];
            osum[t * 128 + tid] = s; }
        lds_barrier();
    }
    float* So = p.gS_s + (((size_t)j * 128 + b) * 8 + h) * 16384;
#pragma unroll
    for (int q = 0; q < 8; ++q) *(f32x4*)(So + (size_t)(ks * 8 + q) * 128 + v4) = S[q];
    {
        const int t = tid >> 7, c = tid & 127;
        const float ov = osum[t * 128 + c];
        float ss = wave_sum(ov * ov);
        if (lane == 0) wred[wid * 2] = ss;
        lds_barrier();
        ss = wred[(2 * t) * 2] + wred[(2 * t + 1) * 2];
        const float rstd = rsqrtf(ss * (1.f / 128.f) + 1e-6f);
        const size_t m = (size_t)mbase + t;
        const float z = bf2f(PROJ[m * GIN_LD + 3072 + h * 128 + c]);
        OG[m * D + h * 128 + c] = (bf16_t)f2bf(ov * rstd * p.gdn_norm_w[j * 128 + c] * siluf_(z));
    }
    lds_barrier();
}
__device__ __forceinline__ void gdn_scan_phase(CParams& p, int j, char* smem) {
    const int G = ogrid(), bid = obid();
    if (G > 64) {
        if (bid < 64) gdn_scan_prompt_item(p, j, bid, smem);
        else {
            for (int it = bid - 64; it < 1024; it += G - 64) gdn_sample_item(p, j, it, smem);
            lds_barrier();
            if (j == 0) prep_phase(p, smem, p.pad2, p.pad1, bid - 64, G - 64); else prep_phase(p, smem, p.pad1, p.njobs, bid - 64, G - 64);
        }
    } else {
        if (j == 0) prep_phase(p, smem, p.pad2, p.pad1, bid, G); else prep_phase(p, smem, p.pad1, p.njobs, bid, G);
        lds_barrier();
        for (int it = bid; it < 64; it += G) gdn_scan_prompt_item(p, j, it, smem);
        for (int it = bid; it < 1024; it += G) gdn_sample_item(p, j, it, smem);
    }
}

constexpr size_t RWB = (size_t)MPAD * D * 2;
constexpr int TOKF = 320;
constexpr int VYS = 36;
__device__ __forceinline__ float row8_sum(float x) {
    x = dpp_add<0xB1>(x); x = dpp_add<0x4E>(x); x = dpp_add<0x141>(x);
    return x;
}
struct RVec { f32x4 k0, k1, f0, f1, a0, a1, r0, r1; };
__device__ __forceinline__ void rvec_load(RVec& V, const float* tb, int k8) {
    V.f0 = *(const f32x4*)(tb + 128 + k8); V.f1 = *(const f32x4*)(tb + 128 + k8 + 4);
    V.a0 = *(const f32x4*)(tb + 64 + k8); V.a1 = *(const f32x4*)(tb + 64 + k8 + 4);
    V.r0 = *(const f32x4*)(tb + 256 + k8); V.r1 = *(const f32x4*)(tb + 256 + k8 + 4);
    V.k0 = *(const f32x4*)(tb + 192 + k8); V.k1 = *(const f32x4*)(tb + 192 + k8 + 4);
}
#define RW_SB __builtin_amdgcn_sched_barrier(0)
#define RW_STEP(VV, vvs, EIN, EOUT, YOUT) { \
    const f32x4 d_ = S0 * VV.k0 + S1 * VV.k1; const f32x2 eh_ = (f32x2){EIN[0], EIN[1]} + (f32x2){EIN[2], EIN[3]}; RW_SB; \
    const f32x2 dh_ = (f32x2){d_[0], d_[1]} + (f32x2){d_[2], d_[3]}; float ey_ = eh_[0] + eh_[1]; float ds_ = dh_[0] + dh_[1]; RW_SB; \
    f32x4 P0_ = VV.f0 * vvs + S0; asm volatile("" : "+v"(P0_)); ds_ = dpp_add<0xB1>(ds_); ey_ = dpp_add<0xB1>(ey_); RW_SB; \
    f32x4 P1_ = VV.f1 * vvs + S1; asm volatile("" : "+v"(P1_)); ds_ = dpp_add<0x4E>(ds_); ey_ = dpp_add<0x4E>(ey_); RW_SB; \
    ds_ = dpp_add<0x141>(ds_); ey_ = dpp_add<0x141>(ey_); RW_SB; \
    asm volatile("" : "+v"(ey_)); YOUT = ey_; RW_SB; \
    S0 = P0_ + VV.a0 * ds_; S1 = P1_ + VV.a1 * ds_; EOUT = S0 * VV.r0 + S1 * VV.r1; RW_SB; }
__device__ __forceinline__ float rvec_yred(const f32x4 e) {
    const f32x2 eh = (f32x2){e[0], e[1]} + (f32x2){e[2], e[3]};
    float y = row8_sum(eh[0] + eh[1]);
    asm volatile("" : "+v"(y));
    return y;
}
__device__ __forceinline__ void rwkv_scan_stream(CParams& p, int j, int h, int half, int m0, int ntok, int seglen, int seq0, char* smem) {
    const int tid = otid(), lane = tid & 63, wid = tid >> 6;
    float* bufs = (float*)smem;
    float* vbuf = (float*)(smem + 2 * 32 * TOKF * 4);
    float* ybuf = (float*)(smem + 2 * 32 * TOKF * 4 + 2 * 32 * VYS * 4);
    const bf16_t* C1 = p.RA;
    const bf16_t* E = (const bf16_t*)p.RB; const bf16_t* AA = (const bf16_t*)(p.RB + RWB); const bf16_t* VM = (const bf16_t*)(p.RB + 3 * RWB);
    bf16_t* YRAW = (bf16_t*)(p.RB + 4 * RWB);
    const int nch = (ntok + 31) >> 5;
    if (wid >= 4) {
        const int pt = tid - 256, ptok = pt >> 3, c8 = (pt & 7) * 8, col = h * 64 + c8;
        const f32x4 kk0 = *(const f32x4*)(p.rwkv_k_k + (size_t)j * D + col), kk1 = *(const f32x4*)(p.rwkv_k_k + (size_t)j * D + col + 4);
        const f32x4 ka0 = *(const f32x4*)(p.rwkv_k_a + (size_t)j * D + col), ka1 = *(const f32x4*)(p.rwkv_k_a + (size_t)j * D + col + 4);
        const f32x4 rq0 = *(const f32x4*)(p.rwkv_r_k + (size_t)j * D + col), rq1 = *(const f32x4*)(p.rwkv_r_k + (size_t)j * D + col + 4);
        u32x4 rr_, rk_, rv_, re_, ra_, rm_, rf_;
        auto load_raw = [&](int ch) {
            int tk = ch * 32 + ptok; if (tk > ntok - 1) tk = ntok - 1;
            const size_t m = (size_t)m0 + tk;
            rr_ = *(const u32x4*)(C1 + m * R1_N + col); rk_ = *(const u32x4*)(C1 + m * R1_N + 1024 + col); rv_ = *(const u32x4*)(C1 + m * R1_N + 2048 + col);
            re_ = *(const u32x4*)(E + m * D + col); ra_ = *(const u32x4*)(AA + m * D + col);
            if (j == 1) { rm_ = *(const u32x4*)(VM + m * D + col); rf_ = *(const u32x4*)(p.VFIRST + m * D + col); }
        };
        auto prep_write = [&](int bi, int chn) {
            float r[8], k[8], v[8], e[8], a[8];
#pragma unroll
            for (int q = 0; q < 4; ++q) {
                r[2 * q] = lo16(rr_[q]); r[2 * q + 1] = hi16(rr_[q]); k[2 * q] = lo16(rk_[q]); k[2 * q + 1] = hi16(rk_[q]);
                v[2 * q] = lo16(rv_[q]); v[2 * q + 1] = hi16(rv_[q]); e[2 * q] = lo16(re_[q]); e[2 * q + 1] = hi16(re_[q]);
                a[2 * q] = lo16(ra_[q]); a[2 * q + 1] = hi16(ra_[q]);
            }
            if (j == 1) {
#pragma unroll
                for (int q = 0; q < 4; ++q) {
                    const float m0_ = lo16(rm_[q]), m1_ = hi16(rm_[q]), f0_ = lo16(rf_[q]), f1_ = hi16(rf_[q]);
                    v[2 * q] += (f0_ - v[2 * q]) * m0_; v[2 * q + 1] += (f1_ - v[2 * q + 1]) * m1_;
                }
            }
            float kkr[8], ss = 0.f;
#pragma unroll
            for (int q = 0; q < 8; ++q) { kkr[q] = k[q] * (q < 4 ? kk0[q] : kk1[q - 4]); ss += kkr[q] * kkr[q]; }
            ss = row8_sum(ss);
            const float rn = rsqrtf(ss + 1e-6f);
            const int pl = pt & 63;
            {
                float bs = 0.f;
#pragma unroll
                for (int q = 0; q < 8; ++q) bs += r[q] * (k[q] * (1.f + (a[q] - 1.f) * (q < 4 ? ka0[q] : ka1[q - 4]))) * (q < 4 ? rq0[q] : rq1[q - 4]);
                bs = row8_sum(bs);
                const int tkb = chn * 32 + ptok;
                if (half == 0 && (pt & 7) == 0 && tkb < ntok) p.BON[(size_t)(m0 + tkb) * 16 + h] = bs;
            }
            f32x4 o[10];
#pragma unroll
            for (int q = 0; q < 8; ++q) {
                float ce = e[q];
                ce += __int_as_float(__builtin_amdgcn_update_dpp(0, __float_as_int(ce), 0x118, 0xf, 0xf, true));
                const float up = __shfl(ce, (pl & 32) + 8 + (pl & 7));
                if (pl & 16) ce += up;
                const float Wm = __expf(-ce), Wp = __expf(ce), Wpv = __expf(e[q] - ce);
                const float kkq = kkr[q] * rn, ka = (q < 4 ? ka0[q] : ka1[q - 4]);
                o[0 + (q >> 2)][q & 3] = Wm;
                o[2 + (q >> 2)][q & 3] = -(kkq * a[q]) * Wp;
                o[4 + (q >> 2)][q & 3] = k[q] * (1.f + (a[q] - 1.f) * ka) * Wp;
                o[6 + (q >> 2)][q & 3] = kkq * Wpv;
                o[8 + (q >> 2)][q & 3] = r[q] * Wm;
            }
            float* tb = bufs + bi * 32 * TOKF + ptok * TOKF;
#pragma unroll
            for (int q = 0; q < 5; ++q) { *(f32x4*)(tb + q * 64 + c8) = o[2 * q]; *(f32x4*)(tb + q * 64 + c8 + 4) = o[2 * q + 1]; }
            if ((c8 >> 5) == half) {
                float* vi = vbuf + bi * 32 * VYS + (c8 & 31) * VYS + ptok;
#pragma unroll
                for (int q = 0; q < 8; ++q) vi[q * VYS] = v[q];
            }
        };
        load_raw(0);
        prep_write(0, 0);
        if (1 < nch) load_raw(1);
        lds_barrier();
        for (int ch = 0; ch < nch; ++ch) {
            if (ch + 1 < nch) { prep_write((ch + 1) & 1, ch + 1); if (ch + 2 < nch) load_raw(ch + 2); }
            lds_barrier();
            const float* yb = ybuf + (ch & 1) * 32 * VYS;
            const int nt = (ntok - ch * 32) < 32 ? (ntok - ch * 32) : 32;
            const int tk = pt >> 3, r4 = (pt & 7) * 4;
            if (tk < nt) {
                const size_t m = (size_t)m0 + ch * 32 + tk;
                const float y0 = yb[r4 * VYS + tk], y1 = yb[(r4 + 1) * VYS + tk], y2 = yb[(r4 + 2) * VYS + tk], y3 = yb[(r4 + 3) * VYS + tk];
                u32x2 w; w.x = pack2(y0, y1); w.y = pack2(y2, y3);
                *(u32x2*)(YRAW + m * D + h * 64 + half * 32 + r4) = w;
            }
        }
    } else {
        const int rw = wid * 8 + (lane >> 3), k8 = (lane & 7) * 8, vrow = half * 32 + rw;
        auto state_ptr = [&](int seq, bool out) -> float* {
            if (seq < 8) return (float*)(out ? p.rS_p : nullptr) + ((((size_t)j * 8 + seq) * 16 + h) * 64 + vrow) * 64 + k8;
            return (float*)(out ? p.rS_s : const_cast<float*>(p.st_rS)) + ((((size_t)j * 128 + (seq - 8)) * 16 + h) * 64 + vrow) * 64 + k8;
        };
        __builtin_amdgcn_s_setprio(3);
        f32x4 S0 = {0.f, 0.f, 0.f, 0.f}, S1 = {0.f, 0.f, 0.f, 0.f}, N0 = S0, N1 = S0;
        const bool carried = (seglen < ntok);
        if (carried) { const float* sp = state_ptr(seq0, false); N0 = *(const f32x4*)sp; N1 = *(const f32x4*)(sp + 4); }
        lds_barrier();
        int seg = 0;
        for (int ch = 0; ch < nch; ++ch) {
            const float* buf = bufs + (ch & 1) * 32 * TOKF;
            const float* vb = vbuf + (ch & 1) * 32 * VYS + rw * VYS;
            float* yb = ybuf + (ch & 1) * 32 * VYS + rw * VYS;
            const int nt = (ntok - ch * 32) < 32 ? (ntok - ch * 32) : 32;
            RVec VA, VB;
            rvec_load(VA, buf, k8);
            f32x4 vn = *(const f32x4*)vb;
            f32x4 ep = {0.f, 0.f, 0.f, 0.f}, e0, e1, e2;
            float ya = 0.f, yb_ = 0.f, yc = 0.f, yd;
            for (int t = 0; t < nt; t += 4) {
                if (carried) {
                    S0 = N0; S1 = N1;
                    if ((seg + 1) * seglen < ntok) { const float* sp = state_ptr(seq0 + seg + 1, false); N0 = *(const f32x4*)sp; N1 = *(const f32x4*)(sp + 4); }
                }
                const f32x4 vc = vn;
                vn = *(const f32x4*)(vb + t + 4);
                const f32x4 wg0 = *(const f32x4*)(buf + (t + 3) * TOKF + k8), wg1 = *(const f32x4*)(buf + (t + 3) * TOKF + k8 + 4);
                rvec_load(VB, buf + (t + 1) * TOKF, k8); RW_SB;
                RW_STEP(VA, vc[0], ep, e0, yd);
                if ((lane & 7) == 0) *(f32x4*)(yb + (t > 0 ? t - 4 : 32)) = (f32x4){ya, yb_, yc, yd};
                rvec_load(VA, buf + (t + 2) * TOKF, k8); RW_SB;
                RW_STEP(VB, vc[1], e0, e1, ya);
                rvec_load(VB, buf + (t + 3) * TOKF, k8); RW_SB;
                RW_STEP(VA, vc[2], e1, e2, yb_);
                rvec_load(VA, buf + (t + 4) * TOKF, k8); RW_SB;
                RW_STEP(VB, vc[3], e2, ep, yc);
                S0 = S0 * wg0; S1 = S1 * wg1;
                if (carried) {
                    float* so = state_ptr(seq0 + seg, true);
                    *(f32x4*)so = S0; *(f32x4*)(so + 4) = S1;
                    ++seg;
                }
            }
            yd = rvec_yred(ep);
            if ((lane & 7) == 0) *(f32x4*)(yb + nt - 4) = (f32x4){ya, yb_, yc, yd};
            lds_barrier();
        }
        if (!carried) { float* so = state_ptr(seq0, true); *(f32x4*)so = S0; *(f32x4*)(so + 4) = S1; }
        __builtin_amdgcn_s_setprio(0);
    }
    lds_barrier();
}
__device__ __forceinline__ void rwkv_scan_phase(CParams& p, int j, char* smem) {
    const int G = ogrid(), bid = obid();
    for (int it = bid; it < 256; it += G) rwkv_scan_stream(p, j, (it >> 1) & 15, it & 1, (it >> 5) * LP, LP, LP, it >> 5, smem);
    for (int it = bid; it < 256; it += G) rwkv_scan_stream(p, j, (it >> 1) & 15, it & 1, TP + (it >> 5) * 64, 64, 4, 8 + (it >> 5) * 16, smem);
}
__device__ __forceinline__ void rwkv_post_phase(CParams& p, int j) {
    const int tid = otid();
    const bf16_t* C1 = p.RA;
    const bf16_t* AA = (const bf16_t*)(p.RB + RWB); const bf16_t* GATE = (const bf16_t*)(p.RB + 2 * RWB); const bf16_t* VM = (const bf16_t*)(p.RB + 3 * RWB);
    const bf16_t* YRAW = (const bf16_t*)(p.RB + 4 * RWB);
    bf16_t* YG = p.HN;
    const int c4 = (tid & 15) * 4;
    struct Raw { u32x2 ry, rv, rg, rm, rf; float bon; };
    auto load = [&](Raw& R, int base) {
        const int it = base + (tid >> 4), m = it >> 4, h = it & 15, col = h * 64 + c4;
        const size_t mm = (size_t)m;
        R.ry = *(const u32x2*)(YRAW + mm * D + col); R.rv = *(const u32x2*)(C1 + mm * R1_N + 2048 + col); R.rg = *(const u32x2*)(GATE + mm * D + col);
        R.bon = p.BON[mm * 16 + h];
        if (j == 1) { R.rm = *(const u32x2*)(VM + mm * D + col); R.rf = *(const u32x2*)(p.VFIRST + mm * D + col); }
    };
    const int stride = ogrid() * 32;
    int base = obid() * 32;
    Raw cur, nxt, nx2;
    if (base < T * 16) load(cur, base);
    if (base + stride < T * 16) load(nxt, base + stride);
    for (; base < T * 16; base += stride) {
        if (base + 2 * stride < T * 16) load(nx2, base + 2 * stride);
        const int it = base + (tid >> 4), m = it >> 4, h = it & 15, col = h * 64 + c4;
        const size_t mm = (size_t)m;
        const u32x2 ry = cur.ry, rv = cur.rv, rg = cur.rg;
        f32x4 y = {lo16(ry.x), hi16(ry.x), lo16(ry.y), hi16(ry.y)};
        f32x4 v = {lo16(rv.x), hi16(rv.x), lo16(rv.y), hi16(rv.y)};
        f32x4 g = {lo16(rg.x), hi16(rg.x), lo16(rg.y), hi16(rg.y)};
        if (j == 1) {
            const u32x2 rm = cur.rm, rf = cur.rf;
            f32x4 vm = {lo16(rm.x), hi16(rm.x), lo16(rm.y), hi16(rm.y)};
            f32x4 vf = {lo16(rf.x), hi16(rf.x), lo16(rf.y), hi16(rf.y)};
            v = v + (vf - v) * vm;
        }
        const f32x4 lw = *(const f32x4*)(p.rwkv_ln_w + (size_t)j * D + col), lb = *(const f32x4*)(p.rwkv_ln_b + (size_t)j * D + col);
        const float mu = row16_sum(y[0] + y[1] + y[2] + y[3]) * (1.f / 64.f);
        const f32x4 yc = y - mu;
        const float var = row16_sum(yc[0] * yc[0] + yc[1] * yc[1] + yc[2] * yc[2] + yc[3] * yc[3]) * (1.f / 64.f);
        const float bon = cur.bon;
        const f32x4 o = (yc * rsqrtf(var + 64e-5f) * lw + lb + v * bon) * g;
        u32x2 w; w.x = pack2(o[0], o[1]); w.y = pack2(o[2], o[3]);
        *(u32x2*)(YG + mm * D + col) = w;
        cur = nxt; nxt = nx2;
    }
}

__global__ void __launch_bounds__(NTH) mega_kernel(Params p_arg, int ph_begin, int ph_end) {
    extern __shared__ __attribute__((aligned(16))) char smem[];
#if !MULTI_LAUNCH
    cg::grid_group grid = cg::this_grid();
    volatile LAS unsigned* xst = (volatile LAS unsigned*)(smem + 131072);
    if (threadIdx.x == 0) { xst[0] = 0u; xst[1] = 0u; }
    __syncthreads();
    XcdBarrier xb = xcd_barrier_post(p_arg.bar, xst);
#endif
    for (int ph = ph_begin; ph < ph_end; ++ph) {
        CParams* pp = (CParams*)__builtin_amdgcn_kernarg_segment_ptr();
        asm volatile("" : "+s"(pp));
        CParams& p = *pp;
        int type, layer; phase_info(ph, type, layer);
        const int j = layer >> 1;
#ifndef DUP
#define DUP -1
#endif
        for (int rep = 0; rep < ((type == DUP) ? 2 : 1); ++rep) {
#if !MULTI_LAUNCH
        if (rep) xcd_barrier(xb);
#endif
        switch (type) {
#ifndef ONLY
#define ONLY -1
#endif
#define EN(t) (ONLY < 0 || ONLY == (t))
            case PH_PREP: if (EN(PH_PREP)) { prep_phase(p, smem, 0, p.pad0, obid(), ogrid()); norm_phase(p, 0, 0); } break;
            case PH_NORM_MIX: if (EN(PH_NORM_MIX)) { if (layer & 1) rwkv_norm_phase(p, layer); else norm_phase(p, layer, 0); } break;
            case PH_NORM_FFN: if (EN(PH_NORM_FFN)) { norm_phase(p, layer, 1); } break;
            case PH_FINAL: if (EN(PH_FINAL)) { norm_phase(p, 0, 2); } break;
            case PH_GDN_IN: if (EN(PH_GDN_IN)) { gdn_in_phase(p, j, smem); } break;
            case PH_GDN_PREP: if (EN(PH_GDN_PREP)) { gdn_prep_phase(p, j, smem); } break;
            case PH_GDN_SCAN: if (EN(PH_GDN_SCAN)) { gdn_scan_phase(p, j, smem); } break;
            case PH_GDN_OUT: if (EN(PH_GDN_OUT)) { res_gemm_phase(p, p.HN, D, p.w_out_t + (size_t)j * D * D, smem, rep); } break;
            case PH_FFN_UP: if (EN(PH_FFN_UP)) { ffn_up_phase(p, layer, smem); } break;
            case PH_FFN_DOWN: if (EN(PH_FFN_DOWN)) { res_gemm_phase(p, p.RA + H_OFF, DFF, p.down_t + (size_t)layer * D * DFF, smem, rep); } break;
            case PH_FFN_ACT: if (EN(PH_FFN_ACT)) { ffn_act_phase(p, layer); } break;
            case PH_RWKV_IN: if (EN(PH_RWKV_IN)) { rwkv_in_phase(p, j, smem); } break;
            case PH_RWKV_LORA: if (EN(PH_RWKV_LORA)) { rwkv_lora_phase(p, j, smem); } break;
            case PH_RWKV_SCAN: if (EN(PH_RWKV_SCAN)) { rwkv_scan_phase(p, j, smem); } break;
            case PH_RWKV_POST: if (EN(PH_RWKV_POST)) { rwkv_post_phase(p, j); } break;
            case PH_RWKV_OUT: if (EN(PH_RWKV_OUT)) { res_gemm_phase(p, p.HN, D, p.wo_t + (size_t)j * D * D, smem, rep); } break;
            default: break;
        }
        }
#if !MULTI_LAUNCH
        if (ph + 1 < ph_end) { if (ph_begin < 0) grid.sync(); else xcd_barrier(xb); }
#endif
    }
}

extern "C" void kernel_launch(void* const* d_in, const int* in_sizes, int n_in, void* d_out, int out_size, void* d_ws, size_t ws_size, hipStream_t stream) {
    static int grid = 0;
    if (grid == 0) {
        int dev = 0, cus = 0, per_cu = 0;
        hipGetDevice(&dev);
        hipDeviceGetAttribute(&cus, hipDeviceAttributeMultiprocessorCount, dev);
        hipFuncSetAttribute((const void*)mega_kernel, hipFuncAttributeMaxDynamicSharedMemorySize, SMEM_BYTES);
        hipOccupancyMaxActiveBlocksPerMultiprocessor(&per_cu, (const void*)mega_kernel, NTH, SMEM_BYTES);
        (void)hipGetLastError();
        if (per_cu < 1) { fprintf(stderr, "kernel_launch: occupancy query reports %d blocks per CU\n", per_cu); per_cu = 1; }
        grid = cus;
    }
    Params p; memset(&p, 0, sizeof(p));
    auto in = [&](int i) { return (const float*)d_in[i]; };
    p.x_prompt = in(0); p.x_sample = in(1); p.st_gS = in(2); p.st_gC = in(3); p.st_rS = in(4); p.st_rSh = in(5); p.st_fC = in(6); p.meta = in(7);
    p.norm_mix = in(8); p.norm_ffn = in(9); p.norm_final = in(10);
    p.gdn_conv_w = in(12); p.gdn_A_log = in(13); p.gdn_dt_bias = in(14); p.gdn_norm_w = in(15);
    p.rwkv_mix = in(17); p.rwkv_w0 = in(22); p.rwkv_a0 = in(25); p.rwkv_k_k = in(30); p.rwkv_k_a = in(31); p.rwkv_r_k = in(32); p.rwkv_ln_w = in(33); p.rwkv_ln_b = in(34); p.rwkv_v0 = in(35);
    p.ffn_conv_w = in(39);
    float* o = (float*)d_out; size_t off = 0;
    p.y_prompt = o + off; off += (size_t)8 * 2048 * 1024;
    p.y_sample = o + off; off += (size_t)128 * 4 * 1024;
    p.gS_p = o + off; off += (size_t)2 * 8 * 8 * 128 * 128;
    p.gC_p = o + off; off += (size_t)2 * 8 * 3 * 3072;
    p.rS_p = o + off; off += (size_t)2 * 8 * 16 * 64 * 64;
    p.rSh_p = o + off; off += (size_t)2 * 8 * 1024;
    p.fC_p = o + off; off += (size_t)4 * 8 * 2 * DFF;
    p.gS_s = o + off; off += (size_t)2 * 128 * 8 * 128 * 128;
    p.gC_s = o + off; off += (size_t)2 * 128 * 3 * 3072;
    p.rS_s = o + off; off += (size_t)2 * 128 * 16 * 64 * 64;
    p.rSh_s = o + off; off += (size_t)2 * 128 * 1024;
    p.fC_s = o + off; off += (size_t)4 * 128 * 2 * DFF;
    char* ws = (char*)d_ws; size_t w = 0;
    auto carve = [&](size_t bytes) { char* r = ws + w; w += (bytes + 255) & ~(size_t)255; return r; };
    p.bar = (unsigned*)carve(XCD_BAR_WORDS * 4);
    p.w_in_t = (bf16_t*)carve((size_t)2 * GIN_NP * D * 2);
    p.w_out_t = (bf16_t*)carve((size_t)2 * D * D * 2);
    p.rwkv1_t = (bf16_t*)carve((size_t)2 * 3072 * D * 2);
    p.w2t = (bf16_t*)carve((size_t)2 * D * 64 * 2);
    p.a2t = (bf16_t*)carve((size_t)2 * D * 64 * 2);
    p.g2t = (bf16_t*)carve((size_t)2 * D * 192 * 2);
    p.v2t = (bf16_t*)carve((size_t)D * 64 * 2);
    p.wo_t = (bf16_t*)carve((size_t)2 * D * D * 2);
    p.up_t = (bf16_t*)carve((size_t)4 * 2 * DFF * D * 2);
    p.down_t = (bf16_t*)carve((size_t)4 * D * DFF * 2);
    p.X = (bf16_t*)carve((size_t)MPAD * D * 2);
    p.HN = (bf16_t*)carve((size_t)MPAD * D * 2);
    p.RA = (bf16_t*)carve((size_t)MPAD * GIN_LD * 2);
    p.RB = carve((size_t)5 * MPAD * D * 2);
    if (w > ws_size) { fprintf(stderr, "kernel_launch: workspace too small: need %zu, have %zu\n", w, ws_size); return; }
    char* sc = (char*)p.y_prompt; size_t so = 0;
    auto scarve = [&](size_t bytes) { char* r = sc + so; so += (bytes + 255) & ~(size_t)255; return r; };
    p.VFIRST = (bf16_t*)scarve((size_t)MPAD * D * 2);
    p.AB = (float*)scarve((size_t)MPAD * 16 * 4);
    p.SHIFT = (bf16_t*)scarve((size_t)NSEQ * D * 2);
    p.GL = (float*)scarve((size_t)64 * NCHUNK * 4);
    p.BON = (float*)scarve((size_t)MPAD * 16 * 4);
    p.l1t = (bf16_t*)scarve((size_t)2 * 768 * 2048 * 2);
    int nj = 0;
    auto jobx = [&](const float* src, bf16_t* dst, int K, int N, int Kd, int Nd, int ld, const float* scale, int smode) {
        TJob& t = p.jobs[nj++]; t.src = src; t.dst = dst; t.scale = scale; t.K = K; t.N = N; t.Kd = Kd; t.Nd = Nd; t.ld = ld; t.smode = smode; };
    auto job = [&](const float* src, bf16_t* dst, int K, int N, int Kd, int Nd) { jobx(src, dst, K, N, Kd, Nd, Kd, nullptr, 0); };
    auto gdn_jobs = [&](int j) {
        job(in(11) + (size_t)j * D * 4112, p.w_in_t + (size_t)j * GIN_NP * D, D, 4112, D, GIN_NP);
        job(in(16) + (size_t)j * D * D, p.w_out_t + (size_t)j * D * D, D, D, D, D);
    };
    auto ffn_jobs = [&](int i) {
        job(in(38) + (size_t)i * D * 2 * DFF, p.up_t + (size_t)i * 2 * DFF * D, D, 2 * DFF, D, 2 * DFF);
        job(in(40) + (size_t)i * DFF * D, p.down_t + (size_t)i * D * DFF, DFF, D, DFF, D);
    };
    auto rwkv_jobs = [&](int j) {
        bf16_t* r1 = p.rwkv1_t + (size_t)j * 3072 * D;
        job(in(18) + (size_t)j * D * D, r1, D, D, D, D);
        job(in(19) + (size_t)j * D * D, r1 + (size_t)1024 * D, D, D, D, D);
        job(in(20) + (size_t)j * D * D, r1 + (size_t)2048 * D, D, D, D, D);
        bf16_t* l1 = p.l1t + (size_t)j * 768 * 2048;
        const float* mixb = in(17) + (size_t)j * 6 * D;
        auto lora = [&](const float* src, int N, int Nd, int row0, int ms) {
            jobx(src, l1 + (size_t)row0 * 2048, D, N, D, Nd, 2048, mixb + (size_t)ms * D, 1);
            jobx(src, l1 + (size_t)row0 * 2048 + 1024, D, N, D, Nd, 2048, mixb + (size_t)ms * D, 2);
        };
        lora(in(23) + (size_t)j * D * 64, 64, 128, 0, 1);
        lora(in(26) + (size_t)j * D * 64, 64, 128, 128, 4);
        lora(in(28) + (size_t)j * D * 160, 160, 256, 256, 5);
        lora(in(36), j == 1 ? 32 : 0, 128, 512, 3);
        lora(in(36), 0, 128, 640, 3);
        jobx(in(24) + (size_t)j * 64 * D, p.w2t + (size_t)j * D * 64, 64, D, 64, D, 64, nullptr, 16);
        jobx(in(27) + (size_t)j * 64 * D, p.a2t + (size_t)j * D * 64, 64, D, 64, D, 64, nullptr, 16);
        jobx(in(29) + (size_t)j * 160 * D, p.g2t + (size_t)j * D * 192, 160, D, 192, D, 192, nullptr, 16);
        job(in(21) + (size_t)j * D * D, p.wo_t + (size_t)j * D * D, D, D, D, D);
    };
    gdn_jobs(0);
    p.pad0 = nj;
    ffn_jobs(0);
    p.pad2 = nj;
    rwkv_jobs(0); ffn_jobs(1); gdn_jobs(1);
    p.pad1 = nj;
    ffn_jobs(2); rwkv_jobs(1); jobx(in(37), p.v2t, 32, D, 64, D, 64, nullptr, 16); ffn_jobs(3);
    p.njobs = nj;
#if MULTI_LAUNCH
    for (int ph = 0; ph < NPHASES; ++ph) hipLaunchKernelGGL(mega_kernel, dim3(grid), dim3(NTH), SMEM_BYTES, stream, p, ph, ph + 1);
#else
    hipMemsetAsync(p.bar, 0, XCD_BAR_WORDS * 4, stream);
    int b0 = 0, b1 = NPHASES;
    void* args[] = { &p, &b0, &b1 };
    hipError_t e = hipLaunchCooperativeKernel((const void*)mega_kernel, dim3(grid), dim3(NTH), args, SMEM_BYTES, stream);
    if (e != hipSuccess) fprintf(stderr, "cooperative launch failed: %s (grid %d)\n", hipGetErrorString(e), grid);
#endif
}
```
